# Optimizing an MI355X kernel written in HIP

```python
import jax, jax.numpy as jnp
from jax import lax
import numpy as np

D_MODEL = 2048
BATCH = 4
SEQ = 2048
DEPTH = 2

GRID_W = 64
CTX_LEN = 256
HEAD_DIM = 128
RET_HEADS = D_MODEL // (2 * HEAD_DIM)
RET_DK = HEAD_DIM
RET_DV = HEAD_DIM
RET_CHUNK = 128
MLA_HEADS = D_MODEL // (2 * HEAD_DIM)
MLA_DN = HEAD_DIM
MLA_DR = 64
MLA_DV = HEAD_DIM
MLA_Q_RANK = D_MODEL // 4
MLA_KV_RANK = D_MODEL // 8
MLA_SCALE = (MLA_DN + MLA_DR) ** -0.5
Q_BLOCK = 128
RET_W = RET_HEADS * RET_DK
RET_VW = RET_HEADS * RET_DV
IN_SPLITS = [RET_W, 2 * RET_W, 2 * RET_W + RET_VW, 2 * RET_W + 2 * RET_VW,
             2 * RET_W + 2 * RET_VW + MLA_Q_RANK, 2 * RET_W + 2 * RET_VW + MLA_Q_RANK + MLA_KV_RANK]
IN_COLS = 2 * RET_W + 2 * RET_VW + MLA_Q_RANK + MLA_KV_RANK + MLA_DR
MIX_W = RET_VW + MLA_HEADS * MLA_DV
POOL_WINDOWS = (2, 4, 8, 16)
POOL_G = D_MODEL // len(POOL_WINDOWS)
FFN_DIM = ((8 * D_MODEL // 3 + 255) // 256) * 256
ROPE_BASE = 10000.0
EPS = 1e-6

kernel_name = "hybrid_retention_mla_pool_diffusion_block"


def rmsnorm(x, g):
    x32 = x.astype(jnp.float32)
    y = x32 * lax.rsqrt(jnp.mean(x32 * x32, axis=-1, keepdims=True) + EPS)
    return (y * g).astype(x.dtype)


def modulate(h, shift, scale):
    return h * (1.0 + scale) + shift


def ada_mod(cvec, w, b):
    m = jax.nn.silu(cvec) @ w + b
    return jnp.split(m, 6, axis=-1)


def axial_rope(rows, dim):
    row = jnp.broadcast_to(jnp.arange(rows, dtype=jnp.float32)[:, None], (rows, GRID_W)).reshape(-1)
    col = jnp.broadcast_to(jnp.arange(GRID_W, dtype=jnp.float32)[None, :], (rows, GRID_W)).reshape(-1)
    n_freq = dim // 4
    inv = ROPE_BASE ** (-jnp.arange(n_freq, dtype=jnp.float32) / n_freq)
    ang = jnp.concatenate([row[:, None] * inv, col[:, None] * inv], axis=-1)
    return jnp.cos(ang), jnp.sin(ang)


def apply_rope(x, cos, sin):
    if x.ndim == 4:
        cos, sin = cos[:, None, :], sin[:, None, :]
    half = x.shape[-1] // 2
    x1, x2 = x[..., :half], x[..., half:]
    return jnp.concatenate([x1 * cos - x2 * sin, x1 * sin + x2 * cos], axis=-1).astype(x.dtype)


def retention_scan(q, k, v, log_g, s0, strict):
    B, L, H, _ = q.shape
    n = L // RET_CHUNK

    def chunks(a):
        return a.reshape(B, n, RET_CHUNK, H, a.shape[-1]).transpose(1, 0, 3, 2, 4)

    idx = jnp.arange(RET_CHUNK, dtype=jnp.float32)
    diff = idx[:, None] - idx[None, :]
    mask = (diff > 0) if strict else (diff >= 0)
    decay_in = jnp.where(mask, jnp.exp(jnp.where(mask, diff, 0.0) * log_g[:, None, None]), 0.0)
    q_dec = jnp.exp((idx + 1.0) * log_g[:, None])[..., None]
    k_dec = jnp.exp((RET_CHUNK - 1.0 - idx) * log_g[:, None])[..., None]
    c_dec = jnp.exp(RET_CHUNK * log_g)[:, None, None]

    def step(s, qkv):
        qc, kc, vc = qkv
        inner = jnp.einsum('bhnd,bhmd->bhnm', qc, kc) * decay_in
        o = jnp.einsum('bhnm,bhme->bhne', inner, vc) + jnp.einsum('bhnd,bhde->bhne', qc * q_dec, s)
        s = s * c_dec + jnp.einsum('bhmd,bhme->bhde', kc * k_dec, vc)
        return s, o

    s, o = lax.scan(step, s0, (chunks(q), chunks(k), chunks(v)))
    return s, o.transpose(1, 0, 3, 2, 4).reshape(B, L, H, v.shape[-1])


def bidir_retention(rc, rl, log_f, log_b):
    qc, kc, vc = rc
    ql, kl, vl = rl
    fl = lambda a: jnp.flip(a, axis=1)
    s0 = jnp.zeros((qc.shape[0], RET_HEADS, RET_DK, RET_DV), jnp.float32)
    s_cf, o_cf = retention_scan(qc, kc, vc, log_f, s0, False)
    s_cb, o_cb = retention_scan(fl(qc), fl(kc), fl(vc), log_b, s0, True)
    _, o_lf = retention_scan(ql, kl, vl, log_f, s_cf, False)
    _, o_lb = retention_scan(fl(ql), fl(kl), fl(vl), log_b, s_cb, True)
    return o_cf + fl(o_cb), o_lf + fl(o_lb)


def mla_attention(qn, qr, kn, kr, v):
    B, Lq, H, _ = qn.shape
    nb = Lq // Q_BLOCK

    def to_blocks(a):
        return a.reshape(B, nb, Q_BLOCK, H, a.shape[-1]).swapaxes(0, 1)

    def one_block(qb):
        qn_b, qr_b = qb
        s = jnp.einsum('bqhd,bkhd->bhqk', qn_b, kn) + jnp.einsum('bqhd,bkd->bhqk', qr_b, kr)
        p = jax.nn.softmax(s.astype(jnp.float32) * MLA_SCALE, axis=-1).astype(v.dtype)
        return jnp.einsum('bhqk,bkhd->bqhd', p, v)

    o = lax.map(one_block, (to_blocks(qn), to_blocks(qr)))
    return o.swapaxes(0, 1).reshape(B, Lq, H, v.shape[-1])


def retention_mla_mixer(h_ctx, h_lat, rope_ret, rope_mla, w_in, q_norm_g, w_uq, kv_norm_g, w_ukv,
                        decay_f, decay_b, w_out, with_ctx):
    def project(h, rope_r, rope_m):
        B, L, _ = h.shape
        z = h @ w_in
        rq, rk, rv, rg, cq, ckv, kr = jnp.split(z, IN_SPLITS, axis=-1)
        rq = rq.reshape(B, L, RET_HEADS, RET_DK)
        rk = rk.reshape(B, L, RET_HEADS, RET_DK)
        rv = rv.reshape(B, L, RET_HEADS, RET_DV)
        q = (rmsnorm(cq, q_norm_g) @ w_uq).reshape(B, L, MLA_HEADS, MLA_DN + MLA_DR)
        kv = (rmsnorm(ckv, kv_norm_g) @ w_ukv).reshape(B, L, MLA_HEADS, MLA_DN + MLA_DV)
        qn, qr = q[..., :MLA_DN], q[..., MLA_DN:]
        kn, v = kv[..., :MLA_DN], kv[..., MLA_DN:]
        if rope_r is not None:
            rq, rk = apply_rope(rq, *rope_r), apply_rope(rk, *rope_r)
            qr, kr = apply_rope(qr, *rope_m), apply_rope(kr, *rope_m)
        ret = (rq.astype(jnp.float32), (rk * RET_DK ** -0.5).astype(jnp.float32), rv.astype(jnp.float32))
        return ret, rg, (qn, qr, kn, kr, v)

    ret_c, g_c, mla_c = project(h_ctx, None, None)
    ret_l, g_l, mla_l = project(h_lat, rope_ret, rope_mla)
    log_f = jax.nn.log_sigmoid(decay_f.astype(jnp.float32))
    log_b = jax.nn.log_sigmoid(decay_b.astype(jnp.float32))
    o_ret_c, o_ret_l = bidir_retention(ret_c, ret_l, log_f, log_b)

    def finish(o_ret, gate, o_mla, dtype):
        B, L = o_ret.shape[:2]
        o_ret = o_ret * lax.rsqrt(jnp.mean(o_ret * o_ret, axis=-1, keepdims=True) + EPS)
        o_ret = o_ret.astype(dtype).reshape(B, L, RET_VW) * jax.nn.silu(gate)
        return jnp.concatenate([o_ret, o_mla.reshape(B, L, MLA_HEADS * MLA_DV)], axis=-1) @ w_out

    qn_c, qr_c, kn_c, kr_c, v_c = mla_c
    qn_l, qr_l, kn_l, kr_l, v_l = mla_l
    o_mla_l = mla_attention(qn_l, qr_l, jnp.concatenate([kn_c, kn_l], axis=1),
                            jnp.concatenate([kr_c, kr_l], axis=1), jnp.concatenate([v_c, v_l], axis=1))
    y_lat = finish(o_ret_l, g_l, o_mla_l, h_lat.dtype)
    y_ctx = None
    if with_ctx:
        o_mla_c = mla_attention(qn_c, qr_c, kn_c, kr_c, v_c)
        y_ctx = finish(o_ret_c, g_c, o_mla_c, h_ctx.dtype)
    return y_ctx, y_lat


def multiscale_pool(h, w_pool, scale):
    B, L, D = h.shape
    hf = h.astype(jnp.float32)
    cs = jnp.concatenate([jnp.zeros((B, 1, D), jnp.float32), jnp.cumsum(hf, axis=1)], axis=1)
    t = jnp.arange(L)
    groups = []
    for gi, w in enumerate(POOL_WINDOWS):
        sl = slice(gi * POOL_G, (gi + 1) * POOL_G)
        lo = jnp.clip(t - w // 2, 0, L)
        hi = jnp.clip(t - w // 2 + w, 0, L)
        cnt = (hi - lo).astype(jnp.float32)[:, None]
        groups.append((cs[:, hi, sl] - cs[:, lo, sl]) / cnt - hf[:, :, sl])
    p = jnp.stack(groups, axis=2).astype(h.dtype)
    y = jnp.einsum('blgc,gcd->blgd', p, w_pool).reshape(B, L, D)
    return y * scale


def conv_ffn(h, w_up, conv_w, conv_b, w_down):
    u = h @ w_up
    up = jnp.pad(u, ((0, 0), (1, 1), (0, 0)))
    u = up[:, :-2] * conv_w[0] + up[:, 1:-1] * conv_w[1] + up[:, 2:] * conv_w[2] + conv_b
    a, g = jnp.split(u, 2, axis=-1)
    return (jax.nn.silu(g) * a) @ w_down


def setup_inputs(seed: int = 0) -> dict:
    key = jax.random.key(seed)
    ks = jax.random.split(key, 24)
    n_even = (DEPTH + 1) // 2
    n_odd = DEPTH // 2
    nrm = lambda k, s, sc: jax.random.normal(k, s, jnp.float32) * sc
    base_logit = jnp.asarray(np.log(2.0 ** (5 + np.arange(RET_HEADS)) - 1.0).astype(np.float32))
    return {
        "x": nrm(ks[0], (BATCH, SEQ, D_MODEL), 1.0),
        "c": nrm(ks[1], (BATCH, D_MODEL), 1.0),
        "ctx": nrm(ks[2], (BATCH, CTX_LEN, D_MODEL), 1.0),
        "c_ctx": nrm(ks[3], (D_MODEL,), 1.0),
        "ada_w": nrm(ks[4], (DEPTH, D_MODEL, 6 * D_MODEL), 0.02),
        "ada_b": nrm(ks[5], (DEPTH, 6 * D_MODEL), 0.01),
        "norm1_g": 1.0 + nrm(ks[6], (DEPTH, D_MODEL), 0.02),
        "norm2_g": 1.0 + nrm(ks[7], (DEPTH, D_MODEL), 0.02),
        "ffn_w_up": nrm(ks[8], (DEPTH, D_MODEL, 2 * FFN_DIM), D_MODEL ** -0.5),
        "ffn_conv_w": nrm(ks[9], (DEPTH, 3, 2 * FFN_DIM), 3 ** -0.5),
        "ffn_conv_b": nrm(ks[10], (DEPTH, 2 * FFN_DIM), 0.01),
        "ffn_w_down": nrm(ks[11], (DEPTH, FFN_DIM, D_MODEL), FFN_DIM ** -0.5),
        "mix_w_in": nrm(ks[12], (n_even, D_MODEL, IN_COLS), D_MODEL ** -0.5),
        "mla_q_norm_g": 1.0 + nrm(ks[13], (n_even, MLA_Q_RANK), 0.02),
        "mla_w_uq": nrm(ks[14], (n_even, MLA_Q_RANK, MLA_HEADS * (MLA_DN + MLA_DR)), MLA_Q_RANK ** -0.5),
        "mla_kv_norm_g": 1.0 + nrm(ks[15], (n_even, MLA_KV_RANK), 0.02),
        "mla_w_ukv": nrm(ks[16], (n_even, MLA_KV_RANK, MLA_HEADS * (MLA_DN + MLA_DV)), MLA_KV_RANK ** -0.5),
        "ret_decay_f": base_logit + nrm(ks[17], (n_even, RET_HEADS), 0.1),
        "ret_decay_b": base_logit + nrm(ks[18], (n_even, RET_HEADS), 0.1),
        "mix_w_out": nrm(ks[19], (n_even, MIX_W, D_MODEL), MIX_W ** -0.5),
        "pool_w": nrm(ks[20], (n_odd, len(POOL_WINDOWS), POOL_G, POOL_G), POOL_G ** -0.5),
        "pool_scale": 1.0 + nrm(ks[21], (n_odd, D_MODEL), 0.1),
        "final_g": 1.0 + nrm(ks[22], (D_MODEL,), 0.02),
    }


def reference(x, c, ctx, c_ctx, ada_w, ada_b, norm1_g, norm2_g, ffn_w_up, ffn_conv_w, ffn_conv_b, ffn_w_down,
              mix_w_in, mla_q_norm_g, mla_w_uq, mla_kv_norm_g, mla_w_ukv, ret_decay_f, ret_decay_b, mix_w_out,
              pool_w, pool_scale, final_g):
    rows = x.shape[1] // GRID_W
    rope_ret = axial_rope(rows, RET_DK)
    rope_mla = axial_rope(rows, MLA_DR)
    x_lat, x_ctx = x, ctx
    for l in range(DEPTH):
        j = l // 2
        with_ctx = l < DEPTH - 1
        sh1, sc1, g1, sh2, sc2, g2 = [m[:, None, :] for m in ada_mod(c, ada_w[l], ada_b[l])]
        h_lat = modulate(rmsnorm(x_lat, norm1_g[l]), sh1, sc1)
        if l % 2 == 0 or with_ctx:
            csh1, csc1, cg1, csh2, csc2, cg2 = ada_mod(c_ctx, ada_w[l], ada_b[l])
            h_ctx = modulate(rmsnorm(x_ctx, norm1_g[l]), csh1, csc1)
        if l % 2 == 0:
            o_ctx, o_lat = retention_mla_mixer(h_ctx, h_lat, rope_ret, rope_mla, mix_w_in[j], mla_q_norm_g[j],
                                               mla_w_uq[j], mla_kv_norm_g[j], mla_w_ukv[j], ret_decay_f[j],
                                               ret_decay_b[j], mix_w_out[j], with_ctx)
        else:
            o_lat = multiscale_pool(h_lat, pool_w[j], pool_scale[j])
            o_ctx = multiscale_pool(h_ctx, pool_w[j], pool_scale[j]) if with_ctx else None
        x_lat = x_lat + g1 * o_lat
        x_lat = x_lat + g2 * conv_ffn(modulate(rmsnorm(x_lat, norm2_g[l]), sh2, sc2),
                                      ffn_w_up[l], ffn_conv_w[l], ffn_conv_b[l], ffn_w_down[l])
        if with_ctx:
            x_ctx = x_ctx + cg1 * o_ctx
            x_ctx = x_ctx + cg2 * conv_ffn(modulate(rmsnorm(x_ctx, norm2_g[l]), csh2, csc2),
                                          ffn_w_up[l], ffn_conv_w[l], ffn_conv_b[l], ffn_w_down[l])
    return rmsnorm(x_lat, final_g)
```

```cpp
#include <hip/hip_runtime.h>
#include <cstdio>
#include <cstdint>

#define GAS __attribute__((address_space(1)))
#define LAS __attribute__((address_space(3)))
typedef unsigned short bf16_t;
typedef short bf16x8 __attribute__((ext_vector_type(8)));
typedef short s16x4 __attribute__((ext_vector_type(4)));
typedef float f32x2 __attribute__((ext_vector_type(2)));
typedef float f32x4 __attribute__((ext_vector_type(4)));
typedef float f32x16 __attribute__((ext_vector_type(16)));
typedef unsigned u32x2 __attribute__((ext_vector_type(2)));
typedef unsigned u32x4 __attribute__((ext_vector_type(4)));

constexpr int DM = 2048, NB = 4, SEQ = 2048, CTX = 256, NH = 8, HD = 128;
constexpr int MLAT = NB * SEQ;
constexpr int MCTX = NB * CTX;
constexpr int MALL = MLAT + MCTX;
constexpr int NKEY = CTX + SEQ;
constexpr int FF = 5632, FF2 = 11264;
constexpr int INC = 4928, INP = 5120;
constexpr int QRANK = 512, KVRANK = 256, DR = 64;
constexpr int NADA = 6 * DM;
constexpr float EPS = 1e-6f;
constexpr int NCHUNK = 18;

constexpr size_t MiB = 1u << 20;
constexpr size_t WS_CTL = 0;
constexpr size_t WS_ADA = 1 * MiB;
constexpr size_t WS_RT128 = 2 * MiB;
constexpr size_t WS_RT64 = 3 * MiB;
constexpr size_t WS_RSTDQ = 3 * MiB + 512 * 1024;
constexpr size_t WS_RSTDKV = WS_RSTDQ + 64 * 1024;
constexpr size_t WS_RSTDX = WS_RSTDKV + 64 * 1024;
constexpr size_t WS_WIN = 4 * MiB;
constexpr size_t WS_WUQ = 24 * MiB;
constexpr size_t WS_WUKV = 26 * MiB;
constexpr size_t WS_WPOOL = 27 * MiB;
constexpr size_t WS_WOUT = 29 * MiB;
constexpr size_t WS_WUP = 37 * MiB;
constexpr size_t WS_WDN = 125 * MiB;
constexpr size_t WS_H = 169 * MiB;
constexpr size_t WS_RQ = 205 * MiB;
constexpr size_t WS_RK = 221 * MiB;
constexpr size_t WS_RV = 239 * MiB;
constexpr size_t WS_RG = 257 * MiB;
constexpr size_t WS_CQ = 273 * MiB;
constexpr size_t WS_CKV = 281 * MiB;
constexpr size_t WS_QN = 286 * MiB;
constexpr size_t WS_QR = 302 * MiB;
constexpr size_t WS_KN = 310 * MiB;
constexpr size_t WS_KR = 328 * MiB;
constexpr size_t WS_VC = 330 * MiB;
constexpr size_t WS_KVB = 348 * MiB;
constexpr size_t WS_ST = 420 * MiB;
constexpr size_t WS_MIX = 452 * MiB;
constexpr size_t WS_ACT = 484 * MiB;
constexpr size_t WS_Z = 572 * MiB;
constexpr size_t WS_Z3 = WS_Z + 48 * MiB;
constexpr size_t WS_SLOTS = 578 * MiB;
constexpr size_t WS_XB = 592 * MiB;
constexpr size_t WS_END = 752 * MiB;

constexpr int LDS_BYTES = 147456;

__device__ __forceinline__ unsigned f2bf(float f) { unsigned u = __builtin_bit_cast(unsigned, f); return (u + 0x7fffu + ((u >> 16) & 1u)) >> 16; }
__device__ __forceinline__ unsigned pk2(float lo, float hi) { return f2bf(lo) | (f2bf(hi) << 16); }
__device__ __forceinline__ float bf2f(unsigned short h) { return __builtin_bit_cast(float, (unsigned)h << 16); }
__device__ __forceinline__ float bflo(unsigned w) { return __builtin_bit_cast(float, w << 16); }
__device__ __forceinline__ float bfhi(unsigned w) { return __builtin_bit_cast(float, w & 0xffff0000u); }
__device__ __forceinline__ unsigned cvtpk(float lo, float hi) { unsigned r; asm volatile("v_cvt_pk_bf16_f32 %0, %1, %2" : "=v"(r) : "v"(lo), "v"(hi)); return r; }
__device__ __forceinline__ f32x4 ldbf4(const bf16_t* p) { const u32x2 w = *(const u32x2*)p; return (f32x4){bflo(w.x), bfhi(w.x), bflo(w.y), bfhi(w.y)}; }
__device__ __forceinline__ void stbf4(bf16_t* p, f32x4 v) { u32x2 w; w.x = cvtpk(v.x, v.y); w.y = cvtpk(v.z, v.w); *(u32x2*)p = w; }
__device__ __forceinline__ float wave_sum(float v) {
#pragma unroll
    for (int o = 1; o < 64; o <<= 1) v += __shfl_xor(v, o);
    return v;
}
__device__ __forceinline__ float silu_f(float v) { return v * __builtin_amdgcn_rcpf(1.f + __builtin_amdgcn_exp2f(v * -1.4426950408889634f)); }
__device__ __forceinline__ void sincos_acc(float x, float& s, float& c) {
    const double xd = (double)x; const double kq = __builtin_rint(xd * 0.63661977236758134308);
    const double r = (xd - kq * 1.57079632679489655800) - kq * 6.12323399573676603587e-17; const int q = ((int)kq) & 3;
    const double r2 = r * r;
    const double sp = r * (1.0 + r2 * (-1.0 / 6 + r2 * (1.0 / 120 + r2 * (-1.0 / 5040 + r2 * (1.0 / 362880 + r2 * (-1.0 / 39916800 + r2 * (1.0 / 6227020800.0)))))));
    const double cp = 1.0 + r2 * (-0.5 + r2 * (1.0 / 24 + r2 * (-1.0 / 720 + r2 * (1.0 / 40320 + r2 * (-1.0 / 3628800 + r2 * (1.0 / 479001600.0 + r2 * (-1.0 / 87178291200.0)))))));
    double sd, cd;
    if (q == 0) { sd = sp; cd = cp; } else if (q == 1) { sd = cp; cd = -sp; } else if (q == 2) { sd = -sp; cd = -cp; } else { sd = -cp; cd = sp; }
    s = (float)sd; c = (float)cd;
}

namespace pg8 {
constexpr int BM = 256, BK = 64, HALF = 128, HTB = HALF * BK * 2, STAGE_BYTES = 8 * HTB, NXCD = 8, WGM = 8;
__host__ __device__ __forceinline__ int lds_byte(int r, int c) { const int st = (r >> 4) * 2 + (c >> 5), rr = r & 15, cc = c & 31, ob = rr * 64 + cc * 2; return st * 1024 + (ob ^ (((ob >> 9) & 1) << 5)); }
__host__ __device__ __forceinline__ void stage_rc(int b, int& R, int& C) { const int st = b / 1024, sb = b % 1024, swz = sb ^ (((sb >> 9) & 1) << 5); R = (st >> 1) * 16 + swz / 64; C = (st & 1) * 32 + (swz % 64) / 2; }
__host__ __device__ __forceinline__ int perm32(int rho) { const int n = rho >> 4, i = rho & 15; return 8 * (i >> 2) + 4 * n + (i & 3); }

struct Unit { int pm, pn, g; };
struct Gemm { const bf16_t* A; const bf16_t* Bt; int K, lda, ldb; size_t a_g, b_g; };

struct TileOrder {
    int nM, nN, nwg, G, c;
    __device__ void init(int nM_, int nN_, int nG_, int G_, int c_) { nM = nM_; nN = nN_; nwg = nM_ * nN_ * nG_; G = G_; c = c_; }
    __device__ bool next(int i, Unit& u) const {
        const long L = (long)i * G + c; if (L >= nwg) return false;
        int wgid = (int)L; { const int q = nwg / NXCD, r = nwg % NXCD, xcd = wgid % NXCD, off = wgid / NXCD; wgid = (xcd < r ? xcd * (q + 1) : r * (q + 1) + (xcd - r) * q) + off; }
        const int per_g = nM * nN; u.g = wgid / per_g; const int w = wgid % per_g;
        const int nig = WGM * nN, gid = w / nig, fm = gid * WGM, gsz = (nM - fm) < WGM ? (nM - fm) : WGM;
        u.pm = fm + ((w % nig) % gsz); u.pn = (w % nig) / gsz; return true;
    }
};

struct EpiF32 {
    static constexpr bool PERM = false, AFTER_DRAIN = false, APERM = false;
    float* C; int ldc;
    __device__ __forceinline__ void operator()(const f32x4 (&acc)[2][2][4][2], const Unit& u, int wr, int wc, int fr, int fq) const {
        const int row0 = u.pm * BM + wr * 64 + fr, col0 = u.pn * BM + wc * 32 + 4 * fq;
#pragma unroll
        for (int ai = 0; ai < 2; ++ai)
#pragma unroll
            for (int m = 0; m < 4; ++m) { float* rowp = C + (size_t)(row0 + ai * HALF + m * 16) * ldc + col0;
#pragma unroll
                for (int bj = 0; bj < 2; ++bj)
#pragma unroll
                    for (int n = 0; n < 2; ++n) *(f32x4*)(rowp + bj * HALF + n * 16) = acc[ai][bj][m][n]; }
    }
};
struct EpiBf16 {
    static constexpr bool PERM = true, AFTER_DRAIN = false, APERM = false;
    bf16_t* O; int ldc;
    __device__ __forceinline__ void operator()(const f32x4 (&acc)[2][2][4][2], const Unit& u, int wr, int wc, int fr, int fq) const {
        const int row0 = u.pm * BM + wr * 64 + fr, col0 = u.pn * BM + wc * 32 + 8 * fq;
#pragma unroll
        for (int ai = 0; ai < 2; ++ai)
#pragma unroll
            for (int m = 0; m < 4; ++m) { bf16_t* rowp = O + (size_t)(row0 + ai * HALF + m * 16) * ldc + col0;
#pragma unroll
                for (int bj = 0; bj < 2; ++bj) { const f32x4 v0 = acc[ai][bj][m][0], v1 = acc[ai][bj][m][1];
                    u32x4 w; w.x = cvtpk(v0[0], v0[1]); w.y = cvtpk(v0[2], v0[3]); w.z = cvtpk(v1[0], v1[1]); w.w = cvtpk(v1[2], v1[3]);
                    *(u32x4*)(rowp + bj * HALF) = w; } }
    }
};
struct EpiResid {
    static constexpr bool PERM = true, AFTER_DRAIN = false, APERM = false;
    const bf16_t* base; bf16_t* out; const float* gate; const float* cscale; int gcols; float* ssq;
    __device__ __forceinline__ void operator()(const f32x4 (&acc)[2][2][4][2], const Unit& u, int wr, int wc, int fr, int fq) const {
        const int row0 = u.pm * BM + wr * 64 + fr, col0 = u.g * gcols + u.pn * BM + wc * 32 + 8 * fq;
        const float* gv = gate + (size_t)(u.pm >> 3) * NADA + col0;
        f32x4 gg[2][2];
#pragma unroll
        for (int bj = 0; bj < 2; ++bj)
#pragma unroll
            for (int n = 0; n < 2; ++n) { gg[bj][n] = *(const f32x4*)(gv + bj * HALF + n * 4); if (cscale) gg[bj][n] *= *(const f32x4*)(cscale + col0 + bj * HALF + n * 4); }
        u32x4 bsr[2][4][2];
#pragma unroll
        for (int ai = 0; ai < 2; ++ai)
#pragma unroll
            for (int m = 0; m < 4; ++m)
#pragma unroll
                for (int bj = 0; bj < 2; ++bj) bsr[ai][m][bj] = *(const u32x4*)(base + (size_t)(row0 + ai * HALF + m * 16) * DM + col0 + bj * HALF);
#pragma unroll
        for (int ai = 0; ai < 2; ++ai)
#pragma unroll
            for (int m = 0; m < 4; ++m) { const size_t off = (size_t)(row0 + ai * HALF + m * 16) * DM + col0; float sq = 0.f;
#pragma unroll
                for (int bj = 0; bj < 2; ++bj) { const u32x4 w = bsr[ai][m][bj];
                    const f32x4 o0 = (f32x4){bflo(w.x), bfhi(w.x), bflo(w.y), bfhi(w.y)} + gg[bj][0] * acc[ai][bj][m][0];
                    const f32x4 o1 = (f32x4){bflo(w.z), bfhi(w.z), bflo(w.w), bfhi(w.w)} + gg[bj][1] * acc[ai][bj][m][1];
                    sq += ((o0.x * o0.x + o0.y * o0.y) + (o0.z * o0.z + o0.w * o0.w)) + ((o1.x * o1.x + o1.y * o1.y) + (o1.z * o1.z + o1.w * o1.w));
                    u32x4 ov; ov.x = cvtpk(o0.x, o0.y); ov.y = cvtpk(o0.z, o0.w); ov.z = cvtpk(o1.x, o1.y); ov.w = cvtpk(o1.z, o1.w);
                    *(u32x4*)(out + off + bj * HALF) = ov; }
                if (ssq) { sq += __shfl_xor(sq, 16); sq += __shfl_xor(sq, 32); if (fq == 0) atomicAdd(ssq + row0 + ai * HALF + m * 16, sq); } }
    }
};

struct EpiSplit1 {
    static constexpr bool PERM = true, AFTER_DRAIN = false, APERM = false;
    unsigned char* ws;
    __device__ __forceinline__ void operator()(const f32x4 (&acc)[2][2][4][2], const Unit& u, int wr, int wc, int fr, int fq) const {
        const int pn = u.pn, pm = u.pm; const bool lat = pm < 32;
        const int b = lat ? (pm >> 3) : (pm - 32); const int t0 = lat ? ((pm & 7) * 256) : 0;
        const int rloc0 = wr * 64 + fr, j8 = wc * 32 + fq * 8;
        if (pn < 8) {
            const bool isk = pn >= 4; if (!isk && !lat) return;
            const float ksc = isk ? 0.08838834764831845f : 1.0f;
            f32x4 cs[2][4][2];
#pragma unroll
            for (int ai = 0; ai < 2; ++ai)
#pragma unroll
                for (int m = 0; m < 4; ++m) { const int tt = t0 + rloc0 + ai * HALF + m * 16;
                    cs[ai][m][0] = (f32x4){1.f, 0.f, 1.f, 0.f}; cs[ai][m][1] = (f32x4){1.f, 0.f, 1.f, 0.f};
                    if (lat) { const f32x4* rt = (const f32x4*)(ws + WS_RT128) + ((tt * 64 + (j8 >> 1)) >> 1); cs[ai][m][0] = rt[0]; cs[ai][m][1] = rt[1]; } }
#pragma unroll
            for (int ai = 0; ai < 2; ++ai)
#pragma unroll
                for (int m = 0; m < 4; ++m) { const int tt = t0 + rloc0 + ai * HALF + m * 16;
                    const f32x4 c0 = cs[ai][m][0], c1 = cs[ai][m][1];
#pragma unroll
                    for (int bj = 0; bj < 2; ++bj) { const int h = 2 * (pn & 3) + bj; const f32x4 v0 = acc[ai][bj][m][0], v1 = acc[ai][bj][m][1];
                        u32x4 w;
                        w.x = cvtpk((v0.x * c0.x - v0.y * c0.y) * ksc, (v0.x * c0.y + v0.y * c0.x) * ksc); w.y = cvtpk((v0.z * c0.z - v0.w * c0.w) * ksc, (v0.z * c0.w + v0.w * c0.z) * ksc);
                        w.z = cvtpk((v1.x * c1.x - v1.y * c1.y) * ksc, (v1.x * c1.y + v1.y * c1.x) * ksc); w.w = cvtpk((v1.z * c1.z - v1.w * c1.w) * ksc, (v1.z * c1.w + v1.w * c1.z) * ksc);
                        bf16_t* dst = isk ? (bf16_t*)(ws + WS_RK) + ((size_t)(b * NH + h) * NKEY + (lat ? CTX + tt : tt)) * HD + j8 : (bf16_t*)(ws + WS_RQ) + ((size_t)(b * NH + h) * SEQ + tt) * HD + j8;
                        *(u32x4*)dst = w; } }
        } else if (pn < 12) {
#pragma unroll
            for (int ai = 0; ai < 2; ++ai)
#pragma unroll
                for (int m = 0; m < 4; ++m) { const int tt = t0 + rloc0 + ai * HALF + m * 16;
#pragma unroll
                    for (int bj = 0; bj < 2; ++bj) { const int h = 2 * (pn - 8) + bj; const f32x4 v0 = acc[ai][bj][m][0], v1 = acc[ai][bj][m][1];
                        u32x4 w; w.x = cvtpk(v0.x, v0.y); w.y = cvtpk(v0.z, v0.w); w.z = cvtpk(v1.x, v1.y); w.w = cvtpk(v1.z, v1.w);
                        *(u32x4*)((bf16_t*)(ws + WS_RV) + ((size_t)(b * NH + h) * NKEY + (lat ? CTX + tt : tt)) * HD + j8) = w; } }
        } else if (pn < 18) {
            if (!lat) return;
            const bool isg = pn < 16; float* ssq = (float*)(ws + WS_RSTDQ);
#pragma unroll
            for (int ai = 0; ai < 2; ++ai)
#pragma unroll
                for (int m = 0; m < 4; ++m) { const int row = pm * 256 + rloc0 + ai * HALF + m * 16; float s = 0.f;
#pragma unroll
                    for (int bj = 0; bj < 2; ++bj) { const f32x4 v0 = acc[ai][bj][m][0], v1 = acc[ai][bj][m][1];
                        u32x4 w; w.x = cvtpk(v0.x, v0.y); w.y = cvtpk(v0.z, v0.w); w.z = cvtpk(v1.x, v1.y); w.w = cvtpk(v1.z, v1.w);
                        s += (v0.x * v0.x + v0.y * v0.y) + (v0.z * v0.z + v0.w * v0.w) + (v1.x * v1.x + v1.y * v1.y) + (v1.z * v1.z + v1.w * v1.w);
                        bf16_t* dst = isg ? (bf16_t*)(ws + WS_RG) + (size_t)row * 1024 + (pn - 12) * 256 + bj * HALF + j8 : (bf16_t*)(ws + WS_CQ) + (size_t)row * QRANK + (pn - 16) * 256 + bj * HALF + j8;
                        *(u32x4*)dst = w; }
                    if (!isg) { s += __shfl_xor(s, 16); s += __shfl_xor(s, 32); if (fq == 0) atomicAdd(ssq + row, s); } }
        } else if (pn == 18) {
            float* ssq = (float*)(ws + WS_RSTDKV);
#pragma unroll
            for (int ai = 0; ai < 2; ++ai)
#pragma unroll
                for (int m = 0; m < 4; ++m) { const int row = pm * 256 + rloc0 + ai * HALF + m * 16; float s = 0.f;
#pragma unroll
                    for (int bj = 0; bj < 2; ++bj) { const f32x4 v0 = acc[ai][bj][m][0], v1 = acc[ai][bj][m][1];
                        u32x4 w; w.x = cvtpk(v0.x, v0.y); w.y = cvtpk(v0.z, v0.w); w.z = cvtpk(v1.x, v1.y); w.w = cvtpk(v1.z, v1.w);
                        s += (v0.x * v0.x + v0.y * v0.y) + (v0.z * v0.z + v0.w * v0.w) + (v1.x * v1.x + v1.y * v1.y) + (v1.z * v1.z + v1.w * v1.w);
                        *(u32x4*)((bf16_t*)(ws + WS_CKV) + (size_t)row * KVRANK + bj * HALF + j8) = w; }
                    s += __shfl_xor(s, 16); s += __shfl_xor(s, 32); if (fq == 0) atomicAdd(ssq + row, s); }
        } else {
            if (wc >= 2) return;
#pragma unroll
            for (int ai = 0; ai < 2; ++ai)
#pragma unroll
                for (int m = 0; m < 4; ++m) { const int tt = t0 + rloc0 + ai * HALF + m * 16;
                    f32x4 c0 = {1.f, 0.f, 1.f, 0.f}, c1 = {1.f, 0.f, 1.f, 0.f};
                    if (lat) { const f32x4* rt = (const f32x4*)(ws + WS_RT64) + ((tt * 32 + (j8 >> 1)) >> 1); c0 = rt[0]; c1 = rt[1]; }
                    const f32x4 v0 = acc[ai][0][m][0], v1 = acc[ai][0][m][1];
                    u32x4 w;
                    w.x = cvtpk(v0.x * c0.x - v0.y * c0.y, v0.x * c0.y + v0.y * c0.x); w.y = cvtpk(v0.z * c0.z - v0.w * c0.w, v0.z * c0.w + v0.w * c0.z);
                    w.z = cvtpk(v1.x * c1.x - v1.y * c1.y, v1.x * c1.y + v1.y * c1.x); w.w = cvtpk(v1.z * c1.z - v1.w * c1.w, v1.z * c1.w + v1.w * c1.z);
                    *(u32x4*)((bf16_t*)(ws + WS_KR) + ((size_t)b * NKEY + (lat ? CTX + tt : tt)) * DR + j8) = w; }
        }
    }
};
struct EpiLowRank {
    static constexpr bool PERM = true, AFTER_DRAIN = false, APERM = false;
    unsigned char* ws; int mode;
    __device__ __forceinline__ void operator()(const f32x4 (&acc)[2][2][4][2], const Unit& u, int wr, int wc, int fr, int fq) const {
        const int pn = u.pn, pm = u.pm; const bool lat = pm < 32;
        const int b = lat ? (pm >> 3) : (pm - 32); const int t0 = lat ? ((pm & 7) * 256) : 0;
        const int rloc0 = wr * 64 + fr, j8 = wc * 32 + fq * 8;
        const float* ssq = (const float*)(ws + (mode == 0 ? WS_RSTDQ : WS_RSTDKV)); const float invn = mode == 0 ? 1.0f / QRANK : 1.0f / KVRANK;
#pragma unroll
        for (int ai = 0; ai < 2; ++ai)
#pragma unroll
            for (int m = 0; m < 4; ++m) { const int rl = rloc0 + ai * HALF + m * 16, tt = t0 + rl; const float rs = 1.0f / sqrtf(ssq[pm * 256 + rl] * invn + EPS);
                if (mode == 0 && pn >= 4) {
#pragma unroll
                    for (int bj = 0; bj < 2; ++bj) { const int o = 256 * (pn - 4) + HALF * bj + j8, h = o >> 6, jj = o & 63;
                        const f32x4* rt = (const f32x4*)(ws + WS_RT64) + ((tt * 32 + (jj >> 1)) >> 1); const f32x4 c0 = rt[0], c1 = rt[1];
                        const f32x4 v0 = acc[ai][bj][m][0] * rs, v1 = acc[ai][bj][m][1] * rs;
                        u32x4 w;
                        w.x = cvtpk(v0.x * c0.x - v0.y * c0.y, v0.x * c0.y + v0.y * c0.x); w.y = cvtpk(v0.z * c0.z - v0.w * c0.w, v0.z * c0.w + v0.w * c0.z);
                        w.z = cvtpk(v1.x * c1.x - v1.y * c1.y, v1.x * c1.y + v1.y * c1.x); w.w = cvtpk(v1.z * c1.z - v1.w * c1.w, v1.z * c1.w + v1.w * c1.z);
                        *(u32x4*)((bf16_t*)(ws + WS_QR) + ((size_t)(b * NH + h) * SEQ + tt) * DR + jj) = w; }
                } else {
#pragma unroll
                    for (int bj = 0; bj < 2; ++bj) { const int h = 2 * (pn & 3) + bj; const f32x4 v0 = acc[ai][bj][m][0] * rs, v1 = acc[ai][bj][m][1] * rs;
                        u32x4 w; w.x = cvtpk(v0.x, v0.y); w.y = cvtpk(v0.z, v0.w); w.z = cvtpk(v1.x, v1.y); w.w = cvtpk(v1.z, v1.w);
                        bf16_t* dst = mode == 0 ? (bf16_t*)(ws + WS_QN) + ((size_t)(b * NH + h) * SEQ + tt) * HD + j8
                                                : (bf16_t*)(ws + (pn < 4 ? WS_KN : WS_VC)) + ((size_t)(b * NH + h) * NKEY + (lat ? CTX + tt : tt)) * HD + j8;
                        *(u32x4*)dst = w; } }
            }
    }
};

__device__ __forceinline__ float dpp_shr1(float x) { return __builtin_bit_cast(float, __builtin_amdgcn_update_dpp(0, __builtin_bit_cast(int, x), 0x111, 0xf, 0xf, true)); }
__device__ __forceinline__ float dpp_shl1(float x) { return __builtin_bit_cast(float, __builtin_amdgcn_update_dpp(0, __builtin_bit_cast(int, x), 0x101, 0xf, 0xf, true)); }
__device__ __forceinline__ float dpp_ror1(float x) { return __builtin_bit_cast(float, __builtin_amdgcn_update_dpp(0, __builtin_bit_cast(int, x), 0x121, 0xf, 0xf, false)); }
__device__ __forceinline__ float dpp_ror15(float x) { return __builtin_bit_cast(float, __builtin_amdgcn_update_dpp(0, __builtin_bit_cast(int, x), 0x12f, 0xf, 0xf, false)); }
__device__ __forceinline__ float dpp_shr1_old(float o, float x) { const int oi = __builtin_bit_cast(int, o), xi = __builtin_bit_cast(int, x); return __builtin_bit_cast(float, __builtin_amdgcn_update_dpp(oi, xi, 0x111, 0xf, 0xf, false)); }
__device__ __forceinline__ float dpp_shl1_old(float o, float x) { const int oi = __builtin_bit_cast(int, o), xi = __builtin_bit_cast(int, x); return __builtin_bit_cast(float, __builtin_amdgcn_update_dpp(oi, xi, 0x101, 0xf, 0xf, false)); }
struct EpiConv {
    static constexpr bool PERM = true, AFTER_DRAIN = false, APERM = true;
    const float* cw; const float* cb; bf16_t* act; float* halo; LAS float* ex;
    __device__ __forceinline__ void operator()(const f32x4 (&acc)[2][2][4][2], const Unit& u, int wr, int wc, int fr, int fq) const {
        const int wid = wr * 4 + wc;
        LAS float* mine = ex + wid * 256;
        if (fr == 0) {
#pragma unroll
            for (int ai = 0; ai < 2; ++ai)
#pragma unroll
                for (int bj = 0; bj < 2; ++bj)
#pragma unroll
                    for (int n = 0; n < 2; ++n) *(LAS f32x4*)(mine + (ai * 2 + 0) * 64 + (bj * 2 + n) * 16 + fq * 4) = acc[ai][bj][0][n]; }
        if (fr == 15) {
#pragma unroll
            for (int ai = 0; ai < 2; ++ai)
#pragma unroll
                for (int bj = 0; bj < 2; ++bj)
#pragma unroll
                    for (int n = 0; n < 2; ++n) *(LAS f32x4*)(mine + (ai * 2 + 1) * 64 + (bj * 2 + n) * 16 + fq * 4) = acc[ai][bj][3][n]; }
        if (wr == 0 && fr == 0) { float* hp = halo + (size_t)(u.pm * 4) * FF2 + u.pn * 256 + wc * 32 + fq * 8;
#pragma unroll
            for (int bj = 0; bj < 2; ++bj)
#pragma unroll
                for (int n = 0; n < 2; ++n) { *(f32x4*)(hp + bj * HALF + n * 4) = acc[0][bj][0][n]; *(f32x4*)(hp + FF2 + bj * HALF + n * 4) = acc[0][bj][1][n]; } }
        if (wr == 1 && fr == 15) { float* hp = halo + (size_t)(u.pm * 4 + 2) * FF2 + u.pn * 256 + wc * 32 + fq * 8;
#pragma unroll
            for (int bj = 0; bj < 2; ++bj)
#pragma unroll
                for (int n = 0; n < 2; ++n) { *(f32x4*)(hp + bj * HALF + n * 4) = acc[1][bj][2][n]; *(f32x4*)(hp + FF2 + bj * HALF + n * 4) = acc[1][bj][3][n]; } }
        const int f0 = u.pn * 128 + wc * 32 + fq * 8;
        f32x4 W0[2][2], W1[2][2], W2[2][2], BB[2][2];
#pragma unroll
        for (int n = 0; n < 2; ++n)
#pragma unroll
            for (int bj = 0; bj < 2; ++bj) { const float* p = cw + bj * FF + f0 + 4 * n; W0[n][bj] = *(const f32x4*)p; W1[n][bj] = *(const f32x4*)(p + FF2); W2[n][bj] = *(const f32x4*)(p + 2 * FF2); BB[n][bj] = *(const f32x4*)(cb + bj * FF + f0 + 4 * n); }
        asm volatile("s_waitcnt lgkmcnt(0)" ::: "memory"); __builtin_amdgcn_s_barrier(); asm volatile("" ::: "memory");
        const LAS float* theirs = ex + (wid ^ 4) * 256;
        const int row0 = u.pm * BM + wr * 64 + 4 * fr;
#pragma unroll
        for (int ai = 0; ai < 2; ++ai) {
            f32x4 vpe[2][2], vne[2][2];
#pragma unroll
            for (int n = 0; n < 2; ++n)
#pragma unroll
                for (int bj = 0; bj < 2; ++bj) {
                    const bool hasp = (wr == 1) || (ai == 1); const int slotp = (wr == 1) ? (ai * 2 + 1) : 1;
                    const bool hasn = (wr == 0) || (ai == 0); const int slotn = (wr == 0) ? (ai * 2) : 2;
                    const f32x4 bp = hasp ? *(const LAS f32x4*)(theirs + slotp * 64 + (bj * 2 + n) * 16 + fq * 4) : (f32x4){0.f, 0.f, 0.f, 0.f};
                    const f32x4 bn = hasn ? *(const LAS f32x4*)(theirs + slotn * 64 + (bj * 2 + n) * 16 + fq * 4) : (f32x4){0.f, 0.f, 0.f, 0.f};
#pragma unroll
                    for (int j = 0; j < 4; ++j) { const float lastv = acc[ai][bj][3][n][j], firstv = acc[ai][bj][0][n][j];
                        vpe[n][bj][j] = dpp_shr1_old(bp[j], lastv); vne[n][bj][j] = dpp_shl1_old(bn[j], firstv); } }
#pragma unroll
            for (int m = 0; m < 4; ++m) {
                u32x4 w;
#pragma unroll
                for (int n = 0; n < 2; ++n) {
                    f32x4 up[2];
#pragma unroll
                    for (int bj = 0; bj < 2; ++bj) { const f32x4 v = acc[ai][bj][m][n];
                        const f32x4 vp = (m > 0) ? acc[ai][bj][m > 0 ? m - 1 : 0][n] : vpe[n][bj];
                        const f32x4 vn = (m < 3) ? acc[ai][bj][m < 3 ? m + 1 : 3][n] : vne[n][bj];
                        up[bj] = BB[n][bj] + W1[n][bj] * v + W0[n][bj] * vp + W2[n][bj] * vn; }
                    const f32x4 a = up[0], gt = up[1];
                    const unsigned lo = cvtpk(a.x * silu_f(gt.x), a.y * silu_f(gt.y)), hi = cvtpk(a.z * silu_f(gt.z), a.w * silu_f(gt.w));
                    if (n == 0) { w.x = lo; w.y = hi; } else { w.z = lo; w.w = hi; } }
                *(u32x4*)(act + (size_t)(row0 + ai * HALF + m) * FF + f0) = w; }
        }
    }
};

struct EpiResidNorm {
    static constexpr bool PERM = true, AFTER_DRAIN = true, APERM = false;
    const float* base; const bf16_t* baseb; bf16_t* xout; const float* gate; const float* cscale; int gcols;
    const float* nw; const float* msh; const float* msc; bf16_t* hout; float* fout;
    float* slots; unsigned* cnt;
    __device__ __forceinline__ void fused(f32x4 (&acc)[2][2][4][2], const Unit& u, int wr, int wc, int fr, int fq, LAS unsigned char* lds, int wid, int lane) const {
        LAS float* P = (LAS float*)lds; LAS float* S = (LAS float*)(lds + 4096); LAS unsigned* flag = (LAS unsigned*)(lds + 4096 + 1024);
        const int rl0 = wr * 64 + fr, row0 = u.pm * BM + rl0, col0 = u.g * gcols + u.pn * BM + wc * 32 + 8 * fq;
        const int b = u.pm >> 3, tile = (u.g * gcols) / 256 + u.pn, tid = wid * 64 + lane;
        {   const float* gv = gate + (size_t)b * NADA + col0;
            f32x4 gg[2][2];
#pragma unroll
            for (int bj = 0; bj < 2; ++bj)
#pragma unroll
                for (int n = 0; n < 2; ++n) { gg[bj][n] = *(const f32x4*)(gv + bj * HALF + n * 4); if (cscale) gg[bj][n] *= *(const f32x4*)(cscale + col0 + bj * HALF + n * 4); }
#pragma unroll
            for (int ai = 0; ai < 2; ++ai) {
                if (baseb) {
                    u32x4 bsr[4][2];
#pragma unroll
                    for (int m = 0; m < 4; ++m)
#pragma unroll
                        for (int bj = 0; bj < 2; ++bj) bsr[m][bj] = *(const u32x4*)(baseb + (size_t)(row0 + ai * HALF + m * 16) * DM + col0 + bj * HALF);
#pragma unroll
                    for (int m = 0; m < 4; ++m) { const size_t off = (size_t)(row0 + ai * HALF + m * 16) * DM + col0; float sq = 0.f;
#pragma unroll
                        for (int bj = 0; bj < 2; ++bj) { const u32x4 w = bsr[m][bj];
                            const f32x4 o0 = (f32x4){bflo(w.x), bfhi(w.x), bflo(w.y), bfhi(w.y)} + gg[bj][0] * acc[ai][bj][m][0];
                            const f32x4 o1 = (f32x4){bflo(w.z), bfhi(w.z), bflo(w.w), bfhi(w.w)} + gg[bj][1] * acc[ai][bj][m][1];
                            sq += ((o0.x * o0.x + o0.y * o0.y) + (o0.z * o0.z + o0.w * o0.w)) + ((o1.x * o1.x + o1.y * o1.y) + (o1.z * o1.z + o1.w * o1.w));
                            acc[ai][bj][m][0] = o0; acc[ai][bj][m][1] = o1;
                            if (xout) { u32x4 ov; ov.x = cvtpk(o0.x, o0.y); ov.y = cvtpk(o0.z, o0.w); ov.z = cvtpk(o1.x, o1.y); ov.w = cvtpk(o1.z, o1.w); *(u32x4*)(xout + off + bj * HALF) = ov; } }
                        sq += __shfl_xor(sq, 16); sq += __shfl_xor(sq, 32);
                        if (fq == 0) P[(rl0 + ai * HALF + m * 16) * 4 + wc] = sq; }
                } else {
                    f32x4 bsf[4][2][2];
#pragma unroll
                    for (int m = 0; m < 4; ++m)
#pragma unroll
                        for (int bj = 0; bj < 2; ++bj)
#pragma unroll
                            for (int n = 0; n < 2; ++n) bsf[m][bj][n] = *(const f32x4*)(base + (size_t)(row0 + ai * HALF + m * 16) * DM + col0 + bj * HALF + n * 4);
#pragma unroll
                    for (int m = 0; m < 4; ++m) { const size_t off = (size_t)(row0 + ai * HALF + m * 16) * DM + col0; float sq = 0.f;
#pragma unroll
                        for (int bj = 0; bj < 2; ++bj)
#pragma unroll
                            for (int n = 0; n < 2; ++n) { const f32x4 o = bsf[m][bj][n] + gg[bj][n] * acc[ai][bj][m][n];
                                sq += (o.x * o.x + o.y * o.y) + (o.z * o.z + o.w * o.w); acc[ai][bj][m][n] = o;
                                if (xout) stbf4(xout + off + bj * HALF + n * 4, o); }
                        sq += __shfl_xor(sq, 16); sq += __shfl_xor(sq, 32);
                        if (fq == 0) P[(rl0 + ai * HALF + m * 16) * 4 + wc] = sq; }
                }
                asm volatile("" ::: "memory");
            }
        }
        asm volatile("s_waitcnt lgkmcnt(0)" ::: "memory"); __builtin_amdgcn_s_barrier(); asm volatile("" ::: "memory");
        if (tid < 256) { const float tot = (P[tid * 4 + 0] + P[tid * 4 + 1]) + (P[tid * 4 + 2] + P[tid * 4 + 3]);
            __hip_atomic_store(slots + (size_t)(u.pm * BM + tid) * 8 + tile, tot, __ATOMIC_RELAXED, __HIP_MEMORY_SCOPE_AGENT); }
        asm volatile("s_waitcnt vmcnt(0)" ::: "memory");
        if (wid < 4 && lane == 0) __hip_atomic_fetch_add(cnt + 64 * u.pm, 1u, __ATOMIC_RELAXED, __HIP_MEMORY_SCOPE_AGENT);
        if (wid == 0) {
            unsigned spins = 0;
            while ((unsigned)__builtin_amdgcn_readfirstlane(__hip_atomic_load(cnt + 64 * u.pm, __ATOMIC_RELAXED, __HIP_MEMORY_SCOPE_AGENT)) < 32u) { __builtin_amdgcn_s_sleep(2); if (++spins > (1u << 20)) break; }
            __builtin_amdgcn_fence(__ATOMIC_ACQUIRE, "agent");
            if (lane == 0) flag[0] = 1u;
        }
        asm volatile("s_waitcnt vmcnt(0) lgkmcnt(0)" ::: "memory"); __builtin_amdgcn_s_barrier(); asm volatile("" ::: "memory");
        if (tid < 256) { const float* sl = slots + (size_t)(u.pm * BM + tid) * 8; float tot = 0.f;
#pragma unroll
            for (int t = 0; t < 8; ++t) tot += __hip_atomic_load(sl + t, __ATOMIC_RELAXED, __HIP_MEMORY_SCOPE_AGENT);
            S[tid] = 1.0f / sqrtf(tot * (1.0f / DM) + EPS); }
        asm volatile("s_waitcnt lgkmcnt(0)" ::: "memory"); __builtin_amdgcn_s_barrier(); asm volatile("" ::: "memory");
        f32x4 ma[2][2], mb[2][2];
#pragma unroll
        for (int bj = 0; bj < 2; ++bj)
#pragma unroll
            for (int n = 0; n < 2; ++n) { const int c = col0 + bj * HALF + n * 4; ma[bj][n] = *(const f32x4*)(nw + c); mb[bj][n] = (f32x4){0.f, 0.f, 0.f, 0.f};
                if (msc) { ma[bj][n] *= (*(const f32x4*)(msc + (size_t)b * NADA + c) + 1.0f); mb[bj][n] = *(const f32x4*)(msh + (size_t)b * NADA + c); } }
#pragma unroll
        for (int ai = 0; ai < 2; ++ai)
#pragma unroll
            for (int m = 0; m < 4; ++m) { const float rs = S[rl0 + ai * HALF + m * 16]; const size_t off = (size_t)(row0 + ai * HALF + m * 16) * DM + col0;
#pragma unroll
                for (int bj = 0; bj < 2; ++bj) { const f32x4 y0 = (acc[ai][bj][m][0] * rs) * ma[bj][0] + mb[bj][0], y1 = (acc[ai][bj][m][1] * rs) * ma[bj][1] + mb[bj][1];
                    if (hout) { u32x4 w; w.x = cvtpk(y0.x, y0.y); w.y = cvtpk(y0.z, y0.w); w.z = cvtpk(y1.x, y1.y); w.w = cvtpk(y1.z, y1.w); *(u32x4*)(hout + off + bj * HALF) = w; }
                    else { *(f32x4*)(fout + off + bj * HALF) = y0; *(f32x4*)(fout + off + bj * HALF + 4) = y1; } } }
    }
};

template <class Epi, bool ALIGN_EPI>
__device__ __forceinline__ void gemm_phase(LAS unsigned char* lds, const Gemm g, const TileOrder& S, const Epi& E, const int tid) {
    const int wid = __builtin_amdgcn_readfirstlane(tid >> 6), lane = tid & 63, wr = wid >> 2, wc = wid & 3, fr = lane & 15, fq = lane >> 4;
    const int K = g.K, nt = K / BK;
    unsigned voffA[2], voffB[2];
#pragma unroll
    for (int i = 0; i < 2; ++i) { int R, C; stage_rc(wid * 2048 + i * 1024 + lane * 16, R, C); const int Rb = Epi::PERM ? ((R & ~31) + perm32(R & 31)) : R;
        const int Ra = Epi::APERM ? ((R & ~63) + 4 * (R & 15) + ((R >> 4) & 3)) : R;
        voffA[i] = (unsigned)(Ra * g.lda + C) * 2u + (i == 0 ? 1024u : 0u); voffB[i] = (unsigned)(Rb * g.ldb + C) * 2u + (i == 0 ? 1024u : 0u); }
    const size_t kstep = (size_t)(BK * 2);
    const size_t hstepA = (size_t)HALF * g.lda * 2, hstepB = (size_t)HALF * g.ldb * 2;
    const unsigned ldsw = (unsigned)wid * 2048u, ldsbase = (unsigned)__builtin_amdgcn_readfirstlane((int)(unsigned)(uintptr_t)lds);
    const int aoff = lds_byte(wr * 64 + fr, fq * 8), boff = lds_byte(wc * 32 + fr, fq * 8);
#define PG8_SA(b, h) (((b) * 2 + (h)) * HTB)
#define PG8_SB(b, h) ((4 + (b) * 2 + (h)) * HTB)
#define PG8_STAGE(bufoff, gbase, voff) do { const char* gb_ = (const char*)(gbase); const unsigned m0v_ = ldsbase + (unsigned)(bufoff) + ldsw; \
        asm volatile("s_mov_b32 m0, %0\n\ts_nop 0\n\tglobal_load_lds_dwordx4 %1, %3\n\tglobal_load_lds_dwordx4 %2, %3 offset:1024" \
                     :: "s"(m0v_), "v"((voff)[0]), "v"((voff)[1]), "s"(gb_) : "memory", "m0"); } while (0)
#define PG8_LDA(dst, b, h) do { _Pragma("unroll") for (int m = 0; m < 4; ++m) _Pragma("unroll") for (int k = 0; k < 2; ++k) dst[m][k] = *(const LAS bf16x8*)(lds + PG8_SA(b, h) + aoff + m * 2048 + k * 1024); } while (0)
#define PG8_LDB(dst, b, h) do { _Pragma("unroll") for (int n = 0; n < 2; ++n) _Pragma("unroll") for (int k = 0; k < 2; ++k) dst[n][k] = *(const LAS bf16x8*)(lds + PG8_SB(b, h) + boff + n * 2048 + k * 1024); } while (0)
#define PG8_MMA(ai, bj, At, Bt) do { __builtin_amdgcn_s_setprio(1); _Pragma("unroll") for (int m = 0; m < 4; ++m) _Pragma("unroll") for (int n = 0; n < 2; ++n) _Pragma("unroll") for (int k = 0; k < 2; ++k) \
        acc[ai][bj][m][n] = __builtin_amdgcn_mfma_f32_16x16x32_bf16(Bt[n][k], At[m][k], acc[ai][bj][m][n], 0, 0, 0); __builtin_amdgcn_s_setprio(0); } while (0)
#define PG8_WAIT_V(n) asm volatile("s_waitcnt vmcnt(" #n ")" ::: "memory")
#define PG8_WAIT_VL8 asm volatile("s_waitcnt vmcnt(8) lgkmcnt(0)" ::: "memory")
#define PG8_WAIT_L(n) asm volatile("s_waitcnt lgkmcnt(" #n ")" ::: "memory")
#define PG8_BAR __builtin_amdgcn_s_barrier()
#define PG8_SCHED __builtin_amdgcn_sched_barrier(0)
    Unit cur, nxt; int ui = 0;
    if (!S.next(0, cur)) return;
    f32x4 acc[2][2][4][2];
#pragma unroll
    for (int a = 0; a < 2; ++a)
#pragma unroll
        for (int b = 0; b < 2; ++b)
#pragma unroll
            for (int m = 0; m < 4; ++m)
#pragma unroll
                for (int n = 0; n < 2; ++n) acc[a][b][m][n] = (f32x4){0.f, 0.f, 0.f, 0.f};
    bf16x8 At[4][2], B0[2][2], B1[2][2];
    const char* const gA0 = (const char*)g.A - 1024; const char* const gB0 = (const char*)g.Bt - 1024;
    const char* cA = gA0 + (size_t)cur.g * g.a_g + (size_t)cur.pm * 2 * hstepA; const char* cB = gB0 + (size_t)cur.g * g.b_g + (size_t)cur.pn * 2 * hstepB;
    PG8_STAGE(PG8_SB(0, 0), cB, voffB); PG8_STAGE(PG8_SB(0, 1), cB + hstepB, voffB); PG8_STAGE(PG8_SA(0, 0), cA, voffA); PG8_STAGE(PG8_SA(0, 1), cA + hstepA, voffA);
    if (wr == 1) PG8_BAR;
    PG8_WAIT_V(2); PG8_BAR;
    PG8_STAGE(PG8_SB(1, 0), cB + kstep, voffB); PG8_STAGE(PG8_SA(1, 0), cA + kstep, voffA); PG8_STAGE(PG8_SB(1, 1), cB + hstepB + kstep, voffB);
    PG8_WAIT_V(6); PG8_BAR;
    for (;;) {
        const bool has_next = S.next(ui + 1, nxt);
        const char* nA = has_next ? gA0 + (size_t)nxt.g * g.a_g + (size_t)nxt.pm * 2 * hstepA : cA;
        const char* nB = has_next ? gB0 + (size_t)nxt.g * g.b_g + (size_t)nxt.pn * 2 * hstepB : cB;
        for (int t = 0; t < nt; t += 2) {
            const bool last = (t == nt - 2);
            const char* a1 = cA + (size_t)(t + 1) * kstep;
            const char* a2 = last ? nA : cA + (size_t)(t + 2) * kstep; const char* b2 = last ? nB : cB + (size_t)(t + 2) * kstep;
            const char* a3 = a2 + kstep; const char* b3 = b2 + kstep;
            PG8_LDB(B0, 0, 0); PG8_LDB(B1, 0, 1); PG8_SCHED; PG8_LDA(At, 0, 0); PG8_STAGE(PG8_SA(1, 1), a1 + hstepA, voffA);
            PG8_WAIT_VL8; PG8_BAR; PG8_MMA(0, 0, At, B0); PG8_MMA(0, 1, At, B1); PG8_BAR; PG8_SCHED;
            PG8_STAGE(PG8_SA(0, 0), a2, voffA); PG8_SCHED; PG8_LDA(At, 0, 1); PG8_STAGE(PG8_SB(0, 0), b2, voffB); PG8_STAGE(PG8_SB(0, 1), b2 + hstepB, voffB);
            PG8_WAIT_VL8; PG8_BAR; PG8_MMA(1, 0, At, B0); PG8_MMA(1, 1, At, B1); PG8_BAR; PG8_SCHED;
            PG8_LDB(B0, 1, 0); PG8_LDB(B1, 1, 1); PG8_SCHED; PG8_LDA(At, 1, 0); PG8_STAGE(PG8_SA(0, 1), a2 + hstepA, voffA);
            PG8_WAIT_VL8; PG8_BAR; PG8_MMA(0, 0, At, B0); PG8_MMA(0, 1, At, B1); PG8_BAR; PG8_SCHED;
            PG8_STAGE(PG8_SA(1, 0), a3, voffA); PG8_SCHED; PG8_LDA(At, 1, 1); PG8_STAGE(PG8_SB(1, 0), b3, voffB); PG8_STAGE(PG8_SB(1, 1), b3 + hstepB, voffB);
            PG8_WAIT_VL8; PG8_BAR; PG8_MMA(1, 0, At, B0); PG8_MMA(1, 1, At, B1); PG8_BAR; PG8_SCHED;
        }
        if constexpr (ALIGN_EPI) { if (wr == 0) PG8_BAR; }
        if constexpr (!Epi::AFTER_DRAIN) E(acc, cur, wr, wc, fr, fq);
        if (!has_next) break;
#pragma unroll
        for (int a = 0; a < 2; ++a)
#pragma unroll
            for (int b = 0; b < 2; ++b)
#pragma unroll
                for (int m = 0; m < 4; ++m)
#pragma unroll
                    for (int n = 0; n < 2; ++n) acc[a][b][m][n] = (f32x4){0.f, 0.f, 0.f, 0.f};
        cur = nxt; cA = nA; cB = nB; ++ui;
        if constexpr (ALIGN_EPI) { if (wr == 1) PG8_BAR; }
    }
    PG8_WAIT_V(0);
    if constexpr (!ALIGN_EPI) { if (wr == 0) PG8_BAR; }
    PG8_BAR;
    if constexpr (Epi::AFTER_DRAIN) E.fused(acc, cur, wr, wc, fr, fq, lds, wid, lane);
#undef PG8_SA
#undef PG8_SB
#undef PG8_STAGE
#undef PG8_LDA
#undef PG8_LDB
#undef PG8_MMA
#undef PG8_WAIT_V
#undef PG8_WAIT_L
#undef PG8_WAIT_VL8
#undef PG8_BAR
#undef PG8_SCHED
}
__device__ __forceinline__ f32x4 pgp_y(const LAS char* Yb, const LAS float* rsd, const int j) {
    const u32x2 w = *(const LAS u32x2*)(Yb + j * 128); const float sc = rsd[j];
    return (f32x4){bflo(w.x) * sc, bfhi(w.x) * sc, bflo(w.y) * sc, bfhi(w.y) * sc};
}
}

namespace att {
constexpr int QBLK = 32, KVBLK = 64;
constexpr float SCALE = 0.072168783648703220f;
constexpr float THR = 8.f;
constexpr int SHM_V = 16384, SHM_KN = 16384, SHM_KR = 8192;
#define KSWZ(row, colB) ((row) * 256 + ((colB) ^ (((row) & 7) << 4)))
#define KRSWZ(row, colB) ((row) * 128 + ((colB) ^ (((row) & 7) << 4)))
#define SBAR() __builtin_amdgcn_sched_barrier(0)
#define LDS_BAR() asm volatile("s_waitcnt lgkmcnt(0)\n\ts_barrier" ::: "memory")
__device__ __forceinline__ int crow(int r, int hi) { return (r & 3) + 8 * (r >> 2) + 4 * hi; }
__device__ __forceinline__ void partialSM(f32x16& p0, f32x16& p1, float& m_reg, float& mn, float& alpha) {
  constexpr float C = SCALE * 1.4426950408889634f;
  float pmax = p0[0];
#pragma unroll
  for (int r = 1; r < 16; ++r) pmax = fmaxf(pmax, p0[r]);
#pragma unroll
  for (int r = 0; r < 16; ++r) pmax = fmaxf(pmax, p1[r]);
  { auto rr = __builtin_amdgcn_permlane32_swap(__float_as_uint(pmax), __float_as_uint(pmax), false, false);
    pmax = fmaxf(__uint_as_float(rr[0]), __uint_as_float(rr[1])); }
  if (__builtin_expect(__all(pmax - m_reg <= THR / SCALE), 1)) { mn = m_reg; alpha = 1.f; }
  else { mn = fmaxf(m_reg, pmax); alpha = __builtin_amdgcn_exp2f((m_reg - mn) * C); m_reg = mn; }
  float mnC = -mn * C;
#pragma unroll
  for (int r = 0; r < 16; ++r) p0[r] = fmaf(p0[r], C, mnC);
#pragma unroll
  for (int r = 0; r < 16; ++r) p1[r] = fmaf(p1[r], C, mnC);
#pragma unroll
  for (int r = 0; r < 16; ++r) p0[r] = __builtin_amdgcn_exp2f(p0[r]);
}
#define PK4(P, BASE, OUT) do { unsigned a0 = cvtpk(P[BASE + 0], P[BASE + 1]), a1 = cvtpk(P[BASE + 2], P[BASE + 3]);   \
    unsigned b0 = cvtpk(P[BASE + 4], P[BASE + 5]), b1 = cvtpk(P[BASE + 6], P[BASE + 7]);                              \
    auto r0 = __builtin_amdgcn_permlane32_swap(a0, b0, false, false); auto r1 = __builtin_amdgcn_permlane32_swap(a1, b1, false, false); \
    u32x4 w = {r0[0], r1[0], r0[1], r1[1]}; OUT = *reinterpret_cast<bf16x8*>(&w); } while (0)
__device__ __forceinline__ void finishSM(f32x16& p0, f32x16& p1, float alpha, float& l_reg, bf16x8& pa0, bf16x8& pa1, bf16x8& pa2, bf16x8& pa3) {
#pragma unroll
  for (int r = 0; r < 16; ++r) p1[r] = __builtin_amdgcn_exp2f(p1[r]);
  float ps = 0;
#pragma unroll
  for (int r = 0; r < 16; ++r) ps += p0[r];
#pragma unroll
  for (int r = 0; r < 16; ++r) ps += p1[r];
  { auto rr = __builtin_amdgcn_permlane32_swap(__float_as_uint(ps), __float_as_uint(ps), false, false);
    ps = __uint_as_float(rr[0]) + __uint_as_float(rr[1]); }
  l_reg = l_reg * alpha + ps;
  PK4(p0, 0, pa0); PK4(p0, 8, pa1); PK4(p1, 0, pa2); PK4(p1, 8, pa3);
}
__device__ __forceinline__ void qkt128(f32x16& p0, f32x16& p1, const char* Ks, const bf16x8* qr, int r32, int hi) {
#pragma unroll
  for (int d0 = 0; d0 < 8; ++d0) { int cb = (d0 * 16 + hi * 8) * 2;
    bf16x8 b0 = *reinterpret_cast<const bf16x8*>(Ks + KSWZ(r32, cb));
    bf16x8 b1 = *reinterpret_cast<const bf16x8*>(Ks + KSWZ(32 + r32, cb));
    p0 = __builtin_amdgcn_mfma_f32_32x32x16_bf16(b0, qr[d0], p0, 0, 0, 0);
    p1 = __builtin_amdgcn_mfma_f32_32x32x16_bf16(b1, qr[d0], p1, 0, 0, 0); }
}
__device__ __forceinline__ void qkt64(f32x16& p0, f32x16& p1, const char* Ks, const bf16x8* qr, int r32, int hi) {
#pragma unroll
  for (int d0 = 0; d0 < 4; ++d0) { int cb = (d0 * 16 + hi * 8) * 2;
    bf16x8 b0 = *reinterpret_cast<const bf16x8*>(Ks + KRSWZ(r32, cb));
    bf16x8 b1 = *reinterpret_cast<const bf16x8*>(Ks + KRSWZ(32 + r32, cb));
    p0 = __builtin_amdgcn_mfma_f32_32x32x16_bf16(b0, qr[d0], p0, 0, 0, 0);
    p1 = __builtin_amdgcn_mfma_f32_32x32x16_bf16(b1, qr[d0], p1, 0, 0, 0); }
}
__device__ __forceinline__ int v_st(int k, int c) { const int kk = (k & ~0xC) | ((k & 4) << 1) | ((k & 8) >> 1); return ((kk >> 3) * 4 + (c >> 5)) * 512 + ((kk & 7) * 32 + (c & 31)) * 2; }
__device__ __forceinline__ int v_rd_base(int lane) { return ((lane & 3) << 3) | (((lane >> 2) & 3) << 6) | (((lane >> 4) & 1) << 5) | (((lane >> 5) & 1) << 8); }
constexpr int v_rd_off(int d0, int ks, int half) { return d0 * 512 + ks * 4096 + half * 2048; }
template <int OFF> __device__ __forceinline__ s16x4 tr_read(int vb) {
  s16x4 r; asm volatile("ds_read_b64_tr_b16 %0, %1 offset:%2" : "=&v"(r) : "v"(vb), "i"(OFF) : "memory"); return r;
}
#define PKLH(L, H) (bf16x8){L[0], L[1], L[2], L[3], H[0], H[1], H[2], H[3]}
template <int D0> __device__ __forceinline__ void pv_one(f32x16& od, int vb, bf16x8 pa0, bf16x8 pa1, bf16x8 pa2, bf16x8 pa3) {
  const s16x4 l0 = tr_read<v_rd_off(D0, 0, 0)>(vb), h0 = tr_read<v_rd_off(D0, 0, 1)>(vb), l1 = tr_read<v_rd_off(D0, 1, 0)>(vb), h1 = tr_read<v_rd_off(D0, 1, 1)>(vb);
  const s16x4 l2 = tr_read<v_rd_off(D0, 2, 0)>(vb), h2 = tr_read<v_rd_off(D0, 2, 1)>(vb), l3 = tr_read<v_rd_off(D0, 3, 0)>(vb), h3 = tr_read<v_rd_off(D0, 3, 1)>(vb);
  asm volatile("s_waitcnt lgkmcnt(0)" ::: "memory"); SBAR();
  od = __builtin_amdgcn_mfma_f32_32x32x16_bf16(pa0, PKLH(l0, h0), od, 0, 0, 0);
  od = __builtin_amdgcn_mfma_f32_32x32x16_bf16(pa1, PKLH(l1, h1), od, 0, 0, 0);
  od = __builtin_amdgcn_mfma_f32_32x32x16_bf16(pa2, PKLH(l2, h2), od, 0, 0, 0);
  od = __builtin_amdgcn_mfma_f32_32x32x16_bf16(pa3, PKLH(l3, h3), od, 0, 0, 0);
}
__device__ __forceinline__ void pv_d0(f32x16* o, int vb, bf16x8 pa0, bf16x8 pa1, bf16x8 pa2, bf16x8 pa3) {
  pv_one<0>(o[0], vb, pa0, pa1, pa2, pa3); pv_one<1>(o[1], vb, pa0, pa1, pa2, pa3); pv_one<2>(o[2], vb, pa0, pa1, pa2, pa3); pv_one<3>(o[3], vb, pa0, pa1, pa2, pa3);
}

__device__ __forceinline__ void mla_body(const bf16_t* __restrict__ Qn, const bf16_t* __restrict__ Qr, const bf16_t* __restrict__ Kn, const bf16_t* __restrict__ Kr,
                                         const bf16_t* __restrict__ Vh, bf16_t* __restrict__ Ob, int ldo, int seq, char* lds, const int tid) {
  const int wid = tid >> 6, lane = tid & 63, r32 = lane & 31, hi = lane >> 5;
  char* V_lds = lds; char* K_lds = lds + 2 * SHM_V; char* R_lds = lds + 2 * SHM_V + 2 * SHM_KN;
  float* ws = (float*)(lds + 2 * SHM_V + 2 * SHM_KN + 2 * SHM_KR) + wid * 64; float* li_l = ws; float* al_l = ws + 32;
  float m_reg = -1e30f, l_reg = 0; f32x16 o[4] = {}; bf16x8 qr[12];
  { const bf16_t* Qw = Qn + (long)(wid * QBLK + r32) * 128 + hi * 8;
#pragma unroll
    for (int d0 = 0; d0 < 8; ++d0) qr[d0] = *reinterpret_cast<const bf16x8*>(Qw + d0 * 16);
    const bf16_t* Qw2 = Qr + (long)(wid * QBLK + r32) * 64 + hi * 8;
#pragma unroll
    for (int d0 = 0; d0 < 4; ++d0) qr[8 + d0] = *reinterpret_cast<const bf16x8*>(Qw2 + d0 * 16); }
  const int sr = tid >> 4, sc = (tid & 15) * 8, vst0 = v_st(sr, sc), vst1 = v_st(32 + sr, sc);
  const int rr = tid >> 3, rc = (tid & 7) * 8;
  const int vb0 = (int)(uintptr_t)V_lds + v_rd_base(lane);
  bf16x8 svs0, svs1, sks0, sks1, skr;
#define SLOAD(k0) do { svs0 = *reinterpret_cast<const bf16x8*>(&Vh[(long)((k0) + sr) * 128 + sc]); svs1 = *reinterpret_cast<const bf16x8*>(&Vh[(long)((k0) + 32 + sr) * 128 + sc]); \
    sks0 = *reinterpret_cast<const bf16x8*>(&Kn[(long)((k0) + sr) * 128 + sc]); sks1 = *reinterpret_cast<const bf16x8*>(&Kn[(long)((k0) + 32 + sr) * 128 + sc]); \
    skr = *reinterpret_cast<const bf16x8*>(&Kr[(long)((k0) + rr) * 64 + rc]); } while (0)
#define SWRITE(b) do { *(bf16x8*)(V_lds + (b) * SHM_V + vst0) = svs0; *(bf16x8*)(V_lds + (b) * SHM_V + vst1) = svs1; int kc = sc * 2;               \
    *(bf16x8*)(K_lds + (b) * SHM_KN + KSWZ(sr, kc)) = sks0; *(bf16x8*)(K_lds + (b) * SHM_KN + KSWZ(32 + sr, kc)) = sks1;                       \
    *(bf16x8*)(R_lds + (b) * SHM_KR + KRSWZ(rr, rc * 2)) = skr; } while (0)
#define RESC(a) do { if (__any((a) < 1.f)) { if (hi == 0) al_l[r32] = (a); asm volatile("s_waitcnt lgkmcnt(0)" ::: "memory"); \
    _Pragma("unroll") for (int d = 0; d < 4; ++d) _Pragma("unroll") for (int r = 0; r < 16; ++r) o[d][r] *= al_l[crow(r, hi)]; } } while (0)
  const int NT = seq / KVBLK;
  SLOAD(0); asm volatile("s_waitcnt vmcnt(0)" ::: "memory"); SWRITE(0); __syncthreads();
  for (int j = 0; j < NT; ++j) {
    const int buf = j & 1;
    if (j + 1 < NT) SLOAD((j + 1) * KVBLK);
    f32x16 p0 = {}, p1 = {}; float mn, al; bf16x8 pa0, pa1, pa2, pa3;
    qkt128(p0, p1, K_lds + buf * SHM_KN, qr, r32, hi); qkt64(p0, p1, R_lds + buf * SHM_KR, qr + 8, r32, hi);
    partialSM(p0, p1, m_reg, mn, al);
    RESC(al);
    finishSM(p0, p1, al, l_reg, pa0, pa1, pa2, pa3); SBAR();
    pv_d0(o, vb0 + buf * SHM_V, pa0, pa1, pa2, pa3);
    if (j + 1 < NT) { asm volatile("s_waitcnt vmcnt(0)" ::: "memory"); SWRITE(buf ^ 1); }
    __syncthreads();
  }
  if (hi == 0) li_l[r32] = l_reg; asm volatile("s_waitcnt lgkmcnt(0)" ::: "memory");
  float rli[16];
#pragma unroll
  for (int r = 0; r < 16; ++r) rli[r] = __builtin_amdgcn_rcpf(li_l[crow(r, hi)]);
  char* OT = lds + wid * 8704;
  { char* OTw = OT + (4 * hi) * 272 + r32 * 2; asm volatile("" : "+v"(OTw));
#pragma unroll
    for (int r = 0; r < 16; ++r) { const int rc = (r & 3) + 8 * (r >> 2);
#pragma unroll
      for (int d0 = 0; d0 < 4; ++d0) *(unsigned short*)(OTw + rc * 272 + d0 * 64) = (unsigned short)f2bf(o[d0][r] * rli[r]); } }
  asm volatile("s_waitcnt lgkmcnt(0)" ::: "memory");
  bf16_t* Ow = Ob + (long)(wid * QBLK) * ldo;
  { int ln = r32 + 32 * hi; asm volatile("" : "+v"(ln));
    const int rw = ln >> 4, ch = ln & 15;
#pragma unroll
    for (int i = 0; i < 8; ++i) { const int row = i * 4 + rw;
      *(u32x4*)(Ow + (long)row * ldo + ch * 8) = *(const u32x4*)(OT + row * 272 + ch * 16); } }
#undef SLOAD
#undef SWRITE
#undef RESC
}
}


#define XB_TMO      128
#define XB_XCNT(j)  (256  + 64 * (j))
#define XB_XSUB(j)  (1280 + 64 * (j))
#define XB_XGEN(j)  (2304 + 64 * (j))
#define XB_TOP      3328
#define XB_TOPGEN   3392
#define XCD_BAR_WORDS 3456
#define XB_SPIN_CAP (1u << 18)
__device__ __forceinline__ unsigned xb_ld(unsigned* p)              { return __hip_atomic_load(p, __ATOMIC_RELAXED, __HIP_MEMORY_SCOPE_AGENT); }
__device__ __forceinline__ unsigned xb_add(unsigned* p, unsigned v) { return __hip_atomic_fetch_add(p, v, __ATOMIC_RELAXED, __HIP_MEMORY_SCOPE_AGENT); }
__device__ __forceinline__ unsigned xb_xcc_id() { return (unsigned)__builtin_amdgcn_s_getreg((3 << 11) | 20) & 0xFu; }
#define XB_SPIN(cond, bar) do { unsigned _sp = 0; while (cond) { __builtin_amdgcn_s_sleep(1); \
    if ((++_sp & 255u) == 0u) { if (xb_ld(&(bar)[XB_TMO])) break; if (_sp > XB_SPIN_CAP) { atomicAdd(&(bar)[XB_TMO], 1u); break; } } } } while (0)
struct XcdBarrier { unsigned* bar; unsigned x; volatile LAS unsigned* st; };
__device__ __forceinline__ XcdBarrier xcd_barrier_post(unsigned* bar, volatile LAS unsigned* st) {
    XcdBarrier b; b.bar = bar; b.x = xb_xcc_id(); b.st = st;
    if (threadIdx.x == 0) (void)xb_add(&bar[XB_XCNT(b.x)], 1u);
    return b;
}
__device__ __forceinline__ void xcd_barrier_complete(unsigned* bar, unsigned x, unsigned& nloc, unsigned& nx) {
    const unsigned G = gridDim.x * gridDim.y * gridDim.z;
    unsigned sum, cnt, mine, sp = 0u;
    for (;;) {
        sum = 0u; cnt = 0u; mine = 0u;
#pragma unroll
        for (unsigned j = 0; j < 16; ++j) { const unsigned c = xb_ld(&bar[XB_XCNT(j)]); sum += c; cnt += (c > 0u) ? 1u : 0u; mine = (j == x) ? c : mine; }
        if (sum == G) break;
        __builtin_amdgcn_s_sleep(1);
        if ((++sp & 255u) == 0u) { if (xb_ld(&bar[XB_TMO])) break; if (sp > XB_SPIN_CAP) { atomicAdd(&bar[XB_TMO], 1u); break; } }
    }
    nloc = mine > 0u ? mine : 1u; nx = cnt > 0u ? cnt : 1u;
}
__device__ __forceinline__ void xcd_barrier(const XcdBarrier& b) {
    asm volatile("s_waitcnt vmcnt(0)" ::: "memory");
    __syncthreads();
    if (threadIdx.x == 0) {
        unsigned* bar = b.bar;
        __builtin_amdgcn_s_waitcnt(0);
        unsigned nloc = b.st[0], nx = b.st[1];
        if (nloc == 0u) { xcd_barrier_complete(bar, b.x, nloc, nx); b.st[0] = nloc; b.st[1] = nx; }
        const unsigned old = xb_add(&bar[XB_XSUB(b.x)], 1u);
        const unsigned gen = old / nloc;
        if (old + 1u == (gen + 1u) * nloc) {
            __builtin_amdgcn_fence(__ATOMIC_RELEASE, "agent");
            asm volatile("s_waitcnt vmcnt(0)" ::: "memory");
            const unsigned og = xb_add(&bar[XB_TOP], 1u);
            const unsigned tg = og / nx;
            if (og + 1u == (tg + 1u) * nx) xb_add(&bar[XB_TOPGEN], 1u);
            else XB_SPIN(xb_ld(&bar[XB_TOPGEN]) == tg, bar);
            __builtin_amdgcn_fence(__ATOMIC_ACQUIRE, "agent");
            xb_add(&bar[XB_XGEN(b.x)], 1u);
            asm volatile("s_waitcnt vmcnt(0)" ::: "memory");
        } else {
            XB_SPIN(xb_ld(&bar[XB_XGEN(b.x)]) == gen, bar);
            __builtin_amdgcn_fence(__ATOMIC_ACQUIRE, "agent");
            asm volatile("s_waitcnt vmcnt(0)" ::: "memory");
        }
    }
    __syncthreads();
}
constexpr int MISC_OFF = LDS_BYTES - 256;
constexpr size_t CTL_ZERO_BYTES = 64 * 1024;

struct Args { const float* in[23]; float* out; unsigned char* ws; int ph_lo, ph_hi; };

#ifndef ONLYMASK
#define ONLYMASK 0xffffffffu
#endif
#define EN(p) (((ONLYMASK) >> (p)) & 1u)
#ifndef REPMASK
#define REPMASK 0u
#endif
#define REP(p) (((REPMASK) >> (p)) & 1u)
enum Phase { PH_PREP = 0, PH_NORM1, PH_G1, PH_SPLIT1, PH_G2, PH_G3, PH_SPLIT2, PH_R1, PH_R2, PH_ATTN, PH_R3, PH_G4, PH_NORM2A, PH_G5, PH_CONVA, PH_G6,
             PH_RSTD, PH_POOL, PH_G7, PH_NORM2B, PH_G8, PH_CONVB, PH_G9, PH_FINAL, PH_COUNT };

__device__ __forceinline__ int map_col(int id, int n) {
    if (id == 0) return n;
    if (id == 1) { if (n < 2048) { const int j = n & 127; return (n & ~127) + (j >> 1) + (j & 1) * 64; } if (n < 4864) return n; if (n < INC) { const int j = n - 4864; return 4864 + (j >> 1) + (j & 1) * 32; } return -1; }
    if (id == 2) { if (n < 1024) return (n >> 7) * 192 + (n & 127); const int j = n - 1024, h = j >> 6, jj = j & 63; return h * 192 + 128 + (jj >> 1) + (jj & 1) * 32; }
    if (id == 3) { if (n < 1024) return (n >> 7) * 256 + (n & 127); const int j = n - 1024; return (j >> 7) * 256 + 128 + (j & 127); }
    return ((n >> 7) & 1) * FF + (n >> 8) * 128 + (n & 127);
}
__device__ __forceinline__ bool map_contig(int id, int n0) { return id == 1 ? (n0 >= 2048 && n0 + 32 <= 4864) : (id == 2 ? n0 < 1024 : true); }
struct TItem { const float* W; bf16_t* WT; const float* ks; int K, N, k0, n0, src; bool fast; };
__device__ __forceinline__ void titem_load(const TItem& t, f32x4 (&v)[8], int lane) {
    if (t.fast) { const int kr = lane >> 3, c4 = (lane & 7) * 4;
#pragma unroll
        for (int i = 0; i < 8; ++i) v[i] = __builtin_nontemporal_load((const f32x4*)(t.W + (size_t)(t.k0 + 8 * i + kr) * t.N + t.src + c4)); }
}
__device__ __forceinline__ void titem_process(const TItem& t, const f32x4 (&v)[8], LAS float* scr, int lane) {
    if (t.fast) { const int kr = lane >> 3, c4 = (lane & 7) * 4;
#pragma unroll
        for (int i = 0; i < 8; ++i) { f32x4 x = v[i]; if (t.ks) x *= t.ks[t.k0 + 8 * i + kr]; LAS float* d = scr + (8 * i + kr) * 33 + c4; d[0] = x.x; d[1] = x.y; d[2] = x.z; d[3] = x.w; }
    } else {
#pragma unroll 8
        for (int i = 0; i < 32; ++i) { const int kk = 2 * i + (lane >> 5); float x = 0.f; if (t.src >= 0) { x = t.W[(size_t)(t.k0 + kk) * t.N + t.src]; if (t.ks) x *= t.ks[t.k0 + kk]; } scr[kk * 33 + (lane & 31)] = x; }
    }
    asm volatile("s_waitcnt lgkmcnt(0)" ::: "memory");
    const int c = lane & 7;
#pragma unroll
    for (int j = 0; j < 4; ++j) { const int n = (lane >> 3) + 8 * j; const LAS float* sp = scr + (8 * c) * 33 + n;
        u32x4 o; o.x = pk2(sp[0 * 33], sp[1 * 33]); o.y = pk2(sp[2 * 33], sp[3 * 33]); o.z = pk2(sp[4 * 33], sp[5 * 33]); o.w = pk2(sp[6 * 33], sp[7 * 33]);
        *(u32x4*)(t.WT + (size_t)(t.n0 + n) * t.K + t.k0 + 8 * c) = o; }
    asm volatile("s_waitcnt lgkmcnt(0)" ::: "memory");
}


#define x_in (args.in[0])
#define c_in (args.in[1])
#define ctx_in (args.in[2])
#define cctx_in (args.in[3])
#define ada_w (args.in[4])
#define ada_b (args.in[5])
#define norm1_g (args.in[6])
#define norm2_g (args.in[7])
#define w_up (args.in[8])
#define conv_w (args.in[9])
#define conv_b (args.in[10])
#define w_down (args.in[11])
#define w_in (args.in[12])
#define qn_g (args.in[13])
#define w_uq (args.in[14])
#define kvn_g (args.in[15])
#define w_ukv (args.in[16])
#define dec_f (args.in[17])
#define dec_b (args.in[18])
#define w_out (args.in[19])
#define pool_w (args.in[20])
#define pool_scale (args.in[21])
#define final_g (args.in[22])
#define X (args.out)
#define ADA ((float*)(ws + WS_ADA))
#define RT128 ((f32x2*)(ws + WS_RT128))
#define RT64 ((f32x2*)(ws + WS_RT64))
#define RSTDQ ((float*)(ws + WS_RSTDQ))
#define RSTDKV ((float*)(ws + WS_RSTDKV))
#define RSTDX ((float*)(ws + WS_RSTDX))
#define WIN ((bf16_t*)(ws + WS_WIN))
#define WUQ ((bf16_t*)(ws + WS_WUQ))
#define WUKV ((bf16_t*)(ws + WS_WUKV))
#define WPOOL ((bf16_t*)(ws + WS_WPOOL))
#define WOUT ((bf16_t*)(ws + WS_WOUT))
#define WUP ((bf16_t*)(ws + WS_WUP))
#define WDN ((bf16_t*)(ws + WS_WDN))
#define H ((bf16_t*)(ws + WS_H))
#define XB2 ((bf16_t*)(ws + WS_MIX))
#define RQ ((bf16_t*)(ws + WS_RQ))
#define RK ((bf16_t*)(ws + WS_RK))
#define RV ((bf16_t*)(ws + WS_RV))
#define RG ((bf16_t*)(ws + WS_RG))
#define CQ ((bf16_t*)(ws + WS_CQ))
#define CKV ((bf16_t*)(ws + WS_CKV))
#define QN ((bf16_t*)(ws + WS_QN))
#define QR ((bf16_t*)(ws + WS_QR))
#define KN ((bf16_t*)(ws + WS_KN))
#define KR ((bf16_t*)(ws + WS_KR))
#define VC ((bf16_t*)(ws + WS_VC))
#define KVB ((bf16_t*)(ws + WS_KVB))
#define ST ((bf16_t*)(ws + WS_ST))
#define MIX ((bf16_t*)(ws + WS_MIX))
#define ACT ((bf16_t*)(ws + WS_ACT))
#define Z1 ((float*)(ws + WS_Z))
#define Z2 ((float*)(ws + WS_Z))
#define Z3 ((float*)(ws + WS_Z3))
#define U ((bf16_t*)(ws + WS_Z))
#define HALO ((float*)(ws + WS_Z))
#define XB ((bf16_t*)(ws + WS_XB))
#define PH_PARAMS const Args& args, unsigned char* ws, LAS unsigned char* lds, unsigned char* lds_raw, const int tid, const int lane, const int wave, const int bid, const int G, const int gw, const int NGW, const int ph
#define PH_CALL(p) args, ws, lds, lds_raw, tid, lane, wave, bid, G, gw, NGW, (p)
constexpr int CV_I0 = 32 * 160, CV_I1 = 8 * 48, CV_I2 = 4 * 64, CV_I3 = 32 * 64, CV_I4 = 32 * 352, CV_I6 = 88 * 64, CV_I8 = 8 * 16;
constexpr int CV_N0 = CV_I0 + CV_I1 + CV_I2 + CV_I3 + CV_I4 + CV_I6, CV_N1 = CV_I4 + CV_I6 + 4 * CV_I8;
__device__ __forceinline__ void convert_weights(PH_PARAMS, const int set, const int lo, const int hi, const int vw, const int nvw) {
    LAS float* scr = (LAS float*)(lds + wave * 16896);
    auto decode = [&](int it) -> TItem {
        TItem t; int r = it, nblk, id;
        if (set == 0) {
            if (r < CV_I0) { t.W = w_in; t.K = DM; t.N = INC; t.WT = WIN; t.ks = nullptr; nblk = 160; id = 1; }
            else if ((r -= CV_I0) < CV_I1) { t.W = w_uq; t.K = QRANK; t.N = 1536; t.WT = WUQ; t.ks = qn_g; nblk = 48; id = 2; }
            else if ((r -= CV_I1) < CV_I2) { t.W = w_ukv; t.K = KVRANK; t.N = 2048; t.WT = WUKV; t.ks = kvn_g; nblk = 64; id = 3; }
            else if ((r -= CV_I2) < CV_I3) { t.W = w_out; t.K = DM; t.N = DM; t.WT = WOUT; t.ks = nullptr; nblk = 64; id = 0; }
            else if ((r -= CV_I3) < CV_I4) { t.W = w_up; t.K = DM; t.N = FF2; t.WT = WUP; t.ks = nullptr; nblk = 352; id = 4; }
            else { r -= CV_I4; t.W = w_down; t.K = FF; t.N = DM; t.WT = WDN; t.ks = nullptr; nblk = 64; id = 0; }
        } else {
            if (r < CV_I4) { t.W = w_up + (size_t)DM * FF2; t.K = DM; t.N = FF2; t.WT = WUP + (size_t)FF2 * DM; t.ks = nullptr; nblk = 352; id = 4; }
            else if ((r -= CV_I4) < CV_I6) { t.W = w_down + (size_t)FF * DM; t.K = FF; t.N = DM; t.WT = WDN + (size_t)DM * FF; t.ks = nullptr; nblk = 64; id = 0; }
            else { r -= CV_I6; const int gi = r / CV_I8; r %= CV_I8; t.W = pool_w + (size_t)gi * 512 * 512; t.K = 512; t.N = 512; t.WT = WPOOL + (size_t)gi * 512 * 512; t.ks = nullptr; nblk = 16; id = 0; }
        }
        t.k0 = 64 * (r / nblk); t.n0 = 32 * (r % nblk); t.fast = map_contig(id, t.n0); t.src = map_col(id, t.fast ? t.n0 : t.n0 + (lane & 31));
        return t; };
    for (int it = lo + vw; it < hi; it += 2 * nvw) {
        const bool hb = it + nvw < hi;
        const TItem ta = decode(it), tb = decode(hb ? it + nvw : it);
        f32x4 va[8], vb[8];
        titem_load(ta, va, lane); if (hb) titem_load(tb, vb, lane);
        titem_process(ta, va, scr, lane); if (hb) titem_process(tb, vb, scr + 2112, lane);
    }
}

constexpr int CT_W_IN = 16 * 40, CT_W_UQ = 4 * 12, CT_W_UKV = 2 * 16, CT_W_OUT = 16 * 16, CT_W_UP = 16 * 88, CT_W_DN = 44 * 16, CT_POOL = 4 * 4;
constexpr int CT_N0 = CT_W_IN + CT_W_UQ + CT_W_UKV + CT_W_OUT + CT_W_UP + CT_W_DN, CT_N1 = CT_W_UP + CT_W_DN + 4 * CT_POOL;
struct CTile { const float* W; bf16_t* WT; const float* ks; int K, N, k0, n0, runA, runB, mode; };
__device__ __forceinline__ const float* ct_opaque(const float* p) { asm volatile("" : "+s"(p)); return p; }
__device__ __forceinline__ void ct_decode(const Args& args, unsigned char* ws, const int set, int r, CTile& t) {
    int ntn, nt, kt; t.ks = nullptr; t.mode = 0;
    if (set == 0 && r < CT_W_IN) { ntn = 40; kt = r / ntn; nt = r % ntn; t.W = ct_opaque(w_in); t.K = DM; t.N = INC; t.WT = WIN;
        if (nt < 16) { t.runA = nt * 128; t.runB = t.runA + 64; t.mode = 1; } else if (nt < 38) { t.runA = nt * 128; t.runB = t.runA + 64; } else if (nt == 38) { t.runA = 4864; t.runB = -1; t.mode = 2; } else { t.runA = -1; t.runB = -1; } }
    else if (set == 0 && (r -= CT_W_IN) < CT_W_UQ) { ntn = 12; kt = r / ntn; nt = r % ntn; t.W = ct_opaque(w_uq); t.K = QRANK; t.N = 1536; t.WT = WUQ; t.ks = qn_g;
        if (nt < 8) { t.runA = nt * 192; t.runB = t.runA + 64; } else { const int h0 = 2 * (nt - 8); t.runA = h0 * 192 + 128; t.runB = (h0 + 1) * 192 + 128; t.mode = 2; } }
    else if (set == 0 && (r -= CT_W_UQ) < CT_W_UKV) { ntn = 16; kt = r / ntn; nt = r % ntn; t.W = ct_opaque(w_ukv); t.K = KVRANK; t.N = 2048; t.WT = WUKV; t.ks = kvn_g;
        t.runA = nt < 8 ? nt * 256 : (nt - 8) * 256 + 128; t.runB = t.runA + 64; }
    else if (set == 0 && (r -= CT_W_UKV) < CT_W_OUT) { ntn = 16; kt = r / ntn; nt = r % ntn; t.W = ct_opaque(w_out); t.K = DM; t.N = DM; t.WT = WOUT; t.runA = nt * 128; t.runB = t.runA + 64; }
    else if (set == 0 ? (r -= CT_W_OUT) < CT_W_UP : r < CT_W_UP) { ntn = 88; kt = r / ntn; nt = r % ntn; const int l = set; t.W = ct_opaque(w_up + (size_t)l * DM * FF2); t.K = DM; t.N = FF2; t.WT = WUP + (size_t)l * FF2 * DM;
        t.runA = (nt & 1) * FF + (nt >> 1) * 128; t.runB = t.runA + 64; }
    else if ((r -= CT_W_UP) < CT_W_DN) { ntn = 16; kt = r / ntn; nt = r % ntn; const int l = set; t.W = ct_opaque(w_down + (size_t)l * FF * DM); t.K = FF; t.N = DM; t.WT = WDN + (size_t)l * DM * FF; t.runA = nt * 128; t.runB = t.runA + 64; }
    else { r -= CT_W_DN; const int gi = r / CT_POOL; r %= CT_POOL; ntn = 4; kt = r / ntn; nt = r % ntn; t.W = ct_opaque(pool_w + (size_t)gi * 512 * 512); t.K = 512; t.N = 512; t.WT = WPOOL + (size_t)gi * 512 * 512; t.runA = nt * 128; t.runB = t.runA + 64; }
    t.k0 = kt * 128; t.n0 = nt * 128;
}
__device__ __forceinline__ void ct_load(const CTile& t, f32x4 (&v)[8], const int wave, const int lane) {
    const int c = (lane & 31) * 4, run = c < 64 ? t.runA : t.runB;
    if (t.runA < 0 && t.runB < 0) {
#pragma unroll
        for (int i = 0; i < 8; ++i) v[i] = (f32x4){0.f, 0.f, 0.f, 0.f};
        return; }
    const int runc = run >= 0 ? run : t.runA;
    const float* p = t.W + (size_t)(t.k0 + wave * 16 + (lane >> 5)) * t.N + runc + (c & 63);
#pragma unroll
    for (int i = 0; i < 8; ++i) v[i] = __builtin_nontemporal_load((const f32x4*)(p + (size_t)(2 * i) * t.N));
    if (run < 0) {
#pragma unroll
        for (int i = 0; i < 8; ++i) v[i] = (f32x4){0.f, 0.f, 0.f, 0.f}; }
}
__device__ __forceinline__ void ct_put(const CTile& t, const f32x4 (&v)[8], LAS float* T, const int wave, const int lane) {
    const int c = (lane & 31) * 4, row0 = wave * 16 + (lane >> 5);
#pragma unroll
    for (int i = 0; i < 8; ++i) { f32x4 x = v[i]; const int row = row0 + 2 * i; if (t.ks) x *= t.ks[t.k0 + row]; LAS float* d = T + row * 129 + c; d[0] = x.x; d[1] = x.y; d[2] = x.z; d[3] = x.w; }
}
__device__ __forceinline__ void ct_store(const CTile& t, const LAS float* T, const int wave, const int lane) {
    const int c8 = lane & 7;
#pragma unroll
    for (int j = 0; j < 4; ++j) { const int half = j & 1, n = wave * 16 + (j >> 1) * 8 + (lane >> 3), kk0 = half * 64 + c8 * 8;
        const int lc = t.mode == 0 ? n : (t.mode == 1 ? (n >> 1) + (n & 1) * 64 : (n & 64) + ((n & 63) >> 1) + (n & 1) * 32);
        const LAS float* sp = T + kk0 * 129 + lc;
        u32x4 o; o.x = pk2(sp[0 * 129], sp[1 * 129]); o.y = pk2(sp[2 * 129], sp[3 * 129]); o.z = pk2(sp[4 * 129], sp[5 * 129]); o.w = pk2(sp[6 * 129], sp[7 * 129]);
        *(u32x4*)(t.WT + (size_t)(t.n0 + n) * t.K + t.k0 + kk0) = o; }
}
__device__ __forceinline__ void convert_tiles2(PH_PARAMS, const int set, const int lo1, const int hi1, const int lo2, const int hi2, const int vb, const int nvb) {
    const int n1 = hi1 - lo1, hi = n1 + (hi2 - lo2), lo = 0;
#define CT_IDX(v) ((v) < n1 ? lo1 + (v) : lo2 + ((v) - n1))
    LAS float* T0 = (LAS float*)lds; LAS float* T1 = (LAS float*)(lds + 66048);
    const int it = lo + vb; if (it >= hi) return;
    CTile tc, ta, tb; f32x4 vA[8], vB[8];
    ct_decode(args, ws, set, CT_IDX(it), tc); ct_load(tc, vA, wave, lane);
    __syncthreads();
    ct_put(tc, vA, T0, wave, lane);
    bool hasA = it + nvb < hi, hasB = it + 2 * nvb < hi; ta = tc; tb = tc;
    if (hasA) { ct_decode(args, ws, set, CT_IDX(it + nvb), ta); ct_load(ta, vA, wave, lane); }
    if (hasB) { ct_decode(args, ws, set, CT_IDX(it + 2 * nvb), tb); ct_load(tb, vB, wave, lane); }
    __syncthreads();
    int nx = it + 3 * nvb, cur = 0;
    for (;;) {
        ct_store(tc, cur ? T1 : T0, wave, lane);
        if (!hasA) break;
        ct_put(ta, vA, cur ? T0 : T1, wave, lane); tc = ta;
        hasA = hasB && nx < hi;
        if (hasA) { ct_decode(args, ws, set, CT_IDX(nx), ta); ct_load(ta, vA, wave, lane); }
        nx += nvb;
        __syncthreads(); cur ^= 1;
        ct_store(tc, cur ? T1 : T0, wave, lane);
        if (!hasB) break;
        ct_put(tb, vB, cur ? T0 : T1, wave, lane); tc = tb;
        hasB = hasA && nx < hi;
        if (hasB) { ct_decode(args, ws, set, CT_IDX(nx), tb); ct_load(tb, vB, wave, lane); }
        nx += nvb;
        __syncthreads(); cur ^= 1;
    }
    __syncthreads();
}
#undef CT_IDX
__device__ __forceinline__ void convert_tiles(PH_PARAMS, const int set, const int lo, const int hi, const int vb, const int nvb) { convert_tiles2(PH_CALL(ph), set, lo, hi, 0, 0, vb, nvb); }
__device__ __forceinline__ void ada_items(PH_PARAMS, const int l, const int vb, const int nvb) {
        {
            LAS float* sil = (LAS float*)lds; LAS float* red = (LAS float*)(lds + 5 * 2048 * 4);
            for (int i = tid; i < 5 * 2048; i += 512) { const int r = i >> 11, k = i & 2047; const float v = r < 4 ? c_in[r * 2048 + k] : cctx_in[k]; sil[i] = v / (1.f + expf(-v)); }
            __syncthreads();
            for (int item = vb; item < 128; item += nvb) {
                const int n0 = item * 96, kq = lane >> 3, c4 = (lane & 7) * 4;
                const float* Wp = ada_w + (size_t)l * DM * NADA + n0 + c4;
                f32x4 a[5][3];
#pragma unroll
                for (int r = 0; r < 5; ++r)
#pragma unroll
                    for (int j = 0; j < 3; ++j) a[r][j] = (f32x4){0.f, 0.f, 0.f, 0.f};
                const int kbeg = wave * 256 + kq;
                const float* wp = Wp + (size_t)kbeg * NADA; const LAS float* sp = sil + kbeg;
#define ADA_LOAD(W) do { _Pragma("unroll") for (int u = 0; u < 4; ++u) _Pragma("unroll") for (int j = 0; j < 3; ++j) W[u][j] = __builtin_nontemporal_load((const f32x4*)(wp + (size_t)(8 * u) * NADA + 32 * j)); wp += (size_t)32 * NADA; } while (0)
#define ADA_FMA(W) do { _Pragma("unroll") for (int u = 0; u < 4; ++u) _Pragma("unroll") for (int r = 0; r < 5; ++r) { const float sv = sp[r * 2048 + 8 * u]; \
                        _Pragma("unroll") for (int j = 0; j < 3; ++j) a[r][j] += W[u][j] * sv; } sp += 32; } while (0)
                f32x4 wv0[4][3], wv1[4][3];
                ADA_LOAD(wv0);
#pragma unroll 1
                for (int kk = 0; kk < 8; kk += 2) {
                    ADA_LOAD(wv1);
                    ADA_FMA(wv0);
                    if (kk + 2 < 8) ADA_LOAD(wv0);
                    ADA_FMA(wv1);
                }
#undef ADA_LOAD
#undef ADA_FMA
#pragma unroll
                for (int r = 0; r < 5; ++r)
#pragma unroll
                    for (int j = 0; j < 3; ++j) {
#pragma unroll
                        for (int q = 0; q < 4; ++q) { float v = a[r][j][q]; v += __shfl_xor(v, 8); v += __shfl_xor(v, 16); v += __shfl_xor(v, 32); a[r][j][q] = v; }
                        if (kq == 0) *(LAS f32x4*)(red + (wave * 5 + r) * 96 + 32 * j + c4) = a[r][j]; }
                __syncthreads();
                if (tid < 5 * 96) { const int r = tid / 96, j = tid % 96; float sum = ada_b[l * NADA + n0 + j];
#pragma unroll
                    for (int w = 0; w < 8; ++w) sum += red[(w * 5 + r) * 96 + j];
                    ADA[(size_t)(l * 5 + r) * NADA + n0 + j] = sum; }
                __syncthreads();
            }
            __syncthreads();
        }
}
__device__ __forceinline__ void phase_PREP(PH_PARAMS) {
        if (G == 256) ada_items(PH_CALL(ph), bid >> 7, bid & 127, 128);
        else { ada_items(PH_CALL(ph), 0, bid, G); __syncthreads(); ada_items(PH_CALL(ph), 1, bid, G); }
        asm volatile("s_waitcnt vmcnt(0)" ::: "memory"); __syncthreads();
        if (tid == 0) { __builtin_amdgcn_fence(__ATOMIC_RELEASE, "agent"); asm volatile("s_waitcnt vmcnt(0)" ::: "memory"); __hip_atomic_fetch_add((unsigned*)(ws + WS_CTL + 49152), 1u, __ATOMIC_RELAXED, __HIP_MEMORY_SCOPE_AGENT); }
    for (int i = bid * 512 + tid; i < 32768 + 8192; i += G * 512) ((float*)(ws + WS_RSTDQ))[i] = 0.f;
        for (int i = bid * 512 + tid; i < 2048 * 96; i += G * 512) {
            const int t = i / 96, e = i % 96; const float row = (float)(t >> 6), col = (float)(t & 63);
            float s, c;
            if (e < 64) { const int nf = 32; const int j = e < nf ? e : e - nf; const float inv = exp2f(-(float)j / (float)nf * 13.287712379549449f); const float ang = (e < nf ? row : col) * inv;
                sincos_acc(ang, s, c); RT128[t * 64 + e] = (f32x2){c, s}; }
            else { const int e2 = e - 64; const int nf = 16; const int j = e2 < nf ? e2 : e2 - nf; const float inv = exp2f(-(float)j / (float)nf * 13.287712379549449f); const float ang = (e2 < nf ? row : col) * inv;
                sincos_acc(ang, s, c); RT64[t * 32 + e2] = (f32x2){c, s}; }
        }
        if (G == 256) convert_tiles(PH_CALL(ph), 0, 0, CT_N0 - CT_W_DN, bid, G);
        else convert_tiles(PH_CALL(ph), 0, 0, CT_N0, bid, G);
        if (tid == 0) { unsigned spins = 0; while (__hip_atomic_load((unsigned*)(ws + WS_CTL + 49152), __ATOMIC_RELAXED, __HIP_MEMORY_SCOPE_AGENT) < (unsigned)G) { __builtin_amdgcn_s_sleep(2); if (++spins > (1u << 20)) break; }
            __builtin_amdgcn_fence(__ATOMIC_ACQUIRE, "agent"); asm volatile("s_waitcnt vmcnt(0)" ::: "memory"); }
        __syncthreads();
}
__device__ __forceinline__ void phase_NORM(PH_PARAMS) {
        const int l = (ph == PH_NORM2B); const int nrows = (ph == PH_NORM1) ? MALL : MLAT;
        const float* gvec = (ph == PH_NORM1 ? norm1_g : norm2_g) + l * DM;
        const int shc = (ph == PH_NORM1) ? 0 : 3;
        LAS float* gm = (LAS float*)lds; LAS float* sm = gm + 5 * DM;
        for (int i = tid; i < 5 * DM / 4; i += 512) { const int r = i / (DM / 4), c = (i % (DM / 4)) * 4;
            const float* sh = ADA + (size_t)(l * 5 + r) * NADA + shc * DM; const float* sc = sh + DM;
            *(LAS f32x4*)(gm + r * DM + c) = *(const f32x4*)(gvec + c) * (*(const f32x4*)(sc + c) + 1.0f); *(LAS f32x4*)(sm + r * DM + c) = *(const f32x4*)(sh + c); }
        __syncthreads();
#define NORM_ROW(m_) ((ph == PH_NORM1) ? ((m_) < MLAT ? x_in + (size_t)(m_) * DM : ctx_in + (size_t)((m_) - MLAT) * DM) : X + (size_t)(m_) * DM)
        int m = gw; if (m >= nrows) return;
        f32x4 v[8], vn[8];
        { const float* xrow = NORM_ROW(m);
#pragma unroll
          for (int j = 0; j < 8; ++j) v[j] = ((const f32x4*)xrow)[lane + 64 * j]; }
        for (;;) {
            const int mn = m + NGW; const bool more = mn < nrows;
            if (more) { const float* xn = NORM_ROW(mn);
#pragma unroll
                for (int j = 0; j < 8; ++j) vn[j] = ((const f32x4*)xn)[lane + 64 * j]; }
            const int r = (ph == PH_NORM1 && m >= MLAT) ? 4 : (m >> 11);
            float ss = 0.f;
#pragma unroll
            for (int j = 0; j < 8; ++j) ss += (v[j].x * v[j].x + v[j].y * v[j].y) + (v[j].z * v[j].z + v[j].w * v[j].w);
            const float rstd = 1.0f / sqrtf(wave_sum(ss) * (1.0f / DM) + EPS);
            bf16_t* orow = H + (size_t)m * DM;
#pragma unroll
            for (int j = 0; j < 8; ++j) { const int idx = 4 * (lane + 64 * j);
                const f32x4 y = (v[j] * rstd) * *(const LAS f32x4*)(gm + r * DM + idx) + *(const LAS f32x4*)(sm + r * DM + idx);
                u32x2 w; w.x = pk2(y.x, y.y); w.y = pk2(y.z, y.w); *(u32x2*)(orow + idx) = w; }
            if (!more) break;
#pragma unroll
            for (int j = 0; j < 8; ++j) v[j] = vn[j];
            m = mn;
        }
#undef NORM_ROW
}
__device__ __forceinline__ void phase_FINAL(PH_PARAMS) {
        for (int m = gw; m < MLAT; m += NGW) {
            float* xrow = X + (size_t)m * DM; f32x4 v[8]; float ss = 0.f;
#pragma unroll
            for (int j = 0; j < 8; ++j) { v[j] = ((const f32x4*)xrow)[lane + 64 * j]; ss += (v[j].x * v[j].x + v[j].y * v[j].y) + (v[j].z * v[j].z + v[j].w * v[j].w); }
            const float rstd = 1.0f / sqrtf(wave_sum(ss) * (1.0f / DM) + EPS);
#pragma unroll
            for (int j = 0; j < 8; ++j) { const int idx = 4 * (lane + 64 * j); const f32x4 gg = *(const f32x4*)(final_g + idx); ((f32x4*)xrow)[lane + 64 * j] = v[j] * rstd * gg; }
        }
}
__device__ __forceinline__ void phase_R1(PH_PARAMS) {
        char* ldsg = (char*)lds_raw;
        const int r32 = lane & 31, hi = lane >> 5;
        const int sr = tid >> 4, sc = (tid & 15) * 8;
        u32x4 kq[2][2], vq[2][2];
#define R1_LOAD(item_) do { const int bh_ = (item_) / NCHUNK, ci_ = (item_) % NCHUNK; const int key0_ = ci_ < 2 ? ci_ * 128 : CTX + (ci_ - 2) * 128; \
            const bf16_t* Kp_ = RK + ((size_t)bh_ * NKEY + key0_) * HD; const bf16_t* Vp_ = RV + ((size_t)bh_ * NKEY + key0_) * HD; \
            _Pragma("unroll") for (int tl = 0; tl < 2; ++tl) _Pragma("unroll") for (int hh = 0; hh < 2; ++hh) { const int m_ = 64 * tl + 32 * hh + sr; \
                kq[tl][hh] = *(const u32x4*)(Kp_ + (size_t)m_ * HD + sc); vq[tl][hh] = *(const u32x4*)(Vp_ + (size_t)m_ * HD + sc); } } while (0)
        if (bid < 32 * NCHUNK) R1_LOAD(bid);
        for (int item = bid; item < 32 * NCHUNK; item += G) {
            const int bh = item / NCHUNK, ci = item % NCHUNK, h = bh & 7;
            const float xf = dec_f[h], xb = dec_b[h];
            const float lf2 = -log1pf(expf(-xf)) * 1.4426950408889634f, lb2 = -log1pf(expf(-xb)) * 1.4426950408889634f;
#pragma unroll
            for (int tl = 0; tl < 2; ++tl)
#pragma unroll
                for (int hh = 0; hh < 2; ++hh) { const int row = 32 * hh + sr, m = 64 * tl + row;
                    const u32x4 kv = kq[tl][hh]; const u32x4 vv = vq[tl][hh];
                    const float ff = __builtin_amdgcn_exp2f((float)(127 - m) * lf2), fb = __builtin_amdgcn_exp2f((float)m * lb2);
                    u32x4 vf, vb;
                    vf.x = pk2(bflo(vv.x) * ff, bfhi(vv.x) * ff); vf.y = pk2(bflo(vv.y) * ff, bfhi(vv.y) * ff); vf.z = pk2(bflo(vv.z) * ff, bfhi(vv.z) * ff); vf.w = pk2(bflo(vv.w) * ff, bfhi(vv.w) * ff);
                    vb.x = pk2(bflo(vv.x) * fb, bfhi(vv.x) * fb); vb.y = pk2(bflo(vv.y) * fb, bfhi(vv.y) * fb); vb.z = pk2(bflo(vv.z) * fb, bfhi(vv.z) * fb); vb.w = pk2(bflo(vv.w) * fb, bfhi(vv.w) * fb);
                    const int o = att::v_st(row, sc);
                    *(u32x4*)(ldsg + tl * 16384 + o) = kv; *(u32x4*)(ldsg + 32768 + tl * 16384 + o) = vf; *(u32x4*)(ldsg + 65536 + tl * 16384 + o) = vb; }
            LDS_BAR();
            if (item + G < 32 * NCHUNK) R1_LOAD(item + G);
            const int D0 = wave & 3, eh = wave >> 2;
            const int base = (int)(uintptr_t)ldsg + att::v_rd_base(lane);
            const int kb = base + D0 * 512, fb0 = base + 32768 + (2 * eh) * 512, bb0 = base + 65536 + (2 * eh) * 512;
            f32x16 af0 = {}, af1 = {}, ab0 = {}, ab1 = {};
#define R1_STEP(TL, KS) do { const int off_ = (TL) * 16384; \
                const s16x4 kl = att::tr_read<att::v_rd_off(0, KS, 0)>(kb + off_), kh = att::tr_read<att::v_rd_off(0, KS, 1)>(kb + off_); \
                const s16x4 f0l = att::tr_read<att::v_rd_off(0, KS, 0)>(fb0 + off_), f0h = att::tr_read<att::v_rd_off(0, KS, 1)>(fb0 + off_); \
                const s16x4 f1l = att::tr_read<att::v_rd_off(1, KS, 0)>(fb0 + off_), f1h = att::tr_read<att::v_rd_off(1, KS, 1)>(fb0 + off_); \
                const s16x4 b0l = att::tr_read<att::v_rd_off(0, KS, 0)>(bb0 + off_), b0h = att::tr_read<att::v_rd_off(0, KS, 1)>(bb0 + off_); \
                const s16x4 b1l = att::tr_read<att::v_rd_off(1, KS, 0)>(bb0 + off_), b1h = att::tr_read<att::v_rd_off(1, KS, 1)>(bb0 + off_); \
                asm volatile("s_waitcnt lgkmcnt(0)" ::: "memory"); SBAR(); \
                const bf16x8 ka = PKLH(kl, kh); \
                af0 = __builtin_amdgcn_mfma_f32_32x32x16_bf16(ka, PKLH(f0l, f0h), af0, 0, 0, 0); af1 = __builtin_amdgcn_mfma_f32_32x32x16_bf16(ka, PKLH(f1l, f1h), af1, 0, 0, 0); \
                ab0 = __builtin_amdgcn_mfma_f32_32x32x16_bf16(ka, PKLH(b0l, b0h), ab0, 0, 0, 0); ab1 = __builtin_amdgcn_mfma_f32_32x32x16_bf16(ka, PKLH(b1l, b1h), ab1, 0, 0, 0); } while (0)
            R1_STEP(0, 0); R1_STEP(0, 1); R1_STEP(0, 2); R1_STEP(0, 3); R1_STEP(1, 0); R1_STEP(1, 1); R1_STEP(1, 2); R1_STEP(1, 3);
#undef R1_STEP
            LDS_BAR();
            { char* OT = ldsg + wave * 17408;
#pragma unroll
              for (int r = 0; r < 16; ++r) { const int rr = att::crow(r, hi);
                  *(float*)(OT + rr * 272 + r32 * 4) = af0[r]; *(float*)(OT + rr * 272 + (32 + r32) * 4) = af1[r];
                  *(float*)(OT + 8704 + rr * 272 + r32 * 4) = ab0[r]; *(float*)(OT + 8704 + rr * 272 + (32 + r32) * 4) = ab1[r]; }
              asm volatile("s_waitcnt lgkmcnt(0)" ::: "memory");
              bf16_t* of = KVB + ((size_t)(bh * NCHUNK + ci) * 2 + 0) * 16384 + (size_t)(32 * D0) * 128 + 64 * eh;
#pragma unroll
              for (int dir = 0; dir < 2; ++dir)
#pragma unroll
                  for (int i = 0; i < 8; ++i) { const int row = i * 4 + (lane >> 4), ch = lane & 15;
                      stbf4(of + (size_t)dir * 16384 + row * 128 + ch * 4, *(const f32x4*)(OT + dir * 8704 + row * 272 + ch * 16)); } }
            LDS_BAR();
        }
}
#undef R1_LOAD
__device__ __forceinline__ void phase_R2(PH_PARAMS) {
        for (int it = bid * 512 + tid; it < 64 * 4096; it += G * 512) {
            const int e4 = it & 4095, dir = (it >> 12) & 1, bh = it >> 13, h = bh & 7;
            const float xd = dir ? dec_b[h] : dec_f[h]; const float g128 = expf(128.f * -log1pf(expf(-xd)));
            const bf16_t* kv = KVB + ((size_t)bh * NCHUNK * 2 + dir) * 16384 + 4 * e4;
            bf16_t* st = ST + ((size_t)bh * 16 * 2 + dir) * 16384 + 4 * e4;
            u32x2 a[17];
#pragma unroll
            for (int i = 0; i < 17; ++i) { const int ci = dir == 0 ? i : (i == 0 ? 1 : (i == 1 ? 0 : 19 - i)); a[i] = *(const u32x2*)(kv + (size_t)ci * 32768); }
#define BF4(w) ((f32x4){bflo((w).x), bfhi((w).x), bflo((w).y), bfhi((w).y)})
            f32x4 S = BF4(a[0]) * g128 + BF4(a[1]);
#pragma unroll
            for (int k = 0; k < 16; ++k) { const int c = dir == 0 ? k : 15 - k; stbf4(st + (size_t)c * 32768, S);
                if (k < 15) S = S * g128 + BF4(a[2 + k]); }
#undef BF4
        }
}
__device__ __forceinline__ void phase_ATTN(PH_PARAMS) {
        for (int item = bid; item < 256; item += G) {
            const int xcd = item & 7, slot = item >> 3, bh = xcd * 4 + (slot >> 3), qb = slot & 7, b = bh >> 3, h = bh & 7;
            att::mla_body(QN + ((size_t)bh * SEQ + qb * 256) * HD, QR + ((size_t)bh * SEQ + qb * 256) * DR, KN + (size_t)bh * NKEY * HD, KR + (size_t)b * NKEY * DR, VC + (size_t)bh * NKEY * HD,
                          MIX + ((size_t)(b * SEQ + qb * 256)) * DM + 1024 + h * HD, DM, NKEY, (char*)lds_raw, tid);
            __syncthreads();
        }
}
__device__ __forceinline__ void phase_R3(PH_PARAMS) {
        char* ldsg = (char*)lds_raw;
        const int r32 = lane & 31, hi = lane >> 5;
        const int sr = tid >> 4, sc = (tid & 15) * 8;
        float* part = (float*)(ldsg + 131072);
        for (int item = bid; item < 32 * 16; item += G) {
            const int bh = item >> 4, c = item & 15, b = bh >> 3, h = bh & 7;
            const float xf = dec_f[h], xb = dec_b[h];
            const float lf2 = -log1pf(expf(-xf)) * 1.4426950408889634f, lb2 = -log1pf(expf(-xb)) * 1.4426950408889634f;
            const bf16_t* Kp = RK + ((size_t)bh * NKEY + CTX + c * 128) * HD; const bf16_t* Vp = RV + ((size_t)bh * NKEY + CTX + c * 128) * HD;
            const bf16_t* Sp = ST + (size_t)(bh * 16 + c) * 32768;
            { u32x4 t0[4], t1[4];
#pragma unroll
              for (int q = 0; q < 4; ++q) { const int tl = q >> 1, hh = q & 1; const int row = 32 * hh + sr, m = 64 * tl + row;
                  t0[q] = *(const u32x4*)(Kp + (size_t)m * HD + sc); t1[q] = *(const u32x4*)(Vp + (size_t)m * HD + sc); }
#pragma unroll
              for (int q = 0; q < 4; ++q) { const int tl = q >> 1, hh = q & 1; const int row = 32 * hh + sr;
                  *(u32x4*)(ldsg + tl * 16384 + KSWZ(row, sc * 2)) = t0[q]; *(u32x4*)(ldsg + 32768 + tl * 16384 + att::v_st(row, sc)) = t1[q]; }
              asm volatile("" ::: "memory");
#pragma unroll
              for (int q = 0; q < 8; ++q) { const int tl = q >> 1, hh = q & 1; const int row = 32 * hh + sr, m = 64 * tl + row;
                  if (q < 4) t0[q] = *(const u32x4*)(Sp + (size_t)m * 128 + sc); else t1[q - 4] = *(const u32x4*)(Sp + (size_t)m * 128 + sc); }
#pragma unroll
              for (int q = 0; q < 8; ++q) { const int tl = q >> 1, hh = q & 1; const int row = 32 * hh + sr;
                  *(u32x4*)(ldsg + 65536 + tl * 16384 + att::v_st(row, sc)) = (q < 4) ? t0[q] : t1[q - 4]; }
              asm volatile("" ::: "memory"); }
            const int qw = wave & 3, ch = wave >> 2; int n = 32 * qw + r32;
            asm volatile("" : "+v"(n));
            bf16x8 qr[8];
            { const bf16_t* Qw = RQ + ((size_t)bh * SEQ + c * 128 + n) * HD + hi * 8;
#pragma unroll
              for (int d0 = 0; d0 < 8; ++d0) qr[d0] = *reinterpret_cast<const bf16x8*>(Qw + d0 * 16); }
            __syncthreads();
            f32x16 o0 = {}, o1 = {};
            const int vb = (int)(uintptr_t)ldsg + att::v_rd_base(lane);
#pragma unroll
            for (int tl = 0; tl < 2; ++tl) {
                f32x16 p0 = {}, p1 = {};
                att::qkt128(p0, p1, ldsg + tl * 16384, qr, r32, hi);
#pragma unroll
                for (int r = 0; r < 16; ++r) { const float d0f = (float)(n - (64 * tl + att::crow(r, hi))), d1f = d0f - 32.f;
                    p0[r] *= __builtin_amdgcn_exp2f(fmaxf(d0f, 0.f) * lf2 + fmaxf(-d0f, 0.f) * lb2);
                    p1[r] *= __builtin_amdgcn_exp2f(fmaxf(d1f, 0.f) * lf2 + fmaxf(-d1f, 0.f) * lb2); }
                bf16x8 pa0, pa1, pa2, pa3;
                PK4(p0, 0, pa0); PK4(p0, 8, pa1); PK4(p1, 0, pa2); PK4(p1, 8, pa3);
                const int vt = vb + 32768 + tl * 16384;
                if (ch == 0) { att::pv_one<0>(o0, vt, pa0, pa1, pa2, pa3); att::pv_one<1>(o1, vt, pa0, pa1, pa2, pa3); }
                else { att::pv_one<2>(o0, vt, pa0, pa1, pa2, pa3); att::pv_one<3>(o1, vt, pa0, pa1, pa2, pa3); }
            }
#pragma unroll 1
            for (int dir = 0; dir < 2; ++dir) {
                const float sf = __builtin_amdgcn_exp2f(dir == 0 ? (float)(n + 1) * lf2 : (float)(128 - n) * lb2);
#pragma unroll
                for (int kt = 0; kt < 2; ++kt) {
                    bf16x8 qs[4];
#pragma unroll
                    for (int d0 = 0; d0 < 4; ++d0) { const u32x4 w = *reinterpret_cast<const u32x4*>(&qr[4 * kt + d0]); u32x4 o;
                        o.x = cvtpk(bflo(w.x) * sf, bfhi(w.x) * sf); o.y = cvtpk(bflo(w.y) * sf, bfhi(w.y) * sf); o.z = cvtpk(bflo(w.z) * sf, bfhi(w.z) * sf); o.w = cvtpk(bflo(w.w) * sf, bfhi(w.w) * sf);
                        qs[d0] = *reinterpret_cast<const bf16x8*>(&o); }
                    const int vt = vb + 65536 + (dir * 2 + kt) * 16384;
                    if (ch == 0) { att::pv_one<0>(o0, vt, qs[0], qs[1], qs[2], qs[3]); att::pv_one<1>(o1, vt, qs[0], qs[1], qs[2], qs[3]); }
                    else { att::pv_one<2>(o0, vt, qs[0], qs[1], qs[2], qs[3]); att::pv_one<3>(o1, vt, qs[0], qs[1], qs[2], qs[3]); } }
            }
            float sq[16];
#pragma unroll
            for (int r = 0; r < 16; ++r) { float v = o0[r] * o0[r] + o1[r] * o1[r];
                v += __shfl_xor(v, 1); v += __shfl_xor(v, 2); v += __shfl_xor(v, 4); v += __shfl_xor(v, 8); v += __shfl_xor(v, 16); sq[r] = v; }
            if (r32 == 0) {
#pragma unroll
                for (int r = 0; r < 16; ++r) part[ch * 128 + 32 * qw + att::crow(r, hi)] = sq[r]; }
            __syncthreads();
            { float* OT = (float*)ldsg;
              float* OTb = OT + (32 * qw + 4 * hi) * 132 + 64 * ch + r32; const float* pb = part + 32 * qw + 4 * hi;
              asm volatile("" : "+v"(OTb), "+v"(pb));
#pragma unroll
              for (int r = 0; r < 16; ++r) { const int rc = (r & 3) + 8 * (r >> 2); const float tot = pb[rc] + pb[128 + rc];
                  const float rn = 1.0f / sqrtf(tot * (1.0f / 128.f) + EPS);
                  OTb[rc * 132] = o0[r] * rn; OTb[rc * 132 + 32] = o1[r] * rn; }
              __syncthreads();
              const int orow = tid >> 2, oc0 = (tid & 3) * 32; const size_t grow = (size_t)b * SEQ + c * 128 + orow;
              const bf16_t* gp = RG + grow * 1024 + h * HD + oc0; bf16_t* mp = MIX + grow * DM + h * HD + oc0; const float* op = OT + orow * 132 + oc0;
#pragma unroll
              for (int q = 0; q < 4; ++q) { const u32x4 gw4 = *(const u32x4*)(gp + 8 * q); const f32x4 a = *(const f32x4*)(op + 8 * q), bq = *(const f32x4*)(op + 8 * q + 4);
                  u32x4 w; w.x = pk2(a.x * silu_f(bflo(gw4.x)), a.y * silu_f(bfhi(gw4.x))); w.y = pk2(a.z * silu_f(bflo(gw4.y)), a.w * silu_f(bfhi(gw4.y)));
                  w.z = pk2(bq.x * silu_f(bflo(gw4.z)), bq.y * silu_f(bfhi(gw4.z))); w.w = pk2(bq.z * silu_f(bflo(gw4.w)), bq.w * silu_f(bfhi(gw4.w)));
                  *(u32x4*)(mp + 8 * q) = w; } }
            __syncthreads();
        }
}
__device__ __forceinline__ void phase_POOL(PH_PARAMS) {
    LAS float* Y = (LAS float*)lds;
    const float* gvec = norm1_g + DM; const float* ssq = RSTDX;
    const int c4 = (tid & 63) * 4, rg = tid >> 6;
    u32x2 raw[10]; float q[10]; f32x4 g0, g1;
#define POOL_LOAD(item_) do { const int tt_ = (item_) >> 3, cb_ = (item_) & 7, b_ = tt_ >> 5, t0_ = (tt_ & 31) * 64; \
        _Pragma("unroll") for (int i = 0; i < 10; ++i) { const int t_ = t0_ - 8 + i * 8 + rg; raw[i] = (u32x2){0u, 0u}; q[i] = 1.0f; \
            if (t_ >= 0 && t_ < SEQ) { const size_t row_ = (size_t)b_ * SEQ + t_; raw[i] = *(const u32x2*)(XB + row_ * DM + cb_ * 256 + c4); q[i] = ssq[row_]; } } \
        g0 = *(const f32x4*)(gvec + cb_ * 256 + c4); g1 = *(const f32x4*)(ADA + (size_t)(5 + b_) * NADA + DM + cb_ * 256 + c4); } while (0)
    int item = bid; if (item >= 1024) return;
    POOL_LOAD(item);
    for (;;) {
        const int tt = item >> 3, cb = item & 7, b = tt >> 5, t0 = (tt & 31) * 64, gi = cb >> 1, hw = 1 << gi;
#pragma unroll
        for (int i = 0; i < 10; ++i) { const int lr = i * 8 + rg; const float rs = 1.0f / sqrtf(q[i] * (1.0f / DM) + EPS);
            *(LAS f32x4*)(Y + lr * 256 + c4) = (f32x4){bflo(raw[i].x), bfhi(raw[i].x), bflo(raw[i].y), bfhi(raw[i].y)} * rs; }
        const f32x4 gm = g0 * (g1 + 1.0f);
        LDS_BAR();
        const int nitem = item + G; const bool more = nitem < 1024;
        if (more) POOL_LOAD(nitem);
        const int r0 = rg * 8;
        f32x4 S = {0.f, 0.f, 0.f, 0.f};
        for (int u = -hw; u < hw; ++u) S += *(const LAS f32x4*)(Y + (r0 + 8 + u) * 256 + c4);
#pragma unroll
        for (int r = 0; r < 8; ++r) { const int t = t0 + r0 + r; int lo = t - hw, hi = t + hw; lo = lo < 0 ? 0 : lo; hi = hi > SEQ ? SEQ : hi;
            const f32x4 own = *(const LAS f32x4*)(Y + (r0 + r + 8) * 256 + c4);
            const f32x4 p = (S * (1.0f / (float)(hi - lo)) - own) * gm;
            u32x2 o; o.x = pk2(p.x, p.y); o.y = pk2(p.z, p.w); *(u32x2*)(MIX + ((size_t)b * SEQ + t) * DM + cb * 256 + c4) = o;
            S += *(const LAS f32x4*)(Y + (r0 + r + 8 + hw) * 256 + c4) - *(const LAS f32x4*)(Y + (r0 + r + 8 - hw) * 256 + c4); }
        LDS_BAR();
        if (!more) break;
        item = nitem;
    }
#undef POOL_LOAD
}
__device__ __forceinline__ void phase_GEMM_G1(PH_PARAMS) {
    pg8::Gemm g{H, WIN, DM, DM, DM, 0, 0}; pg8::TileOrder S; S.init(MALL / 256, INP / 256, 1, G, bid); pg8::EpiSplit1 E{ws};
    pg8::gemm_phase<pg8::EpiSplit1, true>(lds, g, S, E, tid);
    if (G == 256 && bid >= 208) convert_tiles(PH_CALL(ph), 0, CT_N0 - CT_W_DN, CT_N0, bid - 208, 48);
}
__device__ __forceinline__ void phase_GEMM_LR(PH_PARAMS) {
    pg8::Gemm g; pg8::TileOrder S; pg8::EpiLowRank E;
    if (ph == PH_G2) { g = pg8::Gemm{CQ, WUQ, QRANK, QRANK, QRANK, 0, 0}; S.init(MLAT / 256, 1536 / 256, 1, G, bid); E = pg8::EpiLowRank{ws, 0}; }
    else { g = pg8::Gemm{CKV, WUKV, KVRANK, KVRANK, KVRANK, 0, 0}; S.init(MALL / 256, 2048 / 256, 1, G, (bid + 64) % G); E = pg8::EpiLowRank{ws, 1}; }
    pg8::gemm_phase<pg8::EpiLowRank, true>(lds, g, S, E, tid);
}
__device__ __forceinline__ void phase_GEMM_UP(PH_PARAMS) {
    const int l = (ph == PH_G8);
    pg8::Gemm g{H, WUP + (size_t)l * FF2 * DM, DM, DM, DM, 0, 0}; pg8::TileOrder S; S.init(MLAT / 256, FF2 / 256, 1, G, bid);
    pg8::EpiConv E{conv_w + (size_t)l * 3 * FF2, conv_b + (size_t)l * FF2, ACT, HALO, (LAS float*)(lds + 131072)};
    pg8::gemm_phase<pg8::EpiConv, true>(lds, g, S, E, tid);
    if (ph == PH_G5) { if (G == 256 && bid >= 128) { convert_tiles(PH_CALL(ph), 1, 0, CT_W_UP, bid - 128, 128); convert_tiles(PH_CALL(ph), 1, CT_W_UP + CT_W_DN, CT_N1, bid - 128, 128);
                                                    }
                       else if (G != 256) convert_tiles(PH_CALL(ph), 1, 0, CT_N1, bid, G); }
    if (ph == PH_G8 && G == 256 && bid >= 128) convert_tiles(PH_CALL(ph), 1, CT_W_UP, CT_W_UP + CT_W_DN, bid - 128, 128);
}
__device__ __forceinline__ void conv_fixup(PH_PARAMS, const int pm) {
    const int l = (ph == PH_G9); const float* cw = conv_w + (size_t)l * 3 * FF2; const float* cb = conv_b + (size_t)l * FF2;
    const int pmm = pm & 7;
    for (int idx = tid; idx < 2 * (FF / 4); idx += 512) {
        const int which = idx / (FF / 4), f = (idx % (FF / 4)) * 4; const int cd = 256 * (f >> 7) + (f & 127);
        const float* hup; const float* hcur; const float* hdn; bool zup = false, zdn = false;
        if (which == 0) { hup = HALO + (size_t)((pm - 1) * 4 + 3) * FF2; hcur = HALO + (size_t)(pm * 4 + 0) * FF2; hdn = HALO + (size_t)(pm * 4 + 1) * FF2; zup = (pmm == 0); if (zup) hup = hcur; }
        else { hup = HALO + (size_t)(pm * 4 + 2) * FF2; hcur = HALO + (size_t)(pm * 4 + 3) * FF2; hdn = HALO + (size_t)((pm + 1) * 4 + 0) * FF2; zdn = (pmm == 7); if (zdn) hdn = hcur; }
        f32x4 up[2];
#pragma unroll
        for (int bj = 0; bj < 2; ++bj) { const int c = cd + bj * 128; const float* p = cw + bj * FF + f;
            f32x4 vu = *(const f32x4*)(hup + c), vc = *(const f32x4*)(hcur + c), vd = *(const f32x4*)(hdn + c);
            if (zup) vu = (f32x4){0.f, 0.f, 0.f, 0.f}; if (zdn) vd = (f32x4){0.f, 0.f, 0.f, 0.f};
            up[bj] = *(const f32x4*)(cb + bj * FF + f) + *(const f32x4*)p * vu + *(const f32x4*)(p + FF2) * vc + *(const f32x4*)(p + 2 * FF2) * vd; }
        const f32x4 a = up[0], gt = up[1];
        u32x2 w; w.x = pk2(a.x * silu_f(gt.x), a.y * silu_f(gt.y)); w.y = pk2(a.z * silu_f(gt.z), a.w * silu_f(gt.w));
        *(u32x2*)(ACT + (size_t)(pm * 256 + (which ? 255 : 0)) * FF + f) = w;
    }
}
__device__ __forceinline__ void phase_GEMM_RES(PH_PARAMS) {
    pg8::Gemm g{ACT, WDN, FF, FF, FF, 0, 0}; pg8::TileOrder S; S.init(MLAT / 256, DM / 256, 1, G, bid); pg8::EpiResid E{XB, XB, ADA + 5 * DM, nullptr, 0, RSTDX};
    { pg8::Unit uu; for (int i = 0; S.next(i, uu); ++i) conv_fixup(args, ws, lds, lds_raw, tid, lane, wave, bid, G, gw, NGW, ph, uu.pm);
        asm volatile("s_waitcnt vmcnt(0)" ::: "memory"); __syncthreads(); }
    pg8::gemm_phase<pg8::EpiResid, false>(lds, g, S, E, tid);
}
__device__ __forceinline__ void phase_GEMM_POOL(PH_PARAMS) {
    using namespace pg8;
    TileOrder S; S.init(MLAT / 256, 2, 4, G, bid);
    const bf16_t* xb = XB; const float* ssq = RSTDX; const float* gvec = norm1_g + DM; const float* sc1 = ADA + 5 * NADA + DM; const bf16_t* Wp = WPOOL;
    constexpr int SA0 = 0, SB0 = 32768, YOFF = 98304, RSD = YOFF + 272 * 128, GMV = RSD + 272 * 4;
    static_assert(GMV + 512 * 4 <= 147456 - 256, "pool GEMM LDS map");
#define PGP_BAR asm volatile("s_waitcnt lgkmcnt(0)\n\ts_barrier" ::: "memory")
#define PGP_ISSUE_B(kt_) do { const int slot_ = (kt_) & 1; \
        _Pragma("unroll") for (int h_ = 0; h_ < 2; ++h_) _Pragma("unroll") for (int i_ = 0; i_ < 2; ++i_) \
            __builtin_amdgcn_global_load_lds((const unsigned*)(cB + (size_t)h_ * (128 * 512 * 2) + (size_t)(kt_) * 128 + voffB[i_]), (LAS unsigned*)(lds + SB0 + slot_ * 32768 + h_ * 16384 + ldsw + i_ * 8192), 16, 0, 0); } while (0)
#define PGP_ISSUE_Y(kt_) do { \
        _Pragma("unroll") for (int q_ = 0; q_ < 5; ++q_) { const int iq_ = wid + 8 * q_; if (iq_ < 34) { int t_ = t0 - 8 + iq_ * 8 + (lane >> 3); t_ = t_ < 0 ? 0 : (t_ > SEQ - 1 ? SEQ - 1 : t_); \
            __builtin_amdgcn_global_load_lds((const unsigned*)(xrow0 + (size_t)t_ * DM + (kt_) * 64 + (lane & 7) * 8), (LAS unsigned*)(lds + YOFF + iq_ * 1024), 16, 0, 0); } } } while (0)
    Unit cur;
    for (int ui = 0; S.next(ui, cur); ++ui) {
        int tq = threadIdx.x; asm volatile("" : "+v"(tq));
        const int wid = __builtin_amdgcn_readfirstlane(tq >> 6), lane = tq & 63, wr = wid >> 2, wc = wid & 3, fr = lane & 15, fq = lane >> 4;
        unsigned voffB[2];
#pragma unroll
        for (int i = 0; i < 2; ++i) { int R, C; stage_rc(tq * 16 + i * 8192, R, C); const int Rb = (R & ~31) + perm32(R & 31); voffB[i] = (unsigned)(Rb * 512 + C) * 2u; }
        const unsigned ldsw = (unsigned)wid * 1024u;
        const int aoff = lds_byte(wr * 64 + fr, fq * 8), boff = lds_byte(wc * 32 + fr, fq * 8);
        const int cg = tq & 15, seg = tq >> 4;
        const int b = cur.pm >> 3, t0 = (cur.pm & 7) * 256, hw = 1 << cur.g, kc0 = cur.g * 512;
        const bf16_t* xrow0 = xb + (size_t)b * SEQ * DM + kc0;
        const char* cB = (const char*)(Wp + (size_t)cur.g * 512 * 512 + (size_t)cur.pn * 256 * 512);
        PGP_ISSUE_Y(0); PGP_ISSUE_B(0);
        if (tq < 272) { const int t = t0 - 8 + tq; float rs = 0.f; if (t >= 0 && t < SEQ) rs = 1.0f / sqrtf(ssq[(size_t)b * SEQ + t] * (1.0f / DM) + EPS); *(LAS float*)(lds + RSD + tq * 4) = rs; }
        *(LAS float*)(lds + GMV + tq * 4) = gvec[kc0 + tq] * (sc1[(size_t)b * NADA + kc0 + tq] + 1.0f);
        f32x4 acc[2][2][4][2];
#pragma unroll
        for (int a = 0; a < 2; ++a)
#pragma unroll
            for (int bb = 0; bb < 2; ++bb)
#pragma unroll
                for (int m = 0; m < 4; ++m)
#pragma unroll
                    for (int n = 0; n < 2; ++n) acc[a][bb][m][n] = (f32x4){0.f, 0.f, 0.f, 0.f};
#pragma unroll 1
        for (int kt = 0; kt < 8; ++kt) {
            asm volatile("s_waitcnt vmcnt(0)" ::: "memory"); PGP_BAR;
            if (kt + 1 < 8) PGP_ISSUE_B(kt + 1);
            {   const LAS char* Yb = (const LAS char*)(lds + YOFF + cg * 8); const LAS float* rsd = (const LAS float*)(lds + RSD);
                const int r0 = seg * 8;
                const f32x4 gm = *(const LAS f32x4*)(lds + GMV + (kt * 64 + cg * 4) * 4);
                f32x4 Sv = {0.f, 0.f, 0.f, 0.f};
                for (int u = -hw; u < hw; ++u) Sv += pgp_y(Yb, rsd, r0 + 8 + u);
                LAS unsigned char* arow = lds + SA0 + (r0 >> 7) * 16384 + lds_byte(r0 & 127, cg * 4);
                const LAS char* yq = Yb + (r0 + 8) * 128; const LAS float* rq = rsd + r0 + 8;
#pragma unroll 1
                for (int r = 0; r < 8; ++r) { const int t = t0 + r0 + r; int lo = t - hw, hi = t + hw; lo = lo < 0 ? 0 : lo; hi = hi > SEQ ? SEQ : hi;
                    const f32x4 own = pgp_y(yq, rq, 0);
                    const f32x4 p = (Sv * __builtin_amdgcn_rcpf((float)(hi - lo)) - own) * gm;
                    u32x2 o; o.x = pk2(p.x, p.y); o.y = pk2(p.z, p.w);
                    *(LAS u32x2*)arow = o;
                    Sv += pgp_y(yq, rq, hw) - pgp_y(yq, rq, -hw);
                    arow += 64; yq += 128; rq += 1; }
            }
            PGP_BAR;
            if (kt + 1 < 8) PGP_ISSUE_Y(kt + 1);
            {   const int sb = SB0 + (kt & 1) * 32768; bf16x8 At[4][2], B0[2][2], B1[2][2];
#pragma unroll
                for (int n = 0; n < 2; ++n)
#pragma unroll
                    for (int k = 0; k < 2; ++k) { B0[n][k] = *(const LAS bf16x8*)(lds + sb + boff + n * 2048 + k * 1024); B1[n][k] = *(const LAS bf16x8*)(lds + sb + 16384 + boff + n * 2048 + k * 1024); }
#pragma unroll
                for (int ai = 0; ai < 2; ++ai) {
#pragma unroll
                    for (int m = 0; m < 4; ++m)
#pragma unroll
                        for (int k = 0; k < 2; ++k) At[m][k] = *(const LAS bf16x8*)(lds + SA0 + ai * 16384 + aoff + m * 2048 + k * 1024);
                    asm volatile("s_waitcnt lgkmcnt(0)" ::: "memory");
#pragma unroll
                    for (int m = 0; m < 4; ++m)
#pragma unroll
                        for (int n = 0; n < 2; ++n)
#pragma unroll
                            for (int k = 0; k < 2; ++k) { acc[ai][0][m][n] = __builtin_amdgcn_mfma_f32_16x16x32_bf16(B0[n][k], At[m][k], acc[ai][0][m][n], 0, 0, 0);
                                                          acc[ai][1][m][n] = __builtin_amdgcn_mfma_f32_16x16x32_bf16(B1[n][k], At[m][k], acc[ai][1][m][n], 0, 0, 0); }
                }
            }
        }
        asm volatile("s_waitcnt vmcnt(0)" ::: "memory"); PGP_BAR;
        {
            const EpiResidNorm E{nullptr, XB, XB2, ADA + 5 * NADA + 2 * DM, pool_scale, 512, norm2_g + DM, ADA + 5 * NADA + 3 * DM, ADA + 5 * NADA + 4 * DM, H, nullptr,
                                 (float*)(ws + WS_SLOTS), (unsigned*)(ws + WS_CTL + 16384) + 32 * 64};
            E.fused(acc, cur, wr, wc, fr, fq, lds, wid, lane); }
        asm volatile("s_waitcnt vmcnt(0)" ::: "memory"); PGP_BAR;
    }
#undef PGP_BAR
#undef PGP_ISSUE_B
#undef PGP_ISSUE_Y
}
__device__ __forceinline__ void phase_GEMM_RN(PH_PARAMS) {
    pg8::Gemm g; pg8::TileOrder S; pg8::EpiResidNorm E;
    float* slots = (float*)(ws + WS_SLOTS); unsigned* cntb = (unsigned*)(ws + WS_CTL + 16384);
    if (ph == PH_G4) { g = pg8::Gemm{MIX, WOUT, DM, DM, DM, 0, 0}; S.init(MLAT / 256, DM / 256, 1, G, bid);
        E = pg8::EpiResidNorm{x_in, nullptr, XB, ADA + 2 * DM, nullptr, 0, norm2_g, ADA + 3 * DM, ADA + 4 * DM, H, nullptr, slots, cntb}; }
    else if (ph == PH_G7) { return; }
    else { g = pg8::Gemm{ACT, WDN + (size_t)DM * FF, FF, FF, FF, 0, 0}; S.init(MLAT / 256, DM / 256, 1, G, bid);
        E = pg8::EpiResidNorm{nullptr, XB2, nullptr, ADA + 5 * NADA + 5 * DM, nullptr, 0, final_g, nullptr, nullptr, nullptr, X, slots, cntb + 64 * 64}; }
    if (ph == PH_G9) { pg8::Unit uu; for (int i = 0; S.next(i, uu); ++i) conv_fixup(args, ws, lds, lds_raw, tid, lane, wave, bid, G, gw, NGW, ph, uu.pm);
        asm volatile("s_waitcnt vmcnt(0)" ::: "memory"); __syncthreads(); }
    pg8::gemm_phase<pg8::EpiResidNorm, false>(lds, g, S, E, tid);
}
__global__ void __launch_bounds__(512, 2) mega(Args args) {
    extern __shared__ __attribute__((aligned(16))) unsigned char lds_raw[];
    LAS unsigned char* lds = (LAS unsigned char*)lds_raw;
    const int G = gridDim.x, bid = blockIdx.x;
    const int NGW = G * 8;
#define PH_LOCALS int tid_ = threadIdx.x; asm volatile("" : "+v"(tid_)); const int tid = tid_, lane = tid & 63, wave = __builtin_amdgcn_readfirstlane(tid >> 6), gw = bid * 8 + wave; (void)lane; (void)gw;
    unsigned char* ws = args.ws;
    const int lo = args.ph_lo, hi = args.ph_hi;
    volatile LAS unsigned* MISC = (volatile LAS unsigned*)(lds + MISC_OFF);
    if (threadIdx.x < 64) MISC[threadIdx.x] = 0u;
    __syncthreads();
    XcdBarrier bar; bar.bar = (unsigned*)(ws + WS_CTL); bar.x = 0; bar.st = nullptr;
    if (hi - lo > 1) bar = xcd_barrier_post((unsigned*)(ws + WS_CTL), MISC + 8);
#define IN(k) (EN(k) && lo <= (k) && (k) < hi)
#define SEAM(k) do { if ((k) + 1 < hi) xcd_barrier(bar); else __syncthreads(); } while (0)
    if (IN(PH_PREP)) { { PH_LOCALS phase_PREP(PH_CALL(PH_PREP)); } { PH_LOCALS phase_NORM(PH_CALL(PH_NORM1)); } SEAM(PH_NORM1); }
    if (IN(PH_G1)) { PH_LOCALS phase_GEMM_G1(PH_CALL(PH_G1)); SEAM(PH_G1); }
    if (IN(PH_G2)) { { PH_LOCALS phase_GEMM_LR(PH_CALL(PH_G2)); } { PH_LOCALS phase_GEMM_LR(PH_CALL(PH_G3)); } __syncthreads(); { PH_LOCALS phase_R1(PH_CALL(PH_R1)); } SEAM(PH_G2); }
    if (IN(PH_R2)) { { PH_LOCALS phase_R2(PH_CALL(PH_R2)); }
        asm volatile("s_waitcnt vmcnt(0)" ::: "memory"); __syncthreads();
        if (threadIdx.x == 0) { __builtin_amdgcn_fence(__ATOMIC_RELEASE, "agent"); asm volatile("s_waitcnt vmcnt(0)" ::: "memory"); __hip_atomic_fetch_add((unsigned*)(ws + WS_CTL + 49152 + 256), 1u, __ATOMIC_RELAXED, __HIP_MEMORY_SCOPE_AGENT); }
        { PH_LOCALS phase_ATTN(PH_CALL(PH_ATTN)); }
        if (threadIdx.x == 0) { unsigned spins = 0; while (__hip_atomic_load((unsigned*)(ws + WS_CTL + 49152 + 256), __ATOMIC_RELAXED, __HIP_MEMORY_SCOPE_AGENT) < (unsigned)G) { __builtin_amdgcn_s_sleep(2); if (++spins > (1u << 20)) break; }
            __builtin_amdgcn_fence(__ATOMIC_ACQUIRE, "agent"); asm volatile("s_waitcnt vmcnt(0)" ::: "memory"); }
        __syncthreads();
        { PH_LOCALS phase_R3(PH_CALL(PH_R3)); }
        SEAM(PH_R3); }
    if (IN(PH_G4)) { PH_LOCALS phase_GEMM_RN(PH_CALL(PH_G4)); SEAM(PH_G4); }
    if (IN(PH_G5)) { PH_LOCALS phase_GEMM_UP(PH_CALL(PH_G5)); if (REP(PH_G5)) { __syncthreads(); phase_GEMM_UP(PH_CALL(PH_G5)); } SEAM(PH_G5); }
    if (IN(PH_G6)) { PH_LOCALS phase_GEMM_RES(PH_CALL(PH_G6)); SEAM(PH_G6); }
    if (IN(PH_G7)) { PH_LOCALS phase_GEMM_POOL(PH_CALL(PH_G7)); SEAM(PH_G7); }
    if (IN(PH_G8)) { PH_LOCALS phase_GEMM_UP(PH_CALL(PH_G8)); if (REP(PH_G8)) { __syncthreads(); phase_GEMM_UP(PH_CALL(PH_G8)); } SEAM(PH_G8); }
    if (IN(PH_G9)) { PH_LOCALS phase_GEMM_RN(PH_CALL(PH_G9)); }
}

extern "C" void kernel_launch(void* const* d_in, const int* in_sizes, int n_in, void* d_out, int out_size, void* d_ws, size_t ws_size, hipStream_t stream) {
    static int ok = 0;
    if (ok == 0) {
        if (n_in != 23 || out_size != MLAT * DM || ws_size < WS_END) { fprintf(stderr, "kernel_launch: unexpected shapes: n_in %d out %d ws %zu (need %zu)\n", n_in, out_size, ws_size, (size_t)WS_END); ok = -1; return; }
        if (hipFuncSetAttribute((const void*)mega, hipFuncAttributeMaxDynamicSharedMemorySize, LDS_BYTES) != hipSuccess) { fprintf(stderr, "kernel_launch: hipFuncSetAttribute failed\n"); ok = -1; return; }
        int dev = 0, cus = 0, per_cu = 0;
        if (hipGetDevice(&dev) != hipSuccess || hipDeviceGetAttribute(&cus, hipDeviceAttributeMultiprocessorCount, dev) != hipSuccess ||
            hipOccupancyMaxActiveBlocksPerMultiprocessor(&per_cu, (const void*)mega, 512, LDS_BYTES) != hipSuccess || per_cu < 1 || (long)cus * per_cu < 256) {
            fprintf(stderr, "kernel_launch: the 256-workgroup persistent grid is not resident on this device (CUs %d, workgroups per CU %d); nothing launched\n", cus, per_cu); ok = -1; return; }
        ok = 1;
    }
    if (ok < 0) return;
    Args a{};
    for (int i = 0; i < 23; ++i) a.in[i] = (const float*)d_in[i];
    a.out = (float*)d_out; a.ws = (unsigned char*)d_ws;
    if (hipMemsetAsync((char*)d_ws + WS_CTL, 0, CTL_ZERO_BYTES, stream) != hipSuccess) { fprintf(stderr, "kernel_launch: hipMemsetAsync failed\n"); return; }
    a.ph_lo = 0; a.ph_hi = PH_COUNT;
    hipLaunchKernelGGL(mega, dim3(256), dim3(512), LDS_BYTES, stream, a);
    const hipError_t le = hipPeekAtLastError();
    if (le != hipSuccess) fprintf(stderr, "kernel_launch: launch failed: %s\n", hipGetErrorName(le));
}
```

```cpp
#include <hip/hip_runtime.h>
#include <cstdio>
#include <cstdint>

#define GAS __attribute__((address_space(1)))
#define LAS __attribute__((address_space(3)))
typedef unsigned short bf16_t;
typedef short bf16x8 __attribute__((ext_vector_type(8)));
typedef short s16x4 __attribute__((ext_vector_type(4)));
typedef float f32x2 __attribute__((ext_vector_type(2)));
typedef float f32x4 __attribute__((ext_vector_type(4)));
typedef float f32x16 __attribute__((ext_vector_type(16)));
typedef unsigned u32x2 __attribute__((ext_vector_type(2)));
typedef unsigned u32x4 __attribute__((ext_vector_type(4)));

constexpr int DM = 2048, NB = 4, SEQ = 2048, CTX = 256, NH = 8, HD = 128;
constexpr int MLAT = NB * SEQ;
constexpr int MCTX = NB * CTX;
constexpr int MALL = MLAT + MCTX;
constexpr int NKEY = CTX + SEQ;
constexpr int FF = 5632, FF2 = 11264;
constexpr int INC = 4928, INP = 5120;
constexpr int QRANK = 512, KVRANK = 256, DR = 64;
constexpr int NADA = 6 * DM;
constexpr float EPS = 1e-6f;
constexpr int NCHUNK = 18;

constexpr size_t MiB = 1u << 20;
constexpr size_t WS_CTL = 0;
constexpr size_t WS_ADA = 1 * MiB;
constexpr size_t WS_RT128 = 2 * MiB;
constexpr size_t WS_RT64 = 3 * MiB;
constexpr size_t WS_RSTDQ = 3 * MiB + 512 * 1024;
constexpr size_t WS_RSTDKV = WS_RSTDQ + 64 * 1024;
constexpr size_t WS_RSTDX = WS_RSTDKV + 64 * 1024;
constexpr size_t WS_WIN = 4 * MiB;
constexpr size_t WS_WUQ = 24 * MiB;
constexpr size_t WS_WUKV = 26 * MiB;
constexpr size_t WS_WPOOL = 27 * MiB;
constexpr size_t WS_WOUT = 29 * MiB;
constexpr size_t WS_WUP = 37 * MiB;
constexpr size_t WS_WDN = 125 * MiB;
constexpr size_t WS_H = 169 * MiB;
constexpr size_t WS_RQ = 205 * MiB;
constexpr size_t WS_RK = 221 * MiB;
constexpr size_t WS_RV = 239 * MiB;
constexpr size_t WS_RG = 257 * MiB;
constexpr size_t WS_CQ = 273 * MiB;
constexpr size_t WS_CKV = 281 * MiB;
constexpr size_t WS_QN = 286 * MiB;
constexpr size_t WS_QR = 302 * MiB;
constexpr size_t WS_KN = 310 * MiB;
constexpr size_t WS_KR = 328 * MiB;
constexpr size_t WS_VC = 330 * MiB;
constexpr size_t WS_KVB = 348 * MiB;
constexpr size_t WS_ST = 420 * MiB;
constexpr size_t WS_MIX = 452 * MiB;
constexpr size_t WS_ACT = 484 * MiB;
constexpr size_t WS_Z = 572 * MiB;
constexpr size_t WS_Z3 = WS_Z + 48 * MiB;
constexpr size_t WS_SLOTS = 578 * MiB;
constexpr size_t WS_XB = 592 * MiB;
constexpr size_t WS_END = 752 * MiB;

constexpr int LDS_BYTES = 147456;

__device__ __forceinline__ unsigned f2bf(float f) { unsigned u = __builtin_bit_cast(unsigned, f); return (u + 0x7fffu + ((u >> 16) & 1u)) >> 16; }
__device__ __forceinline__ unsigned pk2(float lo, float hi) { return f2bf(lo) | (f2bf(hi) << 16); }
__device__ __forceinline__ float bf2f(unsigned short h) { return __builtin_bit_cast(float, (unsigned)h << 16); }
__device__ __forceinline__ float bflo(unsigned w) { return __builtin_bit_cast(float, w << 16); }
__device__ __forceinline__ float bfhi(unsigned w) { return __builtin_bit_cast(float, w & 0xffff0000u); }
__device__ __forceinline__ unsigned cvtpk(float lo, float hi) { unsigned r; asm volatile("v_cvt_pk_bf16_f32 %0, %1, %2" : "=v"(r) : "v"(lo), "v"(hi)); return r; }
__device__ __forceinline__ f32x4 ldbf4(const bf16_t* p) { const u32x2 w = *(const u32x2*)p; return (f32x4){bflo(w.x), bfhi(w.x), bflo(w.y), bfhi(w.y)}; }
__device__ __forceinline__ void stbf4(bf16_t* p, f32x4 v) { u32x2 w; w.x = cvtpk(v.x, v.y); w.y = cvtpk(v.z, v.w); *(u32x2*)p = w; }
__device__ __forceinline__ float wave_sum(float v) {
#pragma unroll
    for (int o = 1; o < 64; o <<= 1) v += __shfl_xor(v, o);
    return v;
}
__device__ __forceinline__ float silu_f(float v) { return v * __builtin_amdgcn_rcpf(1.f + __builtin_amdgcn_exp2f(v * -1.4426950408889634f)); }
__device__ __forceinline__ void sincos_acc(float x, float& s, float& c) {
    const double xd = (double)x; const double kq = __builtin_rint(xd * 0.63661977236758134308);
    const double r = (xd - kq * 1.57079632679489655800) - kq * 6.12323399573676603587e-17; const int q = ((int)kq) & 3;
    const double r2 = r * r;
    const double sp = r * (1.0 + r2 * (-1.0 / 6 + r2 * (1.0 / 120 + r2 * (-1.0 / 5040 + r2 * (1.0 / 362880 + r2 * (-1.0 / 39916800 + r2 * (1.0 / 6227020800.0)))))));
    const double cp = 1.0 + r2 * (-0.5 + r2 * (1.0 / 24 + r2 * (-1.0 / 720 + r2 * (1.0 / 40320 + r2 * (-1.0 / 3628800 + r2 * (1.0 / 479001600.0 + r2 * (-1.0 / 87178291200.0)))))));
    double sd, cd;
    if (q == 0) { sd = sp; cd = cp; } else if (q == 1) { sd = cp; cd = -sp; } else if (q == 2) { sd = -sp; cd = -cp; } else { sd = -cp; cd = sp; }
    s = (float)sd; c = (float)cd;
}

namespace pg8 {
constexpr int BM = 256, BK = 64, HALF = 128, HTB = HALF * BK * 2, STAGE_BYTES = 8 * HTB, NXCD = 8, WGM = 8;
__host__ __device__ __forceinline__ int lds_byte(int r, int c) { const int st = (r >> 4) * 2 + (c >> 5), rr = r & 15, cc = c & 31, ob = rr * 64 + cc * 2; return st * 1024 + (ob ^ (((ob >> 9) & 1) << 5)); }
__host__ __device__ __forceinline__ void stage_rc(int b, int& R, int& C) { const int st = b / 1024, sb = b % 1024, swz = sb ^ (((sb >> 9) & 1) << 5); R = (st >> 1) * 16 + swz / 64; C = (st & 1) * 32 + (swz % 64) / 2; }
__host__ __device__ __forceinline__ int perm32(int rho) { const int n = rho >> 4, i = rho & 15; return 8 * (i >> 2) + 4 * n + (i & 3); }

struct Unit { int pm, pn, g; };
struct Gemm { const bf16_t* A; const bf16_t* Bt; int K, lda, ldb; size_t a_g, b_g; };

struct TileOrder {
    int nM, nN, nwg, G, c;
    __device__ void init(int nM_, int nN_, int nG_, int G_, int c_) { nM = nM_; nN = nN_; nwg = nM_ * nN_ * nG_; G = G_; c = c_; }
    __device__ bool next(int i, Unit& u) const {
        const long L = (long)i * G + c; if (L >= nwg) return false;
        int wgid = (int)L; { const int q = nwg / NXCD, r = nwg % NXCD, xcd = wgid % NXCD, off = wgid / NXCD; wgid = (xcd < r ? xcd * (q + 1) : r * (q + 1) + (xcd - r) * q) + off; }
        const int per_g = nM * nN; u.g = wgid / per_g; const int w = wgid % per_g;
        const int nig = WGM * nN, gid = w / nig, fm = gid * WGM, gsz = (nM - fm) < WGM ? (nM - fm) : WGM;
        u.pm = fm + ((w % nig) % gsz); u.pn = (w % nig) / gsz; return true;
    }
};

struct EpiF32 {
    static constexpr bool PERM = false, AFTER_DRAIN = false, APERM = false;
    float* C; int ldc;
    __device__ __forceinline__ void operator()(const f32x4 (&acc)[2][2][4][2], const Unit& u, int wr, int wc, int fr, int fq) const {
        const int row0 = u.pm * BM + wr * 64 + fr, col0 = u.pn * BM + wc * 32 + 4 * fq;
#pragma unroll
        for (int ai = 0; ai < 2; ++ai)
#pragma unroll
            for (int m = 0; m < 4; ++m) { float* rowp = C + (size_t)(row0 + ai * HALF + m * 16) * ldc + col0;
#pragma unroll
                for (int bj = 0; bj < 2; ++bj)
#pragma unroll
                    for (int n = 0; n < 2; ++n) *(f32x4*)(rowp + bj * HALF + n * 16) = acc[ai][bj][m][n]; }
    }
};
struct EpiBf16 {
    static constexpr bool PERM = true, AFTER_DRAIN = false, APERM = false;
    bf16_t* O; int ldc;
    __device__ __forceinline__ void operator()(const f32x4 (&acc)[2][2][4][2], const Unit& u, int wr, int wc, int fr, int fq) const {
        const int row0 = u.pm * BM + wr * 64 + fr, col0 = u.pn * BM + wc * 32 + 8 * fq;
#pragma unroll
        for (int ai = 0; ai < 2; ++ai)
#pragma unroll
            for (int m = 0; m < 4; ++m) { bf16_t* rowp = O + (size_t)(row0 + ai * HALF + m * 16) * ldc + col0;
#pragma unroll
                for (int bj = 0; bj < 2; ++bj) { const f32x4 v0 = acc[ai][bj][m][0], v1 = acc[ai][bj][m][1];
                    u32x4 w; w.x = cvtpk(v0[0], v0[1]); w.y = cvtpk(v0[2], v0[3]); w.z = cvtpk(v1[0], v1[1]); w.w = cvtpk(v1[2], v1[3]);
                    *(u32x4*)(rowp + bj * HALF) = w; } }
    }
};
struct EpiResid {
    static constexpr bool PERM = true, AFTER_DRAIN = false, APERM = false;
    const bf16_t* base; bf16_t* out; const float* gate; const float* cscale; int gcols; float* ssq;
    __device__ __forceinline__ void operator()(const f32x4 (&acc)[2][2][4][2], const Unit& u, int wr, int wc, int fr, int fq) const {
        const int row0 = u.pm * BM + wr * 64 + fr, col0 = u.g * gcols + u.pn * BM + wc * 32 + 8 * fq;
        const float* gv = gate + (size_t)(u.pm >> 3) * NADA + col0;
        f32x4 gg[2][2];
#pragma unroll
        for (int bj = 0; bj < 2; ++bj)
#pragma unroll
            for (int n = 0; n < 2; ++n) { gg[bj][n] = *(const f32x4*)(gv + bj * HALF + n * 4); if (cscale) gg[bj][n] *= *(const f32x4*)(cscale + col0 + bj * HALF + n * 4); }
        u32x4 bsr[2][4][2];
#pragma unroll
        for (int ai = 0; ai < 2; ++ai)
#pragma unroll
            for (int m = 0; m < 4; ++m)
#pragma unroll
                for (int bj = 0; bj < 2; ++bj) bsr[ai][m][bj] = *(const u32x4*)(base + (size_t)(row0 + ai * HALF + m * 16) * DM + col0 + bj * HALF);
#pragma unroll
        for (int ai = 0; ai < 2; ++ai)
#pragma unroll
            for (int m = 0; m < 4; ++m) { const size_t off = (size_t)(row0 + ai * HALF + m * 16) * DM + col0; float sq = 0.f;
#pragma unroll
                for (int bj = 0; bj < 2; ++bj) { const u32x4 w = bsr[ai][m][bj];
                    const f32x4 o0 = (f32x4){bflo(w.x), bfhi(w.x), bflo(w.y), bfhi(w.y)} + gg[bj][0] * acc[ai][bj][m][0];
                    const f32x4 o1 = (f32x4){bflo(w.z), bfhi(w.z), bflo(w.w), bfhi(w.w)} + gg[bj][1] * acc[ai][bj][m][1];
                    sq += ((o0.x * o0.x + o0.y * o0.y) + (o0.z * o0.z + o0.w * o0.w)) + ((o1.x * o1.x + o1.y * o1.y) + (o1.z * o1.z + o1.w * o1.w));
                    u32x4 ov; ov.x = cvtpk(o0.x, o0.y); ov.y = cvtpk(o0.z, o0.w); ov.z = cvtpk(o1.x, o1.y); ov.w = cvtpk(o1.z, o1.w);
                    *(u32x4*)(out + off + bj * HALF) = ov; }
                if (ssq) { sq += __shfl_xor(sq, 16); sq += __shfl_xor(sq, 32); if (fq == 0) atomicAdd(ssq + row0 + ai * HALF + m * 16, sq); } }
    }
};

struct EpiSplit1 {
    static constexpr bool PERM = true, AFTER_DRAIN = false, APERM = false;
    unsigned char* ws;
    __device__ __forceinline__ void operator()(const f32x4 (&acc)[2][2][4][2], const Unit& u, int wr, int wc, int fr, int fq) const {
        const int pn = u.pn, pm = u.pm; const bool lat = pm < 32;
        const int b = lat ? (pm >> 3) : (pm - 32); const int t0 = lat ? ((pm & 7) * 256) : 0;
        const int rloc0 = wr * 64 + fr, j8 = wc * 32 + fq * 8;
        if (pn < 8) {
            const bool isk = pn >= 4; if (!isk && !lat) return;
            const float ksc = isk ? 0.08838834764831845f : 1.0f;
            f32x4 cs[2][4][2];
#pragma unroll
            for (int ai = 0; ai < 2; ++ai)
#pragma unroll
                for (int m = 0; m < 4; ++m) { const int tt = t0 + rloc0 + ai * HALF + m * 16;
                    cs[ai][m][0] = (f32x4){1.f, 0.f, 1.f, 0.f}; cs[ai][m][1] = (f32x4){1.f, 0.f, 1.f, 0.f};
                    if (lat) { const f32x4* rt = (const f32x4*)(ws + WS_RT128) + ((tt * 64 + (j8 >> 1)) >> 1); cs[ai][m][0] = rt[0]; cs[ai][m][1] = rt[1]; } }
#pragma unroll
            for (int ai = 0; ai < 2; ++ai)
#pragma unroll
                for (int m = 0; m < 4; ++m) { const int tt = t0 + rloc0 + ai * HALF + m * 16;
                    const f32x4 c0 = cs[ai][m][0], c1 = cs[ai][m][1];
#pragma unroll
                    for (int bj = 0; bj < 2; ++bj) { const int h = 2 * (pn & 3) + bj; const f32x4 v0 = acc[ai][bj][m][0], v1 = acc[ai][bj][m][1];
                        u32x4 w;
                        w.x = cvtpk((v0.x * c0.x - v0.y * c0.y) * ksc, (v0.x * c0.y + v0.y * c0.x) * ksc); w.y = cvtpk((v0.z * c0.z - v0.w * c0.w) * ksc, (v0.z * c0.w + v0.w * c0.z) * ksc);
                        w.z = cvtpk((v1.x * c1.x - v1.y * c1.y) * ksc, (v1.x * c1.y + v1.y * c1.x) * ksc); w.w = cvtpk((v1.z * c1.z - v1.w * c1.w) * ksc, (v1.z * c1.w + v1.w * c1.z) * ksc);
                        bf16_t* dst = isk ? (bf16_t*)(ws + WS_RK) + ((size_t)(b * NH + h) * NKEY + (lat ? CTX + tt : tt)) * HD + j8 : (bf16_t*)(ws + WS_RQ) + ((size_t)(b * NH + h) * SEQ + tt) * HD + j8;
                        *(u32x4*)dst = w; } }
        } else if (pn < 12) {
#pragma unroll
            for (int ai = 0; ai < 2; ++ai)
#pragma unroll
                for (int m = 0; m < 4; ++m) { const int tt = t0 + rloc0 + ai * HALF + m * 16;
#pragma unroll
                    for (int bj = 0; bj < 2; ++bj) { const int h = 2 * (pn - 8) + bj; const f32x4 v0 = acc[ai][bj][m][0], v1 = acc[ai][bj][m][1];
                        u32x4 w; w.x = cvtpk(v0.x, v0.y); w.y = cvtpk(v0.z, v0.w); w.z = cvtpk(v1.x, v1.y); w.w = cvtpk(v1.z, v1.w);
                        *(u32x4*)((bf16_t*)(ws + WS_RV) + ((size_t)(b * NH + h) * NKEY + (lat ? CTX + tt : tt)) * HD + j8) = w; } }
        } else if (pn < 18) {
            if (!lat) return;
            const bool isg = pn < 16; float* ssq = (float*)(ws + WS_RSTDQ);
#pragma unroll
            for (int ai = 0; ai < 2; ++ai)
#pragma unroll
                for (int m = 0; m < 4; ++m) { const int row = pm * 256 + rloc0 + ai * HALF + m * 16; float s = 0.f;
#pragma unroll
                    for (int bj = 0; bj < 2; ++bj) { const f32x4 v0 = acc[ai][bj][m][0], v1 = acc[ai][bj][m][1];
                        u32x4 w; w.x = cvtpk(v0.x, v0.y); w.y = cvtpk(v0.z, v0.w); w.z = cvtpk(v1.x, v1.y); w.w = cvtpk(v1.z, v1.w);
                        s += (v0.x * v0.x + v0.y * v0.y) + (v0.z * v0.z + v0.w * v0.w) + (v1.x * v1.x + v1.y * v1.y) + (v1.z * v1.z + v1.w * v1.w);
                        bf16_t* dst = isg ? (bf16_t*)(ws + WS_RG) + (size_t)row * 1024 + (pn - 12) * 256 + bj * HALF + j8 : (bf16_t*)(ws + WS_CQ) + (size_t)row * QRANK + (pn - 16) * 256 + bj * HALF + j8;
                        *(u32x4*)dst = w; }
                    if (!isg) { s += __shfl_xor(s, 16); s += __shfl_xor(s, 32); if (fq == 0) atomicAdd(ssq + row, s); } }
        } else if (pn == 18) {
            float* ssq = (float*)(ws + WS_RSTDKV);
#pragma unroll
            for (int ai = 0; ai < 2; ++ai)
#pragma unroll
                for (int m = 0; m < 4; ++m) { const int row = pm * 256 + rloc0 + ai * HALF + m * 16; float s = 0.f;
#pragma unroll
                    for (int bj = 0; bj < 2; ++bj) { const f32x4 v0 = acc[ai][bj][m][0], v1 = acc[ai][bj][m][1];
                        u32x4 w; w.x = cvtpk(v0.x, v0.y); w.y = cvtpk(v0.z, v0.w); w.z = cvtpk(v1.x, v1.y); w.w = cvtpk(v1.z, v1.w);
                        s += (v0.x * v0.x + v0.y * v0.y) + (v0.z * v0.z + v0.w * v0.w) + (v1.x * v1.x + v1.y * v1.y) + (v1.z * v1.z + v1.w * v1.w);
                        *(u32x4*)((bf16_t*)(ws + WS_CKV) + (size_t)row * KVRANK + bj * HALF + j8) = w; }
                    s += __shfl_xor(s, 16); s += __shfl_xor(s, 32); if (fq == 0) atomicAdd(ssq + row, s); }
        } else {
            if (wc >= 2) return;
#pragma unroll
            for (int ai = 0; ai < 2; ++ai)
#pragma unroll
                for (int m = 0; m < 4; ++m) { const int tt = t0 + rloc0 + ai * HALF + m * 16;
                    f32x4 c0 = {1.f, 0.f, 1.f, 0.f}, c1 = {1.f, 0.f, 1.f, 0.f};
                    if (lat) { const f32x4* rt = (const f32x4*)(ws + WS_RT64) + ((tt * 32 + (j8 >> 1)) >> 1); c0 = rt[0]; c1 = rt[1]; }
                    const f32x4 v0 = acc[ai][0][m][0], v1 = acc[ai][0][m][1];
                    u32x4 w;
                    w.x = cvtpk(v0.x * c0.x - v0.y * c0.y, v0.x * c0.y + v0.y * c0.x); w.y = cvtpk(v0.z * c0.z - v0.w * c0.w, v0.z * c0.w + v0.w * c0.z);
                    w.z = cvtpk(v1.x * c1.x - v1.y * c1.y, v1.x * c1.y + v1.y * c1.x); w.w = cvtpk(v1.z * c1.z - v1.w * c1.w, v1.z * c1.w + v1.w * c1.z);
                    *(u32x4*)((bf16_t*)(ws + WS_KR) + ((size_t)b * NKEY + (lat ? CTX + tt : tt)) * DR + j8) = w; }
        }
    }
};
struct EpiLowRank {
    static constexpr bool PERM = true, AFTER_DRAIN = false, APERM = false;
    unsigned char* ws; int mode;
    __device__ __forceinline__ void operator()(const f32x4 (&acc)[2][2][4][2], const Unit& u, int wr, int wc, int fr, int fq) const {
        const int pn = u.pn, pm = u.pm; const bool lat = pm < 32;
        const int b = lat ? (pm >> 3) : (pm - 32); const int t0 = lat ? ((pm & 7) * 256) : 0;
        const int rloc0 = wr * 64 + fr, j8 = wc * 32 + fq * 8;
        const float* ssq = (const float*)(ws + (mode == 0 ? WS_RSTDQ : WS_RSTDKV)); const float invn = mode == 0 ? 1.0f / QRANK : 1.0f / KVRANK;
#pragma unroll
        for (int ai = 0; ai < 2; ++ai)
#pragma unroll
            for (int m = 0; m < 4; ++m) { const int rl = rloc0 + ai * HALF + m * 16, tt = t0 + rl; const float rs = 1.0f / sqrtf(ssq[pm * 256 + rl] * invn + EPS);
                if (mode == 0 && pn >= 4) {
#pragma unroll
                    for (int bj = 0; bj < 2; ++bj) { const int o = 256 * (pn - 4) + HALF * bj + j8, h = o >> 6, jj = o & 63;
                        const f32x4* rt = (const f32x4*)(ws + WS_RT64) + ((tt * 32 + (jj >> 1)) >> 1); const f32x4 c0 = rt[0], c1 = rt[1];
                        const f32x4 v0 = acc[ai][bj][m][0] * rs, v1 = acc[ai][bj][m][1] * rs;
                        u32x4 w;
                        w.x = cvtpk(v0.x * c0.x - v0.y * c0.y, v0.x * c0.y + v0.y * c0.x); w.y = cvtpk(v0.z * c0.z - v0.w * c0.w, v0.z * c0.w + v0.w * c0.z);
                        w.z = cvtpk(v1.x * c1.x - v1.y * c1.y, v1.x * c1.y + v1.y * c1.x); w.w = cvtpk(v1.z * c1.z - v1.w * c1.w, v1.z * c1.w + v1.w * c1.z);
                        *(u32x4*)((bf16_t*)(ws + WS_QR) + ((size_t)(b * NH + h) * SEQ + tt) * DR + jj) = w; }
                } else {
#pragma unroll
                    for (int bj = 0; bj < 2; ++bj) { const int h = 2 * (pn & 3) + bj; const f32x4 v0 = acc[ai][bj][m][0] * rs, v1 = acc[ai][bj][m][1] * rs;
                        u32x4 w; w.x = cvtpk(v0.x, v0.y); w.y = cvtpk(v0.z, v0.w); w.z = cvtpk(v1.x, v1.y); w.w = cvtpk(v1.z, v1.w);
                        bf16_t* dst = mode == 0 ? (bf16_t*)(ws + WS_QN) + ((size_t)(b * NH + h) * SEQ + tt) * HD + j8
                                                : (bf16_t*)(ws + (pn < 4 ? WS_KN : WS_VC)) + ((size_t)(b * NH + h) * NKEY + (lat ? CTX + tt : tt)) * HD + j8;
                        *(u32x4*)dst = w; } }
            }
    }
};

__device__ __forceinline__ float dpp_shr1(float x) { return __builtin_bit_cast(float, __builtin_amdgcn_update_dpp(0, __builtin_bit_cast(int, x), 0x111, 0xf, 0xf, true)); }
__device__ __forceinline__ float dpp_shl1(float x) { return __builtin_bit_cast(float, __builtin_amdgcn_update_dpp(0, __builtin_bit_cast(int, x), 0x101, 0xf, 0xf, true)); }
__device__ __forceinline__ float dpp_ror1(float x) { return __builtin_bit_cast(float, __builtin_amdgcn_update_dpp(0, __builtin_bit_cast(int, x), 0x121, 0xf, 0xf, false)); }
__device__ __forceinline__ float dpp_ror15(float x) { return __builtin_bit_cast(float, __builtin_amdgcn_update_dpp(0, __builtin_bit_cast(int, x), 0x12f, 0xf, 0xf, false)); }
__device__ __forceinline__ float dpp_shr1_old(float o, float x) { const int oi = __builtin_bit_cast(int, o), xi = __builtin_bit_cast(int, x); return __builtin_bit_cast(float, __builtin_amdgcn_update_dpp(oi, xi, 0x111, 0xf, 0xf, false)); }
__device__ __forceinline__ float dpp_shl1_old(float o, float x) { const int oi = __builtin_bit_cast(int, o), xi = __builtin_bit_cast(int, x); return __builtin_bit_cast(float, __builtin_amdgcn_update_dpp(oi, xi, 0x101, 0xf, 0xf, false)); }
struct EpiConv {
    static constexpr bool PERM = true, AFTER_DRAIN = false, APERM = true;
    const float* cw; const float* cb; bf16_t* act; float* halo; LAS float* ex;
    __device__ __forceinline__ void operator()(const f32x4 (&acc)[2][2][4][2], const Unit& u, int wr, int wc, int fr, int fq) const {
        const int wid = wr * 4 + wc;
        LAS float* mine = ex + wid * 256;
        if (fr == 0) {
#pragma unroll
            for (int ai = 0; ai < 2; ++ai)
#pragma unroll
                for (int bj = 0; bj < 2; ++bj)
#pragma unroll
                    for (int n = 0; n < 2; ++n) *(LAS f32x4*)(mine + (ai * 2 + 0) * 64 + (bj * 2 + n) * 16 + fq * 4) = acc[ai][bj][0][n]; }
        if (fr == 15) {
#pragma unroll
            for (int ai = 0; ai < 2; ++ai)
#pragma unroll
                for (int bj = 0; bj < 2; ++bj)
#pragma unroll
                    for (int n = 0; n < 2; ++n) *(LAS f32x4*)(mine + (ai * 2 + 1) * 64 + (bj * 2 + n) * 16 + fq * 4) = acc[ai][bj][3][n]; }
        if (wr == 0 && fr == 0) { float* hp = halo + (size_t)(u.pm * 4) * FF2 + u.pn * 256 + wc * 32 + fq * 8;
#pragma unroll
            for (int bj = 0; bj < 2; ++bj)
#pragma unroll
                for (int n = 0; n < 2; ++n) { *(f32x4*)(hp + bj * HALF + n * 4) = acc[0][bj][0][n]; *(f32x4*)(hp + FF2 + bj * HALF + n * 4) = acc[0][bj][1][n]; } }
        if (wr == 1 && fr == 15) { float* hp = halo + (size_t)(u.pm * 4 + 2) * FF2 + u.pn * 256 + wc * 32 + fq * 8;
#pragma unroll
            for (int bj = 0; bj < 2; ++bj)
#pragma unroll
                for (int n = 0; n < 2; ++n) { *(f32x4*)(hp + bj * HALF + n * 4) = acc[1][bj][2][n]; *(f32x4*)(hp + FF2 + bj * HALF + n * 4) = acc[1][bj][3][n]; } }
        const int f0 = u.pn * 128 + wc * 32 + fq * 8;
        f32x4 W0[2][2], W1[2][2], W2[2][2], BB[2][2];
#pragma unroll
        for (int n = 0; n < 2; ++n)
#pragma unroll
            for (int bj = 0; bj < 2; ++bj) { const float* p = cw + bj * FF + f0 + 4 * n; W0[n][bj] = *(const f32x4*)p; W1[n][bj] = *(const f32x4*)(p + FF2); W2[n][bj] = *(const f32x4*)(p + 2 * FF2); BB[n][bj] = *(const f32x4*)(cb + bj * FF + f0 + 4 * n); }
        asm volatile("s_waitcnt lgkmcnt(0)" ::: "memory"); __builtin_amdgcn_s_barrier(); asm volatile("" ::: "memory");
        const LAS float* theirs = ex + (wid ^ 4) * 256;
        const int row0 = u.pm * BM + wr * 64 + 4 * fr;
#pragma unroll
        for (int ai = 0; ai < 2; ++ai) {
            f32x4 vpe[2][2], vne[2][2];
#pragma unroll
            for (int n = 0; n < 2; ++n)
#pragma unroll
                for (int bj = 0; bj < 2; ++bj) {
                    const bool hasp = (wr == 1) || (ai == 1); const int slotp = (wr == 1) ? (ai * 2 + 1) : 1;
                    const bool hasn = (wr == 0) || (ai == 0); const int slotn = (wr == 0) ? (ai * 2) : 2;
                    const f32x4 bp = hasp ? *(const LAS f32x4*)(theirs + slotp * 64 + (bj * 2 + n) * 16 + fq * 4) : (f32x4){0.f, 0.f, 0.f, 0.f};
                    const f32x4 bn = hasn ? *(const LAS f32x4*)(theirs + slotn * 64 + (bj * 2 + n) * 16 + fq * 4) : (f32x4){0.f, 0.f, 0.f, 0.f};
#pragma unroll
                    for (int j = 0; j < 4; ++j) { const float lastv = acc[ai][bj][3][n][j], firstv = acc[ai][bj][0][n][j];
                        vpe[n][bj][j] = dpp_shr1_old(bp[j], lastv); vne[n][bj][j] = dpp_shl1_old(bn[j], firstv); } }
#pragma unroll
            for (int m = 0; m < 4; ++m) {
                u32x4 w;
#pragma unroll
                for (int n = 0; n < 2; ++n) {
                    f32x4 up[2];
#pragma unroll
                    for (int bj = 0; bj < 2; ++bj) { const f32x4 v = acc[ai][bj][m][n];
                        const f32x4 vp = (m > 0) ? acc[ai][bj][m > 0 ? m - 1 : 0][n] : vpe[n][bj];
                        const f32x4 vn = (m < 3) ? acc[ai][bj][m < 3 ? m + 1 : 3][n] : vne[n][bj];
                        up[bj] = BB[n][bj] + W1[n][bj] * v + W0[n][bj] * vp + W2[n][bj] * vn; }
                    const f32x4 a = up[0], gt = up[1];
                    const unsigned lo = cvtpk(a.x * silu_f(gt.x), a.y * silu_f(gt.y)), hi = cvtpk(a.z * silu_f(gt.z), a.w * silu_f(gt.w));
                    if (n == 0) { w.x = lo; w.y = hi; } else { w.z = lo; w.w = hi; } }
                *(u32x4*)(act + (size_t)(row0 + ai * HALF + m) * FF + f0) = w; }
        }
    }
};

struct EpiResidNorm {
    static constexpr bool PERM = true, AFTER_DRAIN = true, APERM = false;
    const float* base; const bf16_t* baseb; bf16_t* xout; const float* gate; const float* cscale; int gcols;
    const float* nw; const float* msh; const float* msc; bf16_t* hout; float* fout;
    float* slots; unsigned* cnt;
    __device__ __forceinline__ void fused(f32x4 (&acc)[2][2][4][2], const Unit& u, int wr, int wc, int fr, int fq, LAS unsigned char* lds, int wid, int lane) const {
        LAS float* P = (LAS float*)lds; LAS float* S = (LAS float*)(lds + 4096); LAS unsigned* flag = (LAS unsigned*)(lds + 4096 + 1024);
        const int rl0 = wr * 64 + fr, row0 = u.pm * BM + rl0, col0 = u.g * gcols + u.pn * BM + wc * 32 + 8 * fq;
        const int b = u.pm >> 3, tile = (u.g * gcols) / 256 + u.pn, tid = wid * 64 + lane;
        {   const float* gv = gate + (size_t)b * NADA + col0;
            f32x4 gg[2][2];
#pragma unroll
            for (int bj = 0; bj < 2; ++bj)
#pragma unroll
                for (int n = 0; n < 2; ++n) { gg[bj][n] = *(const f32x4*)(gv + bj * HALF + n * 4); if (cscale) gg[bj][n] *= *(const f32x4*)(cscale + col0 + bj * HALF + n * 4); }
#pragma unroll
            for (int ai = 0; ai < 2; ++ai) {
                if (baseb) {
                    u32x4 bsr[4][2];
#pragma unroll
                    for (int m = 0; m < 4; ++m)
#pragma unroll
                        for (int bj = 0; bj < 2; ++bj) bsr[m][bj] = *(const u32x4*)(baseb + (size_t)(row0 + ai * HALF + m * 16) * DM + col0 + bj * HALF);
#pragma unroll
                    for (int m = 0; m < 4; ++m) { const size_t off = (size_t)(row0 + ai * HALF + m * 16) * DM + col0; float sq = 0.f;
#pragma unroll
                        for (int bj = 0; bj < 2; ++bj) { const u32x4 w = bsr[m][bj];
                            const f32x4 o0 = (f32x4){bflo(w.x), bfhi(w.x), bflo(w.y), bfhi(w.y)} + gg[bj][0] * acc[ai][bj][m][0];
                            const f32x4 o1 = (f32x4){bflo(w.z), bfhi(w.z), bflo(w.w), bfhi(w.w)} + gg[bj][1] * acc[ai][bj][m][1];
                            sq += ((o0.x * o0.x + o0.y * o0.y) + (o0.z * o0.z + o0.w * o0.w)) + ((o1.x * o1.x + o1.y * o1.y) + (o1.z * o1.z + o1.w * o1.w));
                            acc[ai][bj][m][0] = o0; acc[ai][bj][m][1] = o1;
                            if (xout) { u32x4 ov; ov.x = cvtpk(o0.x, o0.y); ov.y = cvtpk(o0.z, o0.w); ov.z = cvtpk(o1.x, o1.y); ov.w = cvtpk(o1.z, o1.w); *(u32x4*)(xout + off + bj * HALF) = ov; } }
                        sq += __shfl_xor(sq, 16); sq += __shfl_xor(sq, 32);
                        if (fq == 0) P[(rl0 + ai * HALF + m * 16) * 4 + wc] = sq; }
                } else {
                    f32x4 bsf[4][2][2];
#pragma unroll
                    for (int m = 0; m < 4; ++m)
#pragma unroll
                        for (int bj = 0; bj < 2; ++bj)
#pragma unroll
                            for (int n = 0; n < 2; ++n) bsf[m][bj][n] = *(const f32x4*)(base + (size_t)(row0 + ai * HALF + m * 16) * DM + col0 + bj * HALF + n * 4);
#pragma unroll
                    for (int m = 0; m < 4; ++m) { const size_t off = (size_t)(row0 + ai * HALF + m * 16) * DM + col0; float sq = 0.f;
#pragma unroll
                        for (int bj = 0; bj < 2; ++bj)
#pragma unroll
                            for (int n = 0; n < 2; ++n) { const f32x4 o = bsf[m][bj][n] + gg[bj][n] * acc[ai][bj][m][n];
                                sq += (o.x * o.x + o.y * o.y) + (o.z * o.z + o.w * o.w); acc[ai][bj][m][n] = o;
                                if (xout) stbf4(xout + off + bj * HALF + n * 4, o); }
                        sq += __shfl_xor(sq, 16); sq += __shfl_xor(sq, 32);
                        if (fq == 0) P[(rl0 + ai * HALF + m * 16) * 4 + wc] = sq; }
                }
                asm volatile("" ::: "memory");
            }
        }
        asm volatile("s_waitcnt lgkmcnt(0)" ::: "memory"); __builtin_amdgcn_s_barrier(); asm volatile("" ::: "memory");
        if (tid < 256) { const float tot = (P[tid * 4 + 0] + P[tid * 4 + 1]) + (P[tid * 4 + 2] + P[tid * 4 + 3]);
            __hip_atomic_store(slots + (size_t)(u.pm * BM + tid) * 8 + tile, tot, __ATOMIC_RELAXED, __HIP_MEMORY_SCOPE_AGENT); }
        asm volatile("s_waitcnt vmcnt(0)" ::: "memory");
        if (wid < 4 && lane == 0) __hip_atomic_fetch_add(cnt + 64 * u.pm, 1u, __ATOMIC_RELAXED, __HIP_MEMORY_SCOPE_AGENT);
        if (wid == 0) {
            unsigned spins = 0;
            while ((unsigned)__builtin_amdgcn_readfirstlane(__hip_atomic_load(cnt + 64 * u.pm, __ATOMIC_RELAXED, __HIP_MEMORY_SCOPE_AGENT)) < 32u) { __builtin_amdgcn_s_sleep(2); if (++spins > (1u << 20)) break; }
            __builtin_amdgcn_fence(__ATOMIC_ACQUIRE, "agent");
            if (lane == 0) flag[0] = 1u;
        }
        asm volatile("s_waitcnt vmcnt(0) lgkmcnt(0)" ::: "memory"); __builtin_amdgcn_s_barrier(); asm volatile("" ::: "memory");
        if (tid < 256) { const float* sl = slots + (size_t)(u.pm * BM + tid) * 8; float tot = 0.f;
#pragma unroll
            for (int t = 0; t < 8; ++t) tot += __hip_atomic_load(sl + t, __ATOMIC_RELAXED, __HIP_MEMORY_SCOPE_AGENT);
            S[tid] = 1.0f / sqrtf(tot * (1.0f / DM) + EPS); }
        asm volatile("s_waitcnt lgkmcnt(0)" ::: "memory"); __builtin_amdgcn_s_barrier(); asm volatile("" ::: "memory");
        f32x4 ma[2][2], mb[2][2];
#pragma unroll
        for (int bj = 0; bj < 2; ++bj)
#pragma unroll
            for (int n = 0; n < 2; ++n) { const int c = col0 + bj * HALF + n * 4; ma[bj][n] = *(const f32x4*)(nw + c); mb[bj][n] = (f32x4){0.f, 0.f, 0.f, 0.f};
                if (msc) { ma[bj][n] *= (*(const f32x4*)(msc + (size_t)b * NADA + c) + 1.0f); mb[bj][n] = *(const f32x4*)(msh + (size_t)b * NADA + c); } }
#pragma unroll
        for (int ai = 0; ai < 2; ++ai)
#pragma unroll
            for (int m = 0; m < 4; ++m) { const float rs = S[rl0 + ai * HALF + m * 16]; const size_t off = (size_t)(row0 + ai * HALF + m * 16) * DM + col0;
#pragma unroll
                for (int bj = 0; bj < 2; ++bj) { const f32x4 y0 = (acc[ai][bj][m][0] * rs) * ma[bj][0] + mb[bj][0], y1 = (acc[ai][bj][m][1] * rs) * ma[bj][1] + mb[bj][1];
                    if (hout) { u32x4 w; w.x = cvtpk(y0.x, y0.y); w.y = cvtpk(y0.z, y0.w); w.z = cvtpk(y1.x, y1.y); w.w = cvtpk(y1.z, y1.w); *(u32x4*)(hout + off + bj * HALF) = w; }
                    else { *(f32x4*)(fout + off + bj * HALF) = y0; *(f32x4*)(fout + off + bj * HALF + 4) = y1; } } }
    }
};

template <class Epi, bool ALIGN_EPI>
__device__ __forceinline__ void gemm_phase(LAS unsigned char* lds, const Gemm g, const TileOrder& S, const Epi& E, const int tid) {
    const int wid = __builtin_amdgcn_readfirstlane(tid >> 6), lane = tid & 63, wr = wid >> 2, wc = wid & 3, fr = lane & 15, fq = lane >> 4;
    const int K = g.K, nt = K / BK;
    unsigned voffA[2], voffB[2];
#pragma unroll
    for (int i = 0; i < 2; ++i) { int R, C; stage_rc(wid * 2048 + i * 1024 + lane * 16, R, C); const int Rb = Epi::PERM ? ((R & ~31) + perm32(R & 31)) : R;
        const int Ra = Epi::APERM ? ((R & ~63) + 4 * (R & 15) + ((R >> 4) & 3)) : R;
        voffA[i] = (unsigned)(Ra * g.lda + C) * 2u; voffB[i] = (unsigned)(Rb * g.ldb + C) * 2u; }
    const size_t kstep = (size_t)(BK * 2);
    const size_t hstepA = (size_t)HALF * g.lda * 2, hstepB = (size_t)HALF * g.ldb * 2;
    const unsigned ldsw = (unsigned)wid * 2048u, ldsbase = (unsigned)__builtin_amdgcn_readfirstlane((int)(unsigned)(uintptr_t)lds);
    const int aoff = lds_byte(wr * 64 + fr, fq * 8), boff = lds_byte(wc * 32 + fr, fq * 8);
#define PG8_SA(b, h) (((b) * 2 + (h)) * HTB)
#define PG8_SB(b, h) ((4 + (b) * 2 + (h)) * HTB)
#define PG8_STAGE(bufoff, gbase, voff) do { const char* gb_ = (const char*)(gbase); const char* gb1_ = gb_ - 1024; const unsigned m0v_ = ldsbase + (unsigned)(bufoff) + ldsw; \
          \
        asm volatile("s_mov_b32 m0, %0\n\ts_nop 0\n\tglobal_load_lds_dwordx4 %1, %3\n\tglobal_load_lds_dwordx4 %2, %4 offset:1024" \
                     :: "s"(m0v_), "v"((voff)[0]), "v"((voff)[1]), "s"(gb_), "s"(gb1_) : "memory", "m0"); } while (0)
#define PG8_LDA(dst, b, h) do { _Pragma("unroll") for (int m = 0; m < 4; ++m) _Pragma("unroll") for (int k = 0; k < 2; ++k) dst[m][k] = *(const LAS bf16x8*)(lds + PG8_SA(b, h) + aoff + m * 2048 + k * 1024); } while (0)
#define PG8_LDB(dst, b, h) do { _Pragma("unroll") for (int n = 0; n < 2; ++n) _Pragma("unroll") for (int k = 0; k < 2; ++k) dst[n][k] = *(const LAS bf16x8*)(lds + PG8_SB(b, h) + boff + n * 2048 + k * 1024); } while (0)
#define PG8_MMA(ai, bj, At, Bt) do { __builtin_amdgcn_s_setprio(1); _Pragma("unroll") for (int m = 0; m < 4; ++m) _Pragma("unroll") for (int n = 0; n < 2; ++n) _Pragma("unroll") for (int k = 0; k < 2; ++k) \
        acc[ai][bj][m][n] = __builtin_amdgcn_mfma_f32_16x16x32_bf16(Bt[n][k], At[m][k], acc[ai][bj][m][n], 0, 0, 0); __builtin_amdgcn_s_setprio(0); } while (0)
#define PG8_WAIT_V(n) asm volatile("s_waitcnt vmcnt(" #n ")" ::: "memory")
#define PG8_WAIT_VL8 asm volatile("s_waitcnt vmcnt(8) lgkmcnt(0)" ::: "memory")
#define PG8_WAIT_L(n) asm volatile("s_waitcnt lgkmcnt(" #n ")" ::: "memory")
#define PG8_BAR __builtin_amdgcn_s_barrier()
#define PG8_SCHED __builtin_amdgcn_sched_barrier(0)
    Unit cur, nxt; int ui = 0;
    if (!S.next(0, cur)) return;
    f32x4 acc[2][2][4][2];
#pragma unroll
    for (int a = 0; a < 2; ++a)
#pragma unroll
        for (int b = 0; b < 2; ++b)
#pragma unroll
            for (int m = 0; m < 4; ++m)
#pragma unroll
                for (int n = 0; n < 2; ++n) acc[a][b][m][n] = (f32x4){0.f, 0.f, 0.f, 0.f};
    bf16x8 At[4][2], B0[2][2], B1[2][2];
    const char* cA = (const char*)g.A + (size_t)cur.g * g.a_g + (size_t)cur.pm * 2 * hstepA; const char* cB = (const char*)g.Bt + (size_t)cur.g * g.b_g + (size_t)cur.pn * 2 * hstepB;
    PG8_STAGE(PG8_SB(0, 0), cB, voffB); PG8_STAGE(PG8_SB(0, 1), cB + hstepB, voffB); PG8_STAGE(PG8_SA(0, 0), cA, voffA); PG8_STAGE(PG8_SA(0, 1), cA + hstepA, voffA);
    if (wr == 1) PG8_BAR;
    PG8_WAIT_V(2); PG8_BAR;
    PG8_STAGE(PG8_SB(1, 0), cB + kstep, voffB); PG8_STAGE(PG8_SA(1, 0), cA + kstep, voffA); PG8_STAGE(PG8_SB(1, 1), cB + hstepB + kstep, voffB);
    PG8_WAIT_V(6); PG8_BAR;
    for (;;) {
        const bool has_next = S.next(ui + 1, nxt);
        const char* nA = has_next ? (const char*)g.A + (size_t)nxt.g * g.a_g + (size_t)nxt.pm * 2 * hstepA : cA;
        const char* nB = has_next ? (const char*)g.Bt + (size_t)nxt.g * g.b_g + (size_t)nxt.pn * 2 * hstepB : cB;
        for (int t = 0; t < nt; t += 2) {
            const bool last = (t == nt - 2);
            const char* a1 = cA + (size_t)(t + 1) * kstep;
            const char* a2 = last ? nA : cA + (size_t)(t + 2) * kstep; const char* b2 = last ? nB : cB + (size_t)(t + 2) * kstep;
            const char* a3 = a2 + kstep; const char* b3 = b2 + kstep;
            PG8_LDB(B0, 0, 0); PG8_LDB(B1, 0, 1); PG8_SCHED; PG8_LDA(At, 0, 0); PG8_STAGE(PG8_SA(1, 1), a1 + hstepA, voffA);
            PG8_WAIT_L(0); PG8_BAR; PG8_MMA(0, 0, At, B0); PG8_MMA(0, 1, At, B1); PG8_SCHED; PG8_WAIT_V(8); PG8_BAR; PG8_SCHED;
            PG8_STAGE(PG8_SA(0, 0), a2, voffA); PG8_SCHED; PG8_LDA(At, 0, 1); PG8_STAGE(PG8_SB(0, 0), b2, voffB); PG8_STAGE(PG8_SB(0, 1), b2 + hstepB, voffB);
            PG8_WAIT_L(0); PG8_BAR; PG8_MMA(1, 0, At, B0); PG8_MMA(1, 1, At, B1); PG8_SCHED; PG8_WAIT_V(8); PG8_BAR; PG8_SCHED;
            PG8_LDB(B0, 1, 0); PG8_LDB(B1, 1, 1); PG8_SCHED; PG8_LDA(At, 1, 0); PG8_STAGE(PG8_SA(0, 1), a2 + hstepA, voffA);
            PG8_WAIT_L(0); PG8_BAR; PG8_MMA(0, 0, At, B0); PG8_MMA(0, 1, At, B1); PG8_SCHED; PG8_WAIT_V(8); PG8_BAR; PG8_SCHED;
            PG8_STAGE(PG8_SA(1, 0), a3, voffA); PG8_SCHED; PG8_LDA(At, 1, 1); PG8_STAGE(PG8_SB(1, 0), b3, voffB); PG8_STAGE(PG8_SB(1, 1), b3 + hstepB, voffB);
            PG8_WAIT_L(0); PG8_BAR; PG8_MMA(1, 0, At, B0); PG8_MMA(1, 1, At, B1); PG8_SCHED; PG8_WAIT_V(8); PG8_BAR; PG8_SCHED;
        }
        if constexpr (ALIGN_EPI) { if (wr == 0) PG8_BAR; }
        if constexpr (!Epi::AFTER_DRAIN) E(acc, cur, wr, wc, fr, fq);
        if (!has_next) break;
#pragma unroll
        for (int a = 0; a < 2; ++a)
#pragma unroll
            for (int b = 0; b < 2; ++b)
#pragma unroll
                for (int m = 0; m < 4; ++m)
#pragma unroll
                    for (int n = 0; n < 2; ++n) acc[a][b][m][n] = (f32x4){0.f, 0.f, 0.f, 0.f};
        cur = nxt; cA = nA; cB = nB; ++ui;
        if constexpr (ALIGN_EPI) { if (wr == 1) PG8_BAR; }
    }
    PG8_WAIT_V(0);
    if constexpr (!ALIGN_EPI) { if (wr == 0) PG8_BAR; }
    PG8_BAR;
    if constexpr (Epi::AFTER_DRAIN) E.fused(acc, cur, wr, wc, fr, fq, lds, wid, lane);
#undef PG8_SA
#undef PG8_SB
#undef PG8_STAGE
#undef PG8_LDA
#undef PG8_LDB
#undef PG8_MMA
#undef PG8_WAIT_V
#undef PG8_WAIT_L
#undef PG8_WAIT_VL8
#undef PG8_BAR
#undef PG8_SCHED
}
__device__ __forceinline__ f32x4 pgp_y(const LAS char* Yb, const LAS float* rsd, const int j) {
    const u32x2 w = *(const LAS u32x2*)(Yb + j * 128); const float sc = rsd[j];
    return (f32x4){bflo(w.x) * sc, bfhi(w.x) * sc, bflo(w.y) * sc, bfhi(w.y) * sc};
}
}

namespace att {
constexpr int QBLK = 32, KVBLK = 64;
constexpr float SCALE = 0.072168783648703220f;
constexpr float THR = 8.f;
constexpr int SHM_V = 16384, SHM_KN = 16384, SHM_KR = 8192;
#define KSWZ(row, colB) ((row) * 256 + ((colB) ^ (((row) & 7) << 4)))
#define KRSWZ(row, colB) ((row) * 128 + ((colB) ^ (((row) & 7) << 4)))
#define SBAR() __builtin_amdgcn_sched_barrier(0)
#define LDS_BAR() asm volatile("s_waitcnt lgkmcnt(0)\n\ts_barrier" ::: "memory")
__device__ __forceinline__ int crow(int r, int hi) { return (r & 3) + 8 * (r >> 2) + 4 * hi; }
__device__ __forceinline__ void partialSM(f32x16& p0, f32x16& p1, float& m_reg, float& mn, float& alpha) {
  constexpr float C = SCALE * 1.4426950408889634f;
  float pmax = p0[0];
#pragma unroll
  for (int r = 1; r < 16; ++r) pmax = fmaxf(pmax, p0[r]);
#pragma unroll
  for (int r = 0; r < 16; ++r) pmax = fmaxf(pmax, p1[r]);
  { auto rr = __builtin_amdgcn_permlane32_swap(__float_as_uint(pmax), __float_as_uint(pmax), false, false);
    pmax = fmaxf(__uint_as_float(rr[0]), __uint_as_float(rr[1])); }
  if (__builtin_expect(__all(pmax - m_reg <= THR / SCALE), 1)) { mn = m_reg; alpha = 1.f; }
  else { mn = fmaxf(m_reg, pmax); alpha = __builtin_amdgcn_exp2f((m_reg - mn) * C); m_reg = mn; }
  float mnC = -mn * C;
#pragma unroll
  for (int r = 0; r < 16; ++r) p0[r] = fmaf(p0[r], C, mnC);
#pragma unroll
  for (int r = 0; r < 16; ++r) p1[r] = fmaf(p1[r], C, mnC);
#pragma unroll
  for (int r = 0; r < 16; ++r) p0[r] = __builtin_amdgcn_exp2f(p0[r]);
}
#define PK4(P, BASE, OUT) do { unsigned a0 = cvtpk(P[BASE + 0], P[BASE + 1]), a1 = cvtpk(P[BASE + 2], P[BASE + 3]);   \
    unsigned b0 = cvtpk(P[BASE + 4], P[BASE + 5]), b1 = cvtpk(P[BASE + 6], P[BASE + 7]);                              \
    auto r0 = __builtin_amdgcn_permlane32_swap(a0, b0, false, false); auto r1 = __builtin_amdgcn_permlane32_swap(a1, b1, false, false); \
    u32x4 w = {r0[0], r1[0], r0[1], r1[1]}; OUT = *reinterpret_cast<bf16x8*>(&w); } while (0)
__device__ __forceinline__ void finishSM(f32x16& p0, f32x16& p1, float alpha, float& l_reg, bf16x8& pa0, bf16x8& pa1, bf16x8& pa2, bf16x8& pa3) {
#pragma unroll
  for (int r = 0; r < 16; ++r) p1[r] = __builtin_amdgcn_exp2f(p1[r]);
  float ps = 0;
#pragma unroll
  for (int r = 0; r < 16; ++r) ps += p0[r];
#pragma unroll
  for (int r = 0; r < 16; ++r) ps += p1[r];
  { auto rr = __builtin_amdgcn_permlane32_swap(__float_as_uint(ps), __float_as_uint(ps), false, false);
    ps = __uint_as_float(rr[0]) + __uint_as_float(rr[1]); }
  l_reg = l_reg * alpha + ps;
  PK4(p0, 0, pa0); PK4(p0, 8, pa1); PK4(p1, 0, pa2); PK4(p1, 8, pa3);
}
__device__ __forceinline__ void qkt128(f32x16& p0, f32x16& p1, const char* Ks, const bf16x8* qr, int r32, int hi) {
#pragma unroll
  for (int d0 = 0; d0 < 8; ++d0) { int cb = (d0 * 16 + hi * 8) * 2;
    bf16x8 b0 = *reinterpret_cast<const bf16x8*>(Ks + KSWZ(r32, cb));
    bf16x8 b1 = *reinterpret_cast<const bf16x8*>(Ks + KSWZ(32 + r32, cb));
    p0 = __builtin_amdgcn_mfma_f32_32x32x16_bf16(b0, qr[d0], p0, 0, 0, 0);
    p1 = __builtin_amdgcn_mfma_f32_32x32x16_bf16(b1, qr[d0], p1, 0, 0, 0); }
}
__device__ __forceinline__ void qkt64(f32x16& p0, f32x16& p1, const char* Ks, const bf16x8* qr, int r32, int hi) {
#pragma unroll
  for (int d0 = 0; d0 < 4; ++d0) { int cb = (d0 * 16 + hi * 8) * 2;
    bf16x8 b0 = *reinterpret_cast<const bf16x8*>(Ks + KRSWZ(r32, cb));
    bf16x8 b1 = *reinterpret_cast<const bf16x8*>(Ks + KRSWZ(32 + r32, cb));
    p0 = __builtin_amdgcn_mfma_f32_32x32x16_bf16(b0, qr[d0], p0, 0, 0, 0);
    p1 = __builtin_amdgcn_mfma_f32_32x32x16_bf16(b1, qr[d0], p1, 0, 0, 0); }
}
__device__ __forceinline__ int v_st(int k, int c) { const int kk = (k & ~0xC) | ((k & 4) << 1) | ((k & 8) >> 1); return ((kk >> 3) * 4 + (c >> 5)) * 512 + ((kk & 7) * 32 + (c & 31)) * 2; }
__device__ __forceinline__ int v_rd_base(int lane) { return ((lane & 3) << 3) | (((lane >> 2) & 3) << 6) | (((lane >> 4) & 1) << 5) | (((lane >> 5) & 1) << 8); }
constexpr int v_rd_off(int d0, int ks, int half) { return d0 * 512 + ks * 4096 + half * 2048; }
template <int OFF> __device__ __forceinline__ s16x4 tr_read(int vb) {
  s16x4 r; asm volatile("ds_read_b64_tr_b16 %0, %1 offset:%2" : "=&v"(r) : "v"(vb), "i"(OFF) : "memory"); return r;
}
#define PKLH(L, H) (bf16x8){L[0], L[1], L[2], L[3], H[0], H[1], H[2], H[3]}
template <int D0> __device__ __forceinline__ void pv_one(f32x16& od, int vb, bf16x8 pa0, bf16x8 pa1, bf16x8 pa2, bf16x8 pa3) {
  const s16x4 l0 = tr_read<v_rd_off(D0, 0, 0)>(vb), h0 = tr_read<v_rd_off(D0, 0, 1)>(vb), l1 = tr_read<v_rd_off(D0, 1, 0)>(vb), h1 = tr_read<v_rd_off(D0, 1, 1)>(vb);
  const s16x4 l2 = tr_read<v_rd_off(D0, 2, 0)>(vb), h2 = tr_read<v_rd_off(D0, 2, 1)>(vb), l3 = tr_read<v_rd_off(D0, 3, 0)>(vb), h3 = tr_read<v_rd_off(D0, 3, 1)>(vb);
  asm volatile("s_waitcnt lgkmcnt(0)" ::: "memory"); SBAR();
  od = __builtin_amdgcn_mfma_f32_32x32x16_bf16(pa0, PKLH(l0, h0), od, 0, 0, 0);
  od = __builtin_amdgcn_mfma_f32_32x32x16_bf16(pa1, PKLH(l1, h1), od, 0, 0, 0);
  od = __builtin_amdgcn_mfma_f32_32x32x16_bf16(pa2, PKLH(l2, h2), od, 0, 0, 0);
  od = __builtin_amdgcn_mfma_f32_32x32x16_bf16(pa3, PKLH(l3, h3), od, 0, 0, 0);
}
__device__ __forceinline__ void pv_d0(f32x16* o, int vb, bf16x8 pa0, bf16x8 pa1, bf16x8 pa2, bf16x8 pa3) {
  pv_one<0>(o[0], vb, pa0, pa1, pa2, pa3); pv_one<1>(o[1], vb, pa0, pa1, pa2, pa3); pv_one<2>(o[2], vb, pa0, pa1, pa2, pa3); pv_one<3>(o[3], vb, pa0, pa1, pa2, pa3);
}

__device__ __forceinline__ void mla_body(const bf16_t* __restrict__ Qn, const bf16_t* __restrict__ Qr, const bf16_t* __restrict__ Kn, const bf16_t* __restrict__ Kr,
                                         const bf16_t* __restrict__ Vh, bf16_t* __restrict__ Ob, int ldo, int seq, char* lds, const int tid) {
  const int wid = tid >> 6, lane = tid & 63, r32 = lane & 31, hi = lane >> 5;
  char* V_lds = lds; char* K_lds = lds + 2 * SHM_V; char* R_lds = lds + 2 * SHM_V + 2 * SHM_KN;
  float* ws = (float*)(lds + 2 * SHM_V + 2 * SHM_KN + 2 * SHM_KR) + wid * 64; float* li_l = ws; float* al_l = ws + 32;
  float m_reg = -1e30f, l_reg = 0; f32x16 o[4] = {}; bf16x8 qr[12];
  { const bf16_t* Qw = Qn + (long)(wid * QBLK + r32) * 128 + hi * 8;
#pragma unroll
    for (int d0 = 0; d0 < 8; ++d0) qr[d0] = *reinterpret_cast<const bf16x8*>(Qw + d0 * 16);
    const bf16_t* Qw2 = Qr + (long)(wid * QBLK + r32) * 64 + hi * 8;
#pragma unroll
    for (int d0 = 0; d0 < 4; ++d0) qr[8 + d0] = *reinterpret_cast<const bf16x8*>(Qw2 + d0 * 16); }
  const int sr = tid >> 4, sc = (tid & 15) * 8, vst0 = v_st(sr, sc), vst1 = v_st(32 + sr, sc);
  const int rr = tid >> 3, rc = (tid & 7) * 8;
  const int vb0 = (int)(uintptr_t)V_lds + v_rd_base(lane);
  bf16x8 svs0, svs1, sks0, sks1, skr;
#define SLOAD(k0) do { svs0 = *reinterpret_cast<const bf16x8*>(&Vh[(long)((k0) + sr) * 128 + sc]); svs1 = *reinterpret_cast<const bf16x8*>(&Vh[(long)((k0) + 32 + sr) * 128 + sc]); \
    sks0 = *reinterpret_cast<const bf16x8*>(&Kn[(long)((k0) + sr) * 128 + sc]); sks1 = *reinterpret_cast<const bf16x8*>(&Kn[(long)((k0) + 32 + sr) * 128 + sc]); \
    skr = *reinterpret_cast<const bf16x8*>(&Kr[(long)((k0) + rr) * 64 + rc]); } while (0)
#define SWRITE(b) do { *(bf16x8*)(V_lds + (b) * SHM_V + vst0) = svs0; *(bf16x8*)(V_lds + (b) * SHM_V + vst1) = svs1; int kc = sc * 2;               \
    *(bf16x8*)(K_lds + (b) * SHM_KN + KSWZ(sr, kc)) = sks0; *(bf16x8*)(K_lds + (b) * SHM_KN + KSWZ(32 + sr, kc)) = sks1;                       \
    *(bf16x8*)(R_lds + (b) * SHM_KR + KRSWZ(rr, rc * 2)) = skr; } while (0)
#define RESC(a) do { if (__any((a) < 1.f)) { if (hi == 0) al_l[r32] = (a); asm volatile("s_waitcnt lgkmcnt(0)" ::: "memory"); \
    _Pragma("unroll") for (int d = 0; d < 4; ++d) _Pragma("unroll") for (int r = 0; r < 16; ++r) o[d][r] *= al_l[crow(r, hi)]; } } while (0)
  const int NT = seq / KVBLK;
  SLOAD(0); asm volatile("s_waitcnt vmcnt(0)" ::: "memory"); SWRITE(0); __syncthreads();
  for (int j = 0; j < NT; ++j) {
    const int buf = j & 1;
    if (j + 1 < NT) SLOAD((j + 1) * KVBLK);
    f32x16 p0 = {}, p1 = {}; float mn, al; bf16x8 pa0, pa1, pa2, pa3;
    qkt128(p0, p1, K_lds + buf * SHM_KN, qr, r32, hi); qkt64(p0, p1, R_lds + buf * SHM_KR, qr + 8, r32, hi);
    partialSM(p0, p1, m_reg, mn, al);
    RESC(al);
    finishSM(p0, p1, al, l_reg, pa0, pa1, pa2, pa3); SBAR();
    pv_d0(o, vb0 + buf * SHM_V, pa0, pa1, pa2, pa3);
    if (j + 1 < NT) { asm volatile("s_waitcnt vmcnt(0)" ::: "memory"); SWRITE(buf ^ 1); }
    __syncthreads();
  }
  if (hi == 0) li_l[r32] = l_reg; asm volatile("s_waitcnt lgkmcnt(0)" ::: "memory");
  float rli[16];
#pragma unroll
  for (int r = 0; r < 16; ++r) rli[r] = __builtin_amdgcn_rcpf(li_l[crow(r, hi)]);
  char* OT = lds + wid * 8704;
  { char* OTw = OT + (4 * hi) * 272 + r32 * 2; asm volatile("" : "+v"(OTw));
#pragma unroll
    for (int r = 0; r < 16; ++r) { const int rc = (r & 3) + 8 * (r >> 2);
#pragma unroll
      for (int d0 = 0; d0 < 4; ++d0) *(unsigned short*)(OTw + rc * 272 + d0 * 64) = (unsigned short)f2bf(o[d0][r] * rli[r]); } }
  asm volatile("s_waitcnt lgkmcnt(0)" ::: "memory");
  bf16_t* Ow = Ob + (long)(wid * QBLK) * ldo;
  { int ln = r32 + 32 * hi; asm volatile("" : "+v"(ln));
    const int rw = ln >> 4, ch = ln & 15;
#pragma unroll
    for (int i = 0; i < 8; ++i) { const int row = i * 4 + rw;
      *(u32x4*)(Ow + (long)row * ldo + ch * 8) = *(const u32x4*)(OT + row * 272 + ch * 16); } }
#undef SLOAD
#undef SWRITE
#undef RESC
}
}


#define XB_TMO      128
#define XB_XCNT(j)  (256  + 64 * (j))
#define XB_XSUB(j)  (1280 + 64 * (j))
#define XB_XGEN(j)  (2304 + 64 * (j))
#define XB_TOP      3328
#define XB_TOPGEN   3392
#define XCD_BAR_WORDS 3456
#define XB_SPIN_CAP (1u << 18)
__device__ __forceinline__ unsigned xb_ld(unsigned* p)              { return __hip_atomic_load(p, __ATOMIC_RELAXED, __HIP_MEMORY_SCOPE_AGENT); }
__device__ __forceinline__ unsigned xb_add(unsigned* p, unsigned v) { return __hip_atomic_fetch_add(p, v, __ATOMIC_RELAXED, __HIP_MEMORY_SCOPE_AGENT); }
__device__ __forceinline__ unsigned xb_xcc_id() { return (unsigned)__builtin_amdgcn_s_getreg((3 << 11) | 20) & 0xFu; }
#define XB_SPIN(cond, bar) do { unsigned _sp = 0; while (cond) { __builtin_amdgcn_s_sleep(1); \
    if ((++_sp & 255u) == 0u) { if (xb_ld(&(bar)[XB_TMO])) break; if (_sp > XB_SPIN_CAP) { atomicAdd(&(bar)[XB_TMO], 1u); break; } } } } while (0)
struct XcdBarrier { unsigned* bar; unsigned x; volatile LAS unsigned* st; };
__device__ __forceinline__ XcdBarrier xcd_barrier_post(unsigned* bar, volatile LAS unsigned* st) {
    XcdBarrier b; b.bar = bar; b.x = xb_xcc_id(); b.st = st;
    if (threadIdx.x == 0) (void)xb_add(&bar[XB_XCNT(b.x)], 1u);
    return b;
}
__device__ __forceinline__ void xcd_barrier_complete(unsigned* bar, unsigned x, unsigned& nloc, unsigned& nx) {
    const unsigned G = gridDim.x * gridDim.y * gridDim.z;
    unsigned sum, cnt, mine, sp = 0u;
    for (;;) {
        sum = 0u; cnt = 0u; mine = 0u;
#pragma unroll
        for (unsigned j = 0; j < 16; ++j) { const unsigned c = xb_ld(&bar[XB_XCNT(j)]); sum += c; cnt += (c > 0u) ? 1u : 0u; mine = (j == x) ? c : mine; }
        if (sum == G) break;
        __builtin_amdgcn_s_sleep(1);
        if ((++sp & 255u) == 0u) { if (xb_ld(&bar[XB_TMO])) break; if (sp > XB_SPIN_CAP) { atomicAdd(&bar[XB_TMO], 1u); break; } }
    }
    nloc = mine > 0u ? mine : 1u; nx = cnt > 0u ? cnt : 1u;
}
__device__ __forceinline__ void xcd_barrier(const XcdBarrier& b) {
    asm volatile("s_waitcnt vmcnt(0)" ::: "memory");
    __syncthreads();
    if (threadIdx.x == 0) {
        unsigned* bar = b.bar;
        __builtin_amdgcn_s_waitcnt(0);
        unsigned nloc = b.st[0], nx = b.st[1];
        if (nloc == 0u) { xcd_barrier_complete(bar, b.x, nloc, nx); b.st[0] = nloc; b.st[1] = nx; }
        const unsigned old = xb_add(&bar[XB_XSUB(b.x)], 1u);
        const unsigned gen = old / nloc;
        if (old + 1u == (gen + 1u) * nloc) {
            __builtin_amdgcn_fence(__ATOMIC_RELEASE, "agent");
            asm volatile("s_waitcnt vmcnt(0)" ::: "memory");
            const unsigned og = xb_add(&bar[XB_TOP], 1u);
            const unsigned tg = og / nx;
            if (og + 1u == (tg + 1u) * nx) xb_add(&bar[XB_TOPGEN], 1u);
            else XB_SPIN(xb_ld(&bar[XB_TOPGEN]) == tg, bar);
            __builtin_amdgcn_fence(__ATOMIC_ACQUIRE, "agent");
            xb_add(&bar[XB_XGEN(b.x)], 1u);
            asm volatile("s_waitcnt vmcnt(0)" ::: "memory");
        } else {
            XB_SPIN(xb_ld(&bar[XB_XGEN(b.x)]) == gen, bar);
            __builtin_amdgcn_fence(__ATOMIC_ACQUIRE, "agent");
            asm volatile("s_waitcnt vmcnt(0)" ::: "memory");
        }
    }
    __syncthreads();
}
constexpr int MISC_OFF = LDS_BYTES - 256;
constexpr size_t CTL_ZERO_BYTES = 64 * 1024;

struct Args { const float* in[23]; float* out; unsigned char* ws; int ph_lo, ph_hi; };

#ifndef ONLYMASK
#define ONLYMASK 0xffffffffu
#endif
#define EN(p) (((ONLYMASK) >> (p)) & 1u)
#ifndef REPMASK
#define REPMASK 0u
#endif
#define REP(p) (((REPMASK) >> (p)) & 1u)
enum Phase { PH_PREP = 0, PH_NORM1, PH_G1, PH_SPLIT1, PH_G2, PH_G3, PH_SPLIT2, PH_R1, PH_R2, PH_ATTN, PH_R3, PH_G4, PH_NORM2A, PH_G5, PH_CONVA, PH_G6,
             PH_RSTD, PH_POOL, PH_G7, PH_NORM2B, PH_G8, PH_CONVB, PH_G9, PH_FINAL, PH_COUNT };

__device__ __forceinline__ int map_col(int id, int n) {
    if (id == 0) return n;
    if (id == 1) { if (n < 2048) { const int j = n & 127; return (n & ~127) + (j >> 1) + (j & 1) * 64; } if (n < 4864) return n; if (n < INC) { const int j = n - 4864; return 4864 + (j >> 1) + (j & 1) * 32; } return -1; }
    if (id == 2) { if (n < 1024) return (n >> 7) * 192 + (n & 127); const int j = n - 1024, h = j >> 6, jj = j & 63; return h * 192 + 128 + (jj >> 1) + (jj & 1) * 32; }
    if (id == 3) { if (n < 1024) return (n >> 7) * 256 + (n & 127); const int j = n - 1024; return (j >> 7) * 256 + 128 + (j & 127); }
    return ((n >> 7) & 1) * FF + (n >> 8) * 128 + (n & 127);
}
__device__ __forceinline__ bool map_contig(int id, int n0) { return id == 1 ? (n0 >= 2048 && n0 + 32 <= 4864) : (id == 2 ? n0 < 1024 : true); }
struct TItem { const float* W; bf16_t* WT; const float* ks; int K, N, k0, n0, src; bool fast; };
__device__ __forceinline__ void titem_load(const TItem& t, f32x4 (&v)[8], int lane) {
    if (t.fast) { const int kr = lane >> 3, c4 = (lane & 7) * 4;
#pragma unroll
        for (int i = 0; i < 8; ++i) v[i] = __builtin_nontemporal_load((const f32x4*)(t.W + (size_t)(t.k0 + 8 * i + kr) * t.N + t.src + c4)); }
}
__device__ __forceinline__ void titem_process(const TItem& t, const f32x4 (&v)[8], LAS float* scr, int lane) {
    if (t.fast) { const int kr = lane >> 3, c4 = (lane & 7) * 4;
#pragma unroll
        for (int i = 0; i < 8; ++i) { f32x4 x = v[i]; if (t.ks) x *= t.ks[t.k0 + 8 * i + kr]; LAS float* d = scr + (8 * i + kr) * 33 + c4; d[0] = x.x; d[1] = x.y; d[2] = x.z; d[3] = x.w; }
    } else {
#pragma unroll 8
        for (int i = 0; i < 32; ++i) { const int kk = 2 * i + (lane >> 5); float x = 0.f; if (t.src >= 0) { x = t.W[(size_t)(t.k0 + kk) * t.N + t.src]; if (t.ks) x *= t.ks[t.k0 + kk]; } scr[kk * 33 + (lane & 31)] = x; }
    }
    asm volatile("s_waitcnt lgkmcnt(0)" ::: "memory");
    const int c = lane & 7;
#pragma unroll
    for (int j = 0; j < 4; ++j) { const int n = (lane >> 3) + 8 * j; const LAS float* sp = scr + (8 * c) * 33 + n;
        u32x4 o; o.x = pk2(sp[0 * 33], sp[1 * 33]); o.y = pk2(sp[2 * 33], sp[3 * 33]); o.z = pk2(sp[4 * 33], sp[5 * 33]); o.w = pk2(sp[6 * 33], sp[7 * 33]);
        *(u32x4*)(t.WT + (size_t)(t.n0 + n) * t.K + t.k0 + 8 * c) = o; }
    asm volatile("s_waitcnt lgkmcnt(0)" ::: "memory");
}


#define x_in (args.in[0])
#define c_in (args.in[1])
#define ctx_in (args.in[2])
#define cctx_in (args.in[3])
#define ada_w (args.in[4])
#define ada_b (args.in[5])
#define norm1_g (args.in[6])
#define norm2_g (args.in[7])
#define w_up (args.in[8])
#define conv_w (args.in[9])
#define conv_b (args.in[10])
#define w_down (args.in[11])
#define w_in (args.in[12])
#define qn_g (args.in[13])
#define w_uq (args.in[14])
#define kvn_g (args.in[15])
#define w_ukv (args.in[16])
#define dec_f (args.in[17])
#define dec_b (args.in[18])
#define w_out (args.in[19])
#define pool_w (args.in[20])
#define pool_scale (args.in[21])
#define final_g (args.in[22])
#define X (args.out)
#define ADA ((float*)(ws + WS_ADA))
#define RT128 ((f32x2*)(ws + WS_RT128))
#define RT64 ((f32x2*)(ws + WS_RT64))
#define RSTDQ ((float*)(ws + WS_RSTDQ))
#define RSTDKV ((float*)(ws + WS_RSTDKV))
#define RSTDX ((float*)(ws + WS_RSTDX))
#define WIN ((bf16_t*)(ws + WS_WIN))
#define WUQ ((bf16_t*)(ws + WS_WUQ))
#define WUKV ((bf16_t*)(ws + WS_WUKV))
#define WPOOL ((bf16_t*)(ws + WS_WPOOL))
#define WOUT ((bf16_t*)(ws + WS_WOUT))
#define WUP ((bf16_t*)(ws + WS_WUP))
#define WDN ((bf16_t*)(ws + WS_WDN))
#define H ((bf16_t*)(ws + WS_H))
#define XB2 ((bf16_t*)(ws + WS_MIX))
#define RQ ((bf16_t*)(ws + WS_RQ))
#define RK ((bf16_t*)(ws + WS_RK))
#define RV ((bf16_t*)(ws + WS_RV))
#define RG ((bf16_t*)(ws + WS_RG))
#define CQ ((bf16_t*)(ws + WS_CQ))
#define CKV ((bf16_t*)(ws + WS_CKV))
#define QN ((bf16_t*)(ws + WS_QN))
#define QR ((bf16_t*)(ws + WS_QR))
#define KN ((bf16_t*)(ws + WS_KN))
#define KR ((bf16_t*)(ws + WS_KR))
#define VC ((bf16_t*)(ws + WS_VC))
#define KVB ((bf16_t*)(ws + WS_KVB))
#define ST ((bf16_t*)(ws + WS_ST))
#define MIX ((bf16_t*)(ws + WS_MIX))
#define ACT ((bf16_t*)(ws + WS_ACT))
#define Z1 ((float*)(ws + WS_Z))
#define Z2 ((float*)(ws + WS_Z))
#define Z3 ((float*)(ws + WS_Z3))
#define U ((bf16_t*)(ws + WS_Z))
#define HALO ((float*)(ws + WS_Z))
#define XB ((bf16_t*)(ws + WS_XB))
#define PH_PARAMS const Args& args, unsigned char* ws, LAS unsigned char* lds, unsigned char* lds_raw, const int tid, const int lane, const int wave, const int bid, const int G, const int gw, const int NGW, const int ph
#define PH_CALL(p) args, ws, lds, lds_raw, tid, lane, wave, bid, G, gw, NGW, (p)
constexpr int CV_I0 = 32 * 160, CV_I1 = 8 * 48, CV_I2 = 4 * 64, CV_I3 = 32 * 64, CV_I4 = 32 * 352, CV_I6 = 88 * 64, CV_I8 = 8 * 16;
constexpr int CV_N0 = CV_I0 + CV_I1 + CV_I2 + CV_I3 + CV_I4 + CV_I6, CV_N1 = CV_I4 + CV_I6 + 4 * CV_I8;
__device__ __forceinline__ void convert_weights(PH_PARAMS, const int set, const int lo, const int hi, const int vw, const int nvw) {
    LAS float* scr = (LAS float*)(lds + wave * 16896);
    auto decode = [&](int it) -> TItem {
        TItem t; int r = it, nblk, id;
        if (set == 0) {
            if (r < CV_I0) { t.W = w_in; t.K = DM; t.N = INC; t.WT = WIN; t.ks = nullptr; nblk = 160; id = 1; }
            else if ((r -= CV_I0) < CV_I1) { t.W = w_uq; t.K = QRANK; t.N = 1536; t.WT = WUQ; t.ks = qn_g; nblk = 48; id = 2; }
            else if ((r -= CV_I1) < CV_I2) { t.W = w_ukv; t.K = KVRANK; t.N = 2048; t.WT = WUKV; t.ks = kvn_g; nblk = 64; id = 3; }
            else if ((r -= CV_I2) < CV_I3) { t.W = w_out; t.K = DM; t.N = DM; t.WT = WOUT; t.ks = nullptr; nblk = 64; id = 0; }
            else if ((r -= CV_I3) < CV_I4) { t.W = w_up; t.K = DM; t.N = FF2; t.WT = WUP; t.ks = nullptr; nblk = 352; id = 4; }
            else { r -= CV_I4; t.W = w_down; t.K = FF; t.N = DM; t.WT = WDN; t.ks = nullptr; nblk = 64; id = 0; }
        } else {
            if (r < CV_I4) { t.W = w_up + (size_t)DM * FF2; t.K = DM; t.N = FF2; t.WT = WUP + (size_t)FF2 * DM; t.ks = nullptr; nblk = 352; id = 4; }
            else if ((r -= CV_I4) < CV_I6) { t.W = w_down + (size_t)FF * DM; t.K = FF; t.N = DM; t.WT = WDN + (size_t)DM * FF; t.ks = nullptr; nblk = 64; id = 0; }
            else { r -= CV_I6; const int gi = r / CV_I8; r %= CV_I8; t.W = pool_w + (size_t)gi * 512 * 512; t.K = 512; t.N = 512; t.WT = WPOOL + (size_t)gi * 512 * 512; t.ks = nullptr; nblk = 16; id = 0; }
        }
        t.k0 = 64 * (r / nblk); t.n0 = 32 * (r % nblk); t.fast = map_contig(id, t.n0); t.src = map_col(id, t.fast ? t.n0 : t.n0 + (lane & 31));
        return t; };
    for (int it = lo + vw; it < hi; it += 2 * nvw) {
        const bool hb = it + nvw < hi;
        const TItem ta = decode(it), tb = decode(hb ? it + nvw : it);
        f32x4 va[8], vb[8];
        titem_load(ta, va, lane); if (hb) titem_load(tb, vb, lane);
        titem_process(ta, va, scr, lane); if (hb) titem_process(tb, vb, scr + 2112, lane);
    }
}

constexpr int CT_W_IN = 16 * 40, CT_W_UQ = 4 * 12, CT_W_UKV = 2 * 16, CT_W_OUT = 16 * 16, CT_W_UP = 16 * 88, CT_W_DN = 44 * 16, CT_POOL = 4 * 4;
constexpr int CT_N0 = CT_W_IN + CT_W_UQ + CT_W_UKV + CT_W_OUT + CT_W_UP + CT_W_DN, CT_N1 = CT_W_UP + CT_W_DN + 4 * CT_POOL;
struct CTile { const float* W; bf16_t* WT; const float* ks; int K, N, k0, n0, runA, runB, mode; };
__device__ __forceinline__ const float* ct_opaque(const float* p) { asm volatile("" : "+s"(p)); return p; }
__device__ __forceinline__ void ct_decode(const Args& args, unsigned char* ws, const int set, int r, CTile& t) {
    int ntn, nt, kt; t.ks = nullptr; t.mode = 0;
    if (set == 0 && r < CT_W_IN) { ntn = 40; kt = r / ntn; nt = r % ntn; t.W = ct_opaque(w_in); t.K = DM; t.N = INC; t.WT = WIN;
        if (nt < 16) { t.runA = nt * 128; t.runB = t.runA + 64; t.mode = 1; } else if (nt < 38) { t.runA = nt * 128; t.runB = t.runA + 64; } else if (nt == 38) { t.runA = 4864; t.runB = -1; t.mode = 2; } else { t.runA = -1; t.runB = -1; } }
    else if (set == 0 && (r -= CT_W_IN) < CT_W_UQ) { ntn = 12; kt = r / ntn; nt = r % ntn; t.W = ct_opaque(w_uq); t.K = QRANK; t.N = 1536; t.WT = WUQ; t.ks = qn_g;
        if (nt < 8) { t.runA = nt * 192; t.runB = t.runA + 64; } else { const int h0 = 2 * (nt - 8); t.runA = h0 * 192 + 128; t.runB = (h0 + 1) * 192 + 128; t.mode = 2; } }
    else if (set == 0 && (r -= CT_W_UQ) < CT_W_UKV) { ntn = 16; kt = r / ntn; nt = r % ntn; t.W = ct_opaque(w_ukv); t.K = KVRANK; t.N = 2048; t.WT = WUKV; t.ks = kvn_g;
        t.runA = nt < 8 ? nt * 256 : (nt - 8) * 256 + 128; t.runB = t.runA + 64; }
    else if (set == 0 && (r -= CT_W_UKV) < CT_W_OUT) { ntn = 16; kt = r / ntn; nt = r % ntn; t.W = ct_opaque(w_out); t.K = DM; t.N = DM; t.WT = WOUT; t.runA = nt * 128; t.runB = t.runA + 64; }
    else if (set == 0 ? (r -= CT_W_OUT) < CT_W_UP : r < CT_W_UP) { ntn = 88; kt = r / ntn; nt = r % ntn; const int l = set; t.W = ct_opaque(w_up + (size_t)l * DM * FF2); t.K = DM; t.N = FF2; t.WT = WUP + (size_t)l * FF2 * DM;
        t.runA = (nt & 1) * FF + (nt >> 1) * 128; t.runB = t.runA + 64; }
    else if ((r -= CT_W_UP) < CT_W_DN) { ntn = 16; kt = r / ntn; nt = r % ntn; const int l = set; t.W = ct_opaque(w_down + (size_t)l * FF * DM); t.K = FF; t.N = DM; t.WT = WDN + (size_t)l * DM * FF; t.runA = nt * 128; t.runB = t.runA + 64; }
    else { r -= CT_W_DN; const int gi = r / CT_POOL; r %= CT_POOL; ntn = 4; kt = r / ntn; nt = r % ntn; t.W = ct_opaque(pool_w + (size_t)gi * 512 * 512); t.K = 512; t.N = 512; t.WT = WPOOL + (size_t)gi * 512 * 512; t.runA = nt * 128; t.runB = t.runA + 64; }
    t.k0 = kt * 128; t.n0 = nt * 128;
}
__device__ __forceinline__ void ct_load(const CTile& t, f32x4 (&v)[8], const int wave, const int lane) {
    const int c = (lane & 31) * 4, run = c < 64 ? t.runA : t.runB;
    if (t.runA < 0 && t.runB < 0) {
#pragma unroll
        for (int i = 0; i < 8; ++i) v[i] = (f32x4){0.f, 0.f, 0.f, 0.f};
        return; }
    const int runc = run >= 0 ? run : t.runA;
    const float* p = t.W + (size_t)(t.k0 + wave * 16 + (lane >> 5)) * t.N + runc + (c & 63);
#pragma unroll
    for (int i = 0; i < 8; ++i) v[i] = __builtin_nontemporal_load((const f32x4*)(p + (size_t)(2 * i) * t.N));
    if (run < 0) {
#pragma unroll
        for (int i = 0; i < 8; ++i) v[i] = (f32x4){0.f, 0.f, 0.f, 0.f}; }
}
__device__ __forceinline__ void ct_put(const CTile& t, const f32x4 (&v)[8], LAS float* T, const int wave, const int lane) {
    const int c = (lane & 31) * 4, row0 = wave * 16 + (lane >> 5);
#pragma unroll
    for (int i = 0; i < 8; ++i) { f32x4 x = v[i]; const int row = row0 + 2 * i; if (t.ks) x *= t.ks[t.k0 + row]; LAS float* d = T + row * 129 + c; d[0] = x.x; d[1] = x.y; d[2] = x.z; d[3] = x.w; }
}
__device__ __forceinline__ void ct_store(const CTile& t, const LAS float* T, const int wave, const int lane) {
    const int c8 = lane & 7;
#pragma unroll
    for (int j = 0; j < 4; ++j) { const int half = j & 1, n = wave * 16 + (j >> 1) * 8 + (lane >> 3), kk0 = half * 64 + c8 * 8;
        const int lc = t.mode == 0 ? n : (t.mode == 1 ? (n >> 1) + (n & 1) * 64 : (n & 64) + ((n & 63) >> 1) + (n & 1) * 32);
        const LAS float* sp = T + kk0 * 129 + lc;
        u32x4 o; o.x = pk2(sp[0 * 129], sp[1 * 129]); o.y = pk2(sp[2 * 129], sp[3 * 129]); o.z = pk2(sp[4 * 129], sp[5 * 129]); o.w = pk2(sp[6 * 129], sp[7 * 129]);
        *(u32x4*)(t.WT + (size_t)(t.n0 + n) * t.K + t.k0 + kk0) = o; }
}
__device__ __forceinline__ void convert_tiles2(PH_PARAMS, const int set, const int lo1, const int hi1, const int lo2, const int hi2, const int vb, const int nvb) {
    const int n1 = hi1 - lo1, hi = n1 + (hi2 - lo2), lo = 0;
#define CT_IDX(v) ((v) < n1 ? lo1 + (v) : lo2 + ((v) - n1))
    LAS float* T0 = (LAS float*)lds; LAS float* T1 = (LAS float*)(lds + 66048);
    const int it = lo + vb; if (it >= hi) return;
    CTile tc, ta, tb; f32x4 vA[8], vB[8];
    ct_decode(args, ws, set, CT_IDX(it), tc); ct_load(tc, vA, wave, lane);
    __syncthreads();
    ct_put(tc, vA, T0, wave, lane);
    bool hasA = it + nvb < hi, hasB = it + 2 * nvb < hi; ta = tc; tb = tc;
    if (hasA) { ct_decode(args, ws, set, CT_IDX(it + nvb), ta); ct_load(ta, vA, wave, lane); }
    if (hasB) { ct_decode(args, ws, set, CT_IDX(it + 2 * nvb), tb); ct_load(tb, vB, wave, lane); }
    __syncthreads();
    int nx = it + 3 * nvb, cur = 0;
    for (;;) {
        ct_store(tc, cur ? T1 : T0, wave, lane);
        if (!hasA) break;
        ct_put(ta, vA, cur ? T0 : T1, wave, lane); tc = ta;
        hasA = hasB && nx < hi;
        if (hasA) { ct_decode(args, ws, set, CT_IDX(nx), ta); ct_load(ta, vA, wave, lane); }
        nx += nvb;
        __syncthreads(); cur ^= 1;
        ct_store(tc, cur ? T1 : T0, wave, lane);
        if (!hasB) break;
        ct_put(tb, vB, cur ? T0 : T1, wave, lane); tc = tb;
        hasB = hasA && nx < hi;
        if (hasB) { ct_decode(args, ws, set, CT_IDX(nx), tb); ct_load(tb, vB, wave, lane); }
        nx += nvb;
        __syncthreads(); cur ^= 1;
    }
    __syncthreads();
}
#undef CT_IDX
__device__ __forceinline__ void convert_tiles(PH_PARAMS, const int set, const int lo, const int hi, const int vb, const int nvb) { convert_tiles2(PH_CALL(ph), set, lo, hi, 0, 0, vb, nvb); }
__device__ __forceinline__ void ada_items(PH_PARAMS, const int l, const int vb, const int nvb) {
        {
            LAS float* sil = (LAS float*)lds; LAS float* red = (LAS float*)(lds + 5 * 2048 * 4);
            for (int i = tid; i < 5 * 2048; i += 512) { const int r = i >> 11, k = i & 2047; const float v = r < 4 ? c_in[r * 2048 + k] : cctx_in[k]; sil[i] = v / (1.f + expf(-v)); }
            __syncthreads();
            for (int item = vb; item < 128; item += nvb) {
                const int n0 = item * 96, kq = lane >> 3, c4 = (lane & 7) * 4;
                const float* Wp = ada_w + (size_t)l * DM * NADA + n0 + c4;
                f32x4 a[5][3];
#pragma unroll
                for (int r = 0; r < 5; ++r)
#pragma unroll
                    for (int j = 0; j < 3; ++j) a[r][j] = (f32x4){0.f, 0.f, 0.f, 0.f};
                const int kbeg = wave * 256 + kq;
                const float* wp = Wp + (size_t)kbeg * NADA; const LAS float* sp = sil + kbeg;
#define ADA_LOAD(W) do { _Pragma("unroll") for (int u = 0; u < 4; ++u) _Pragma("unroll") for (int j = 0; j < 3; ++j) W[u][j] = __builtin_nontemporal_load((const f32x4*)(wp + (size_t)(8 * u) * NADA + 32 * j)); wp += (size_t)32 * NADA; } while (0)
#define ADA_FMA(W) do { _Pragma("unroll") for (int u = 0; u < 4; ++u) _Pragma("unroll") for (int r = 0; r < 5; ++r) { const float sv = sp[r * 2048 + 8 * u]; \
                        _Pragma("unroll") for (int j = 0; j < 3; ++j) a[r][j] += W[u][j] * sv; } sp += 32; } while (0)
                f32x4 wv0[4][3], wv1[4][3];
                ADA_LOAD(wv0);
#pragma unroll 1
                for (int kk = 0; kk < 8; kk += 2) {
                    ADA_LOAD(wv1);
                    ADA_FMA(wv0);
                    if (kk + 2 < 8) ADA_LOAD(wv0);
                    ADA_FMA(wv1);
                }
#undef ADA_LOAD
#undef ADA_FMA
#pragma unroll
                for (int r = 0; r < 5; ++r)
#pragma unroll
                    for (int j = 0; j < 3; ++j) {
#pragma unroll
                        for (int q = 0; q < 4; ++q) { float v = a[r][j][q]; v += __shfl_xor(v, 8); v += __shfl_xor(v, 16); v += __shfl_xor(v, 32); a[r][j][q] = v; }
                        if (kq == 0) *(LAS f32x4*)(red + (wave * 5 + r) * 96 + 32 * j + c4) = a[r][j]; }
                __syncthreads();
                if (tid < 5 * 96) { const int r = tid / 96, j = tid % 96; float sum = ada_b[l * NADA + n0 + j];
#pragma unroll
                    for (int w = 0; w < 8; ++w) sum += red[(w * 5 + r) * 96 + j];
                    ADA[(size_t)(l * 5 + r) * NADA + n0 + j] = sum; }
                __syncthreads();
            }
            __syncthreads();
        }
}
__device__ __forceinline__ void phase_PREP(PH_PARAMS) {
        if (G == 256) ada_items(PH_CALL(ph), bid >> 7, bid & 127, 128);
        else { ada_items(PH_CALL(ph), 0, bid, G); __syncthreads(); ada_items(PH_CALL(ph), 1, bid, G); }
        asm volatile("s_waitcnt vmcnt(0)" ::: "memory"); __syncthreads();
        if (tid == 0) { __builtin_amdgcn_fence(__ATOMIC_RELEASE, "agent"); asm volatile("s_waitcnt vmcnt(0)" ::: "memory"); __hip_atomic_fetch_add((unsigned*)(ws + WS_CTL + 49152), 1u, __ATOMIC_RELAXED, __HIP_MEMORY_SCOPE_AGENT); }
    for (int i = bid * 512 + tid; i < 32768 + 8192; i += G * 512) ((float*)(ws + WS_RSTDQ))[i] = 0.f;
        for (int i = bid * 512 + tid; i < 2048 * 96; i += G * 512) {
            const int t = i / 96, e = i % 96; const float row = (float)(t >> 6), col = (float)(t & 63);
            float s, c;
            if (e < 64) { const int nf = 32; const int j = e < nf ? e : e - nf; const float inv = exp2f(-(float)j / (float)nf * 13.287712379549449f); const float ang = (e < nf ? row : col) * inv;
                sincos_acc(ang, s, c); RT128[t * 64 + e] = (f32x2){c, s}; }
            else { const int e2 = e - 64; const int nf = 16; const int j = e2 < nf ? e2 : e2 - nf; const float inv = exp2f(-(float)j / (float)nf * 13.287712379549449f); const float ang = (e2 < nf ? row : col) * inv;
                sincos_acc(ang, s, c); RT64[t * 32 + e2] = (f32x2){c, s}; }
        }
        if (G == 256) convert_tiles(PH_CALL(ph), 0, 0, CT_N0 - CT_W_DN, bid, G);
        else convert_tiles(PH_CALL(ph), 0, 0, CT_N0, bid, G);
        if (tid == 0) { unsigned spins = 0; while (__hip_atomic_load((unsigned*)(ws + WS_CTL + 49152), __ATOMIC_RELAXED, __HIP_MEMORY_SCOPE_AGENT) < (unsigned)G) { __builtin_amdgcn_s_sleep(2); if (++spins > (1u << 20)) break; }
            __builtin_amdgcn_fence(__ATOMIC_ACQUIRE, "agent"); asm volatile("s_waitcnt vmcnt(0)" ::: "memory"); }
        __syncthreads();
}
__device__ __forceinline__ void phase_NORM(PH_PARAMS) {
        const int l = (ph == PH_NORM2B); const int nrows = (ph == PH_NORM1) ? MALL : MLAT;
        const float* gvec = (ph == PH_NORM1 ? norm1_g : norm2_g) + l * DM;
        const int shc = (ph == PH_NORM1) ? 0 : 3;
        LAS float* gm = (LAS float*)lds; LAS float* sm = gm + 5 * DM;
        for (int i = tid; i < 5 * DM / 4; i += 512) { const int r = i / (DM / 4), c = (i % (DM / 4)) * 4;
            const float* sh = ADA + (size_t)(l * 5 + r) * NADA + shc * DM; const float* sc = sh + DM;
            *(LAS f32x4*)(gm + r * DM + c) = *(const f32x4*)(gvec + c) * (*(const f32x4*)(sc + c) + 1.0f); *(LAS f32x4*)(sm + r * DM + c) = *(const f32x4*)(sh + c); }
        __syncthreads();
#define NORM_ROW(m_) ((ph == PH_NORM1) ? ((m_) < MLAT ? x_in + (size_t)(m_) * DM : ctx_in + (size_t)((m_) - MLAT) * DM) : X + (size_t)(m_) * DM)
        int m = gw; if (m >= nrows) return;
        f32x4 v[8], vn[8];
        { const float* xrow = NORM_ROW(m);
#pragma unroll
          for (int j = 0; j < 8; ++j) v[j] = ((const f32x4*)xrow)[lane + 64 * j]; }
        for (;;) {
            const int mn = m + NGW; const bool more = mn < nrows;
            if (more) { const float* xn = NORM_ROW(mn);
#pragma unroll
                for (int j = 0; j < 8; ++j) vn[j] = ((const f32x4*)xn)[lane + 64 * j]; }
            const int r = (ph == PH_NORM1 && m >= MLAT) ? 4 : (m >> 11);
            float ss = 0.f;
#pragma unroll
            for (int j = 0; j < 8; ++j) ss += (v[j].x * v[j].x + v[j].y * v[j].y) + (v[j].z * v[j].z + v[j].w * v[j].w);
            const float rstd = 1.0f / sqrtf(wave_sum(ss) * (1.0f / DM) + EPS);
            bf16_t* orow = H + (size_t)m * DM;
#pragma unroll
            for (int j = 0; j < 8; ++j) { const int idx = 4 * (lane + 64 * j);
                const f32x4 y = (v[j] * rstd) * *(const LAS f32x4*)(gm + r * DM + idx) + *(const LAS f32x4*)(sm + r * DM + idx);
                u32x2 w; w.x = pk2(y.x, y.y); w.y = pk2(y.z, y.w); *(u32x2*)(orow + idx) = w; }
            if (!more) break;
#pragma unroll
            for (int j = 0; j < 8; ++j) v[j] = vn[j];
            m = mn;
        }
#undef NORM_ROW
}
__device__ __forceinline__ void phase_FINAL(PH_PARAMS) {
        for (int m = gw; m < MLAT; m += NGW) {
            float* xrow = X + (size_t)m * DM; f32x4 v[8]; float ss = 0.f;
#pragma unroll
            for (int j = 0; j < 8; ++j) { v[j] = ((const f32x4*)xrow)[lane + 64 * j]; ss += (v[j].x * v[j].x + v[j].y * v[j].y) + (v[j].z * v[j].z + v[j].w * v[j].w); }
            const float rstd = 1.0f / sqrtf(wave_sum(ss) * (1.0f / DM) + EPS);
#pragma unroll
            for (int j = 0; j < 8; ++j) { const int idx = 4 * (lane + 64 * j); const f32x4 gg = *(const f32x4*)(final_g + idx); ((f32x4*)xrow)[lane + 64 * j] = v[j] * rstd * gg; }
        }
}
__device__ __forceinline__ void phase_R1(PH_PARAMS) {
        char* ldsg = (char*)lds_raw;
        const int r32 = lane & 31, hi = lane >> 5;
        const int sr = tid >> 4, sc = (tid & 15) * 8;
        u32x4 kq[2][2], vq[2][2];
#define R1_LOAD(item_) do { const int bh_ = (item_) / NCHUNK, ci_ = (item_) % NCHUNK; const int key0_ = ci_ < 2 ? ci_ * 128 : CTX + (ci_ - 2) * 128; \
            const bf16_t* Kp_ = RK + ((size_t)bh_ * NKEY + key0_) * HD; const bf16_t* Vp_ = RV + ((size_t)bh_ * NKEY + key0_) * HD; \
            _Pragma("unroll") for (int tl = 0; tl < 2; ++tl) _Pragma("unroll") for (int hh = 0; hh < 2; ++hh) { const int m_ = 64 * tl + 32 * hh + sr; \
                kq[tl][hh] = *(const u32x4*)(Kp_ + (size_t)m_ * HD + sc); vq[tl][hh] = *(const u32x4*)(Vp_ + (size_t)m_ * HD + sc); } } while (0)
        if (bid < 32 * NCHUNK) R1_LOAD(bid);
        for (int item = bid; item < 32 * NCHUNK; item += G) {
            const int bh = item / NCHUNK, ci = item % NCHUNK, h = bh & 7;
            const float xf = dec_f[h], xb = dec_b[h];
            const float lf2 = -log1pf(expf(-xf)) * 1.4426950408889634f, lb2 = -log1pf(expf(-xb)) * 1.4426950408889634f;
#pragma unroll
            for (int tl = 0; tl < 2; ++tl)
#pragma unroll
                for (int hh = 0; hh < 2; ++hh) { const int row = 32 * hh + sr, m = 64 * tl + row;
                    const u32x4 kv = kq[tl][hh]; const u32x4 vv = vq[tl][hh];
                    const float ff = __builtin_amdgcn_exp2f((float)(127 - m) * lf2), fb = __builtin_amdgcn_exp2f((float)m * lb2);
                    u32x4 vf, vb;
                    vf.x = pk2(bflo(vv.x) * ff, bfhi(vv.x) * ff); vf.y = pk2(bflo(vv.y) * ff, bfhi(vv.y) * ff); vf.z = pk2(bflo(vv.z) * ff, bfhi(vv.z) * ff); vf.w = pk2(bflo(vv.w) * ff, bfhi(vv.w) * ff);
                    vb.x = pk2(bflo(vv.x) * fb, bfhi(vv.x) * fb); vb.y = pk2(bflo(vv.y) * fb, bfhi(vv.y) * fb); vb.z = pk2(bflo(vv.z) * fb, bfhi(vv.z) * fb); vb.w = pk2(bflo(vv.w) * fb, bfhi(vv.w) * fb);
                    const int o = att::v_st(row, sc);
                    *(u32x4*)(ldsg + tl * 16384 + o) = kv; *(u32x4*)(ldsg + 32768 + tl * 16384 + o) = vf; *(u32x4*)(ldsg + 65536 + tl * 16384 + o) = vb; }
            LDS_BAR();
            if (item + G < 32 * NCHUNK) R1_LOAD(item + G);
            const int D0 = wave & 3, eh = wave >> 2;
            const int base = (int)(uintptr_t)ldsg + att::v_rd_base(lane);
            const int kb = base + D0 * 512, fb0 = base + 32768 + (2 * eh) * 512, bb0 = base + 65536 + (2 * eh) * 512;
            f32x16 af0 = {}, af1 = {}, ab0 = {}, ab1 = {};
#define R1_STEP(TL, KS) do { const int off_ = (TL) * 16384; \
                const s16x4 kl = att::tr_read<att::v_rd_off(0, KS, 0)>(kb + off_), kh = att::tr_read<att::v_rd_off(0, KS, 1)>(kb + off_); \
                const s16x4 f0l = att::tr_read<att::v_rd_off(0, KS, 0)>(fb0 + off_), f0h = att::tr_read<att::v_rd_off(0, KS, 1)>(fb0 + off_); \
                const s16x4 f1l = att::tr_read<att::v_rd_off(1, KS, 0)>(fb0 + off_), f1h = att::tr_read<att::v_rd_off(1, KS, 1)>(fb0 + off_); \
                const s16x4 b0l = att::tr_read<att::v_rd_off(0, KS, 0)>(bb0 + off_), b0h = att::tr_read<att::v_rd_off(0, KS, 1)>(bb0 + off_); \
                const s16x4 b1l = att::tr_read<att::v_rd_off(1, KS, 0)>(bb0 + off_), b1h = att::tr_read<att::v_rd_off(1, KS, 1)>(bb0 + off_); \
                asm volatile("s_waitcnt lgkmcnt(0)" ::: "memory"); SBAR(); \
                const bf16x8 ka = PKLH(kl, kh); \
                af0 = __builtin_amdgcn_mfma_f32_32x32x16_bf16(ka, PKLH(f0l, f0h), af0, 0, 0, 0); af1 = __builtin_amdgcn_mfma_f32_32x32x16_bf16(ka, PKLH(f1l, f1h), af1, 0, 0, 0); \
                ab0 = __builtin_amdgcn_mfma_f32_32x32x16_bf16(ka, PKLH(b0l, b0h), ab0, 0, 0, 0); ab1 = __builtin_amdgcn_mfma_f32_32x32x16_bf16(ka, PKLH(b1l, b1h), ab1, 0, 0, 0); } while (0)
            R1_STEP(0, 0); R1_STEP(0, 1); R1_STEP(0, 2); R1_STEP(0, 3); R1_STEP(1, 0); R1_STEP(1, 1); R1_STEP(1, 2); R1_STEP(1, 3);
#undef R1_STEP
            LDS_BAR();
            { char* OT = ldsg + wave * 17408;
#pragma unroll
              for (int r = 0; r < 16; ++r) { const int rr = att::crow(r, hi);
                  *(float*)(OT + rr * 272 + r32 * 4) = af0[r]; *(float*)(OT + rr * 272 + (32 + r32) * 4) = af1[r];
                  *(float*)(OT + 8704 + rr * 272 + r32 * 4) = ab0[r]; *(float*)(OT + 8704 + rr * 272 + (32 + r32) * 4) = ab1[r]; }
              asm volatile("s_waitcnt lgkmcnt(0)" ::: "memory");
              bf16_t* of = KVB + ((size_t)(bh * NCHUNK + ci) * 2 + 0) * 16384 + (size_t)(32 * D0) * 128 + 64 * eh;
#pragma unroll
              for (int dir = 0; dir < 2; ++dir)
#pragma unroll
                  for (int i = 0; i < 8; ++i) { const int row = i * 4 + (lane >> 4), ch = lane & 15;
                      stbf4(of + (size_t)dir * 16384 + row * 128 + ch * 4, *(const f32x4*)(OT + dir * 8704 + row * 272 + ch * 16)); } }
            LDS_BAR();
        }
}
#undef R1_LOAD
__device__ __forceinline__ void phase_R2(PH_PARAMS) {
        for (int it = bid * 512 + tid; it < 64 * 4096; it += G * 512) {
            const int e4 = it & 4095, dir = (it >> 12) & 1, bh = it >> 13, h = bh & 7;
            const float xd = dir ? dec_b[h] : dec_f[h]; const float g128 = expf(128.f * -log1pf(expf(-xd)));
            const bf16_t* kv = KVB + ((size_t)bh * NCHUNK * 2 + dir) * 16384 + 4 * e4;
            bf16_t* st = ST + ((size_t)bh * 16 * 2 + dir) * 16384 + 4 * e4;
            u32x2 a[17];
#pragma unroll
            for (int i = 0; i < 17; ++i) { const int ci = dir == 0 ? i : (i == 0 ? 1 : (i == 1 ? 0 : 19 - i)); a[i] = *(const u32x2*)(kv + (size_t)ci * 32768); }
#define BF4(w) ((f32x4){bflo((w).x), bfhi((w).x), bflo((w).y), bfhi((w).y)})
            f32x4 S = BF4(a[0]) * g128 + BF4(a[1]);
#pragma unroll
            for (int k = 0; k < 16; ++k) { const int c = dir == 0 ? k : 15 - k; stbf4(st + (size_t)c * 32768, S);
                if (k < 15) S = S * g128 + BF4(a[2 + k]); }
#undef BF4
        }
}
__device__ __forceinline__ void phase_ATTN(PH_PARAMS) {
        for (int item = bid; item < 256; item += G) {
            const int xcd = item & 7, slot = item >> 3, bh = xcd * 4 + (slot >> 3), qb = slot & 7, b = bh >> 3, h = bh & 7;
            att::mla_body(QN + ((size_t)bh * SEQ + qb * 256) * HD, QR + ((size_t)bh * SEQ + qb * 256) * DR, KN + (size_t)bh * NKEY * HD, KR + (size_t)b * NKEY * DR, VC + (size_t)bh * NKEY * HD,
                          MIX + ((size_t)(b * SEQ + qb * 256)) * DM + 1024 + h * HD, DM, NKEY, (char*)lds_raw, tid);
            __syncthreads();
        }
}
__device__ __forceinline__ void phase_R3(PH_PARAMS) {
        char* ldsg = (char*)lds_raw;
        const int r32 = lane & 31, hi = lane >> 5;
        const int sr = tid >> 4, sc = (tid & 15) * 8;
        float* part = (float*)(ldsg + 131072);
        for (int item = bid; item < 32 * 16; item += G) {
            const int bh = item >> 4, c = item & 15, b = bh >> 3, h = bh & 7;
            const float xf = dec_f[h], xb = dec_b[h];
            const float lf2 = -log1pf(expf(-xf)) * 1.4426950408889634f, lb2 = -log1pf(expf(-xb)) * 1.4426950408889634f;
            const bf16_t* Kp = RK + ((size_t)bh * NKEY + CTX + c * 128) * HD; const bf16_t* Vp = RV + ((size_t)bh * NKEY + CTX + c * 128) * HD;
            const bf16_t* Sp = ST + (size_t)(bh * 16 + c) * 32768;
            { u32x4 t0[4], t1[4];
#pragma unroll
              for (int q = 0; q < 4; ++q) { const int tl = q >> 1, hh = q & 1; const int row = 32 * hh + sr, m = 64 * tl + row;
                  t0[q] = *(const u32x4*)(Kp + (size_t)m * HD + sc); t1[q] = *(const u32x4*)(Vp + (size_t)m * HD + sc); }
#pragma unroll
              for (int q = 0; q < 4; ++q) { const int tl = q >> 1, hh = q & 1; const int row = 32 * hh + sr;
                  *(u32x4*)(ldsg + tl * 16384 + KSWZ(row, sc * 2)) = t0[q]; *(u32x4*)(ldsg + 32768 + tl * 16384 + att::v_st(row, sc)) = t1[q]; }
              asm volatile("" ::: "memory");
#pragma unroll
              for (int q = 0; q < 8; ++q) { const int tl = q >> 1, hh = q & 1; const int row = 32 * hh + sr, m = 64 * tl + row;
                  if (q < 4) t0[q] = *(const u32x4*)(Sp + (size_t)m * 128 + sc); else t1[q - 4] = *(const u32x4*)(Sp + (size_t)m * 128 + sc); }
#pragma unroll
              for (int q = 0; q < 8; ++q) { const int tl = q >> 1, hh = q & 1; const int row = 32 * hh + sr;
                  *(u32x4*)(ldsg + 65536 + tl * 16384 + att::v_st(row, sc)) = (q < 4) ? t0[q] : t1[q - 4]; }
              asm volatile("" ::: "memory"); }
            const int qw = wave & 3, ch = wave >> 2; int n = 32 * qw + r32;
            asm volatile("" : "+v"(n));
            bf16x8 qr[8];
            { const bf16_t* Qw = RQ + ((size_t)bh * SEQ + c * 128 + n) * HD + hi * 8;
#pragma unroll
              for (int d0 = 0; d0 < 8; ++d0) qr[d0] = *reinterpret_cast<const bf16x8*>(Qw + d0 * 16); }
            __syncthreads();
            f32x16 o0 = {}, o1 = {};
            const int vb = (int)(uintptr_t)ldsg + att::v_rd_base(lane);
#pragma unroll
            for (int tl = 0; tl < 2; ++tl) {
                f32x16 p0 = {}, p1 = {};
                att::qkt128(p0, p1, ldsg + tl * 16384, qr, r32, hi);
#pragma unroll
                for (int r = 0; r < 16; ++r) { const float d0f = (float)(n - (64 * tl + att::crow(r, hi))), d1f = d0f - 32.f;
                    p0[r] *= __builtin_amdgcn_exp2f(fmaxf(d0f, 0.f) * lf2 + fmaxf(-d0f, 0.f) * lb2);
                    p1[r] *= __builtin_amdgcn_exp2f(fmaxf(d1f, 0.f) * lf2 + fmaxf(-d1f, 0.f) * lb2); }
                bf16x8 pa0, pa1, pa2, pa3;
                PK4(p0, 0, pa0); PK4(p0, 8, pa1); PK4(p1, 0, pa2); PK4(p1, 8, pa3);
                const int vt = vb + 32768 + tl * 16384;
                if (ch == 0) { att::pv_one<0>(o0, vt, pa0, pa1, pa2, pa3); att::pv_one<1>(o1, vt, pa0, pa1, pa2, pa3); }
                else { att::pv_one<2>(o0, vt, pa0, pa1, pa2, pa3); att::pv_one<3>(o1, vt, pa0, pa1, pa2, pa3); }
            }
#pragma unroll 1
            for (int dir = 0; dir < 2; ++dir) {
                const float sf = __builtin_amdgcn_exp2f(dir == 0 ? (float)(n + 1) * lf2 : (float)(128 - n) * lb2);
#pragma unroll
                for (int kt = 0; kt < 2; ++kt) {
                    bf16x8 qs[4];
#pragma unroll
                    for (int d0 = 0; d0 < 4; ++d0) { const u32x4 w = *reinterpret_cast<const u32x4*>(&qr[4 * kt + d0]); u32x4 o;
                        o.x = cvtpk(bflo(w.x) * sf, bfhi(w.x) * sf); o.y = cvtpk(bflo(w.y) * sf, bfhi(w.y) * sf); o.z = cvtpk(bflo(w.z) * sf, bfhi(w.z) * sf); o.w = cvtpk(bflo(w.w) * sf, bfhi(w.w) * sf);
                        qs[d0] = *reinterpret_cast<const bf16x8*>(&o); }
                    const int vt = vb + 65536 + (dir * 2 + kt) * 16384;
                    if (ch == 0) { att::pv_one<0>(o0, vt, qs[0], qs[1], qs[2], qs[3]); att::pv_one<1>(o1, vt, qs[0], qs[1], qs[2], qs[3]); }
                    else { att::pv_one<2>(o0, vt, qs[0], qs[1], qs[2], qs[3]); att::pv_one<3>(o1, vt, qs[0], qs[1], qs[2], qs[3]); } }
            }
            float sq[16];
#pragma unroll
            for (int r = 0; r < 16; ++r) { float v = o0[r] * o0[r] + o1[r] * o1[r];
                v += __shfl_xor(v, 1); v += __shfl_xor(v, 2); v += __shfl_xor(v, 4); v += __shfl_xor(v, 8); v += __shfl_xor(v, 16); sq[r] = v; }
            if (r32 == 0) {
#pragma unroll
                for (int r = 0; r < 16; ++r) part[ch * 128 + 32 * qw + att::crow(r, hi)] = sq[r]; }
            __syncthreads();
            { float* OT = (float*)ldsg;
              float* OTb = OT + (32 * qw + 4 * hi) * 132 + 64 * ch + r32; const float* pb = part + 32 * qw + 4 * hi;
              asm volatile("" : "+v"(OTb), "+v"(pb));
#pragma unroll
              for (int r = 0; r < 16; ++r) { const int rc = (r & 3) + 8 * (r >> 2); const float tot = pb[rc] + pb[128 + rc];
                  const float rn = 1.0f / sqrtf(tot * (1.0f / 128.f) + EPS);
                  OTb[rc * 132] = o0[r] * rn; OTb[rc * 132 + 32] = o1[r] * rn; }
              __syncthreads();
              const int orow = tid >> 2, oc0 = (tid & 3) * 32; const size_t grow = (size_t)b * SEQ + c * 128 + orow;
              const bf16_t* gp = RG + grow * 1024 + h * HD + oc0; bf16_t* mp = MIX + grow * DM + h * HD + oc0; const float* op = OT + orow * 132 + oc0;
#pragma unroll
              for (int q = 0; q < 4; ++q) { const u32x4 gw4 = *(const u32x4*)(gp + 8 * q); const f32x4 a = *(const f32x4*)(op + 8 * q), bq = *(const f32x4*)(op + 8 * q + 4);
                  u32x4 w; w.x = pk2(a.x * silu_f(bflo(gw4.x)), a.y * silu_f(bfhi(gw4.x))); w.y = pk2(a.z * silu_f(bflo(gw4.y)), a.w * silu_f(bfhi(gw4.y)));
                  w.z = pk2(bq.x * silu_f(bflo(gw4.z)), bq.y * silu_f(bfhi(gw4.z))); w.w = pk2(bq.z * silu_f(bflo(gw4.w)), bq.w * silu_f(bfhi(gw4.w)));
                  *(u32x4*)(mp + 8 * q) = w; } }
            __syncthreads();
        }
}
__device__ __forceinline__ void phase_POOL(PH_PARAMS) {
    LAS float* Y = (LAS float*)lds;
    const float* gvec = norm1_g + DM; const float* ssq = RSTDX;
    const int c4 = (tid & 63) * 4, rg = tid >> 6;
    u32x2 raw[10]; float q[10]; f32x4 g0, g1;
#define POOL_LOAD(item_) do { const int tt_ = (item_) >> 3, cb_ = (item_) & 7, b_ = tt_ >> 5, t0_ = (tt_ & 31) * 64; \
        _Pragma("unroll") for (int i = 0; i < 10; ++i) { const int t_ = t0_ - 8 + i * 8 + rg; raw[i] = (u32x2){0u, 0u}; q[i] = 1.0f; \
            if (t_ >= 0 && t_ < SEQ) { const size_t row_ = (size_t)b_ * SEQ + t_; raw[i] = *(const u32x2*)(XB + row_ * DM + cb_ * 256 + c4); q[i] = ssq[row_]; } } \
        g0 = *(const f32x4*)(gvec + cb_ * 256 + c4); g1 = *(const f32x4*)(ADA + (size_t)(5 + b_) * NADA + DM + cb_ * 256 + c4); } while (0)
    int item = bid; if (item >= 1024) return;
    POOL_LOAD(item);
    for (;;) {
        const int tt = item >> 3, cb = item & 7, b = tt >> 5, t0 = (tt & 31) * 64, gi = cb >> 1, hw = 1 << gi;
#pragma unroll
        for (int i = 0; i < 10; ++i) { const int lr = i * 8 + rg; const float rs = 1.0f / sqrtf(q[i] * (1.0f / DM) + EPS);
            *(LAS f32x4*)(Y + lr * 256 + c4) = (f32x4){bflo(raw[i].x), bfhi(raw[i].x), bflo(raw[i].y), bfhi(raw[i].y)} * rs; }
        const f32x4 gm = g0 * (g1 + 1.0f);
        LDS_BAR();
        const int nitem = item + G; const bool more = nitem < 1024;
        if (more) POOL_LOAD(nitem);
        const int r0 = rg * 8;
        f32x4 S = {0.f, 0.f, 0.f, 0.f};
        for (int u = -hw; u < hw; ++u) S += *(const LAS f32x4*)(Y + (r0 + 8 + u) * 256 + c4);
#pragma unroll
        for (int r = 0; r < 8; ++r) { const int t = t0 + r0 + r; int lo = t - hw, hi = t + hw; lo = lo < 0 ? 0 : lo; hi = hi > SEQ ? SEQ : hi;
            const f32x4 own = *(const LAS f32x4*)(Y + (r0 + r + 8) * 256 + c4);
            const f32x4 p = (S * (1.0f / (float)(hi - lo)) - own) * gm;
            u32x2 o; o.x = pk2(p.x, p.y); o.y = pk2(p.z, p.w); *(u32x2*)(MIX + ((size_t)b * SEQ + t) * DM + cb * 256 + c4) = o;
            S += *(const LAS f32x4*)(Y + (r0 + r + 8 + hw) * 256 + c4) - *(const LAS f32x4*)(Y + (r0 + r + 8 - hw) * 256 + c4); }
        LDS_BAR();
        if (!more) break;
        item = nitem;
    }
#undef POOL_LOAD
}
__device__ __forceinline__ void phase_GEMM_G1(PH_PARAMS) {
    pg8::Gemm g{H, WIN, DM, DM, DM, 0, 0}; pg8::TileOrder S; S.init(MALL / 256, INP / 256, 1, G, bid); pg8::EpiSplit1 E{ws};
    pg8::gemm_phase<pg8::EpiSplit1, true>(lds, g, S, E, tid);
    if (G == 256 && bid >= 208) convert_tiles(PH_CALL(ph), 0, CT_N0 - CT_W_DN, CT_N0, bid - 208, 48);
}
__device__ __forceinline__ void phase_GEMM_LR(PH_PARAMS) {
    pg8::Gemm g; pg8::TileOrder S; pg8::EpiLowRank E;
    if (ph == PH_G2) { g = pg8::Gemm{CQ, WUQ, QRANK, QRANK, QRANK, 0, 0}; S.init(MLAT / 256, 1536 / 256, 1, G, bid); E = pg8::EpiLowRank{ws, 0}; }
    else { g = pg8::Gemm{CKV, WUKV, KVRANK, KVRANK, KVRANK, 0, 0}; S.init(MALL / 256, 2048 / 256, 1, G, (bid + 64) % G); E = pg8::EpiLowRank{ws, 1}; }
    pg8::gemm_phase<pg8::EpiLowRank, true>(lds, g, S, E, tid);
}
__device__ __forceinline__ void phase_GEMM_UP(PH_PARAMS) {
    const int l = (ph == PH_G8);
    pg8::Gemm g{H, WUP + (size_t)l * FF2 * DM, DM, DM, DM, 0, 0}; pg8::TileOrder S; S.init(MLAT / 256, FF2 / 256, 1, G, bid);
    pg8::EpiConv E{conv_w + (size_t)l * 3 * FF2, conv_b + (size_t)l * FF2, ACT, HALO, (LAS float*)(lds + 131072)};
    pg8::gemm_phase<pg8::EpiConv, true>(lds, g, S, E, tid);
    if (ph == PH_G5) { if (G == 256 && bid >= 128) { convert_tiles(PH_CALL(ph), 1, 0, CT_W_UP, bid - 128, 128); convert_tiles(PH_CALL(ph), 1, CT_W_UP + CT_W_DN, CT_N1, bid - 128, 128);
                                                    }
                       else if (G != 256) convert_tiles(PH_CALL(ph), 1, 0, CT_N1, bid, G); }
    if (ph == PH_G8 && G == 256 && bid >= 128) convert_tiles(PH_CALL(ph), 1, CT_W_UP, CT_W_UP + CT_W_DN, bid - 128, 128);
}
__device__ __forceinline__ void conv_fixup(PH_PARAMS, const int pm) {
    const int l = (ph == PH_G9); const float* cw = conv_w + (size_t)l * 3 * FF2; const float* cb = conv_b + (size_t)l * FF2;
    const int pmm = pm & 7;
    for (int idx = tid; idx < 2 * (FF / 4); idx += 512) {
        const int which = idx / (FF / 4), f = (idx % (FF / 4)) * 4; const int cd = 256 * (f >> 7) + (f & 127);
        const float* hup; const float* hcur; const float* hdn; bool zup = false, zdn = false;
        if (which == 0) { hup = HALO + (size_t)((pm - 1) * 4 + 3) * FF2; hcur = HALO + (size_t)(pm * 4 + 0) * FF2; hdn = HALO + (size_t)(pm * 4 + 1) * FF2; zup = (pmm == 0); if (zup) hup = hcur; }
        else { hup = HALO + (size_t)(pm * 4 + 2) * FF2; hcur = HALO + (size_t)(pm * 4 + 3) * FF2; hdn = HALO + (size_t)((pm + 1) * 4 + 0) * FF2; zdn = (pmm == 7); if (zdn) hdn = hcur; }
        f32x4 up[2];
#pragma unroll
        for (int bj = 0; bj < 2; ++bj) { const int c = cd + bj * 128; const float* p = cw + bj * FF + f;
            f32x4 vu = *(const f32x4*)(hup + c), vc = *(const f32x4*)(hcur + c), vd = *(const f32x4*)(hdn + c);
            if (zup) vu = (f32x4){0.f, 0.f, 0.f, 0.f}; if (zdn) vd = (f32x4){0.f, 0.f, 0.f, 0.f};
            up[bj] = *(const f32x4*)(cb + bj * FF + f) + *(const f32x4*)p * vu + *(const f32x4*)(p + FF2) * vc + *(const f32x4*)(p + 2 * FF2) * vd; }
        const f32x4 a = up[0], gt = up[1];
        u32x2 w; w.x = pk2(a.x * silu_f(gt.x), a.y * silu_f(gt.y)); w.y = pk2(a.z * silu_f(gt.z), a.w * silu_f(gt.w));
        *(u32x2*)(ACT + (size_t)(pm * 256 + (which ? 255 : 0)) * FF + f) = w;
    }
}
__device__ __forceinline__ void phase_GEMM_RES(PH_PARAMS) {
    pg8::Gemm g{ACT, WDN, FF, FF, FF, 0, 0}; pg8::TileOrder S; S.init(MLAT / 256, DM / 256, 1, G, bid); pg8::EpiResid E{XB, XB, ADA + 5 * DM, nullptr, 0, RSTDX};
    { pg8::Unit uu; for (int i = 0; S.next(i, uu); ++i) conv_fixup(args, ws, lds, lds_raw, tid, lane, wave, bid, G, gw, NGW, ph, uu.pm);
        asm volatile("s_waitcnt vmcnt(0)" ::: "memory"); __syncthreads(); }
    pg8::gemm_phase<pg8::EpiResid, false>(lds, g, S, E, tid);
}
__device__ __forceinline__ void phase_GEMM_POOL(PH_PARAMS) {
    using namespace pg8;
    TileOrder S; S.init(MLAT / 256, 2, 4, G, bid);
    const bf16_t* xb = XB; const float* ssq = RSTDX; const float* gvec = norm1_g + DM; const float* sc1 = ADA + 5 * NADA + DM; const bf16_t* Wp = WPOOL;
    constexpr int SA0 = 0, SB0 = 32768, YOFF = 98304, RSD = YOFF + 272 * 128, GMV = RSD + 272 * 4;
    static_assert(GMV + 512 * 4 <= 147456 - 256, "pool GEMM LDS map");
#define PGP_BAR asm volatile("s_waitcnt lgkmcnt(0)\n\ts_barrier" ::: "memory")
#define PGP_ISSUE_B(kt_) do { const int slot_ = (kt_) & 1; \
        _Pragma("unroll") for (int h_ = 0; h_ < 2; ++h_) _Pragma("unroll") for (int i_ = 0; i_ < 2; ++i_) \
            __builtin_amdgcn_global_load_lds((const unsigned*)(cB + (size_t)h_ * (128 * 512 * 2) + (size_t)(kt_) * 128 + voffB[i_]), (LAS unsigned*)(lds + SB0 + slot_ * 32768 + h_ * 16384 + ldsw + i_ * 8192), 16, 0, 0); } while (0)
#define PGP_ISSUE_Y(kt_) do { \
        _Pragma("unroll") for (int q_ = 0; q_ < 5; ++q_) { const int iq_ = wid + 8 * q_; if (iq_ < 34) { int t_ = t0 - 8 + iq_ * 8 + (lane >> 3); t_ = t_ < 0 ? 0 : (t_ > SEQ - 1 ? SEQ - 1 : t_); \
            __builtin_amdgcn_global_load_lds((const unsigned*)(xrow0 + (size_t)t_ * DM + (kt_) * 64 + (lane & 7) * 8), (LAS unsigned*)(lds + YOFF + iq_ * 1024), 16, 0, 0); } } } while (0)
    Unit cur;
    for (int ui = 0; S.next(ui, cur); ++ui) {
        int tq = threadIdx.x; asm volatile("" : "+v"(tq));
        const int wid = __builtin_amdgcn_readfirstlane(tq >> 6), lane = tq & 63, wr = wid >> 2, wc = wid & 3, fr = lane & 15, fq = lane >> 4;
        unsigned voffB[2];
#pragma unroll
        for (int i = 0; i < 2; ++i) { int R, C; stage_rc(tq * 16 + i * 8192, R, C); const int Rb = (R & ~31) + perm32(R & 31); voffB[i] = (unsigned)(Rb * 512 + C) * 2u; }
        const unsigned ldsw = (unsigned)wid * 1024u;
        const int aoff = lds_byte(wr * 64 + fr, fq * 8), boff = lds_byte(wc * 32 + fr, fq * 8);
        const int cg = tq & 15, seg = tq >> 4;
        const int b = cur.pm >> 3, t0 = (cur.pm & 7) * 256, hw = 1 << cur.g, kc0 = cur.g * 512;
        const bf16_t* xrow0 = xb + (size_t)b * SEQ * DM + kc0;
        const char* cB = (const char*)(Wp + (size_t)cur.g * 512 * 512 + (size_t)cur.pn * 256 * 512);
        PGP_ISSUE_Y(0); PGP_ISSUE_B(0);
        if (tq < 272) { const int t = t0 - 8 + tq; float rs = 0.f; if (t >= 0 && t < SEQ) rs = 1.0f / sqrtf(ssq[(size_t)b * SEQ + t] * (1.0f / DM) + EPS); *(LAS float*)(lds + RSD + tq * 4) = rs; }
        *(LAS float*)(lds + GMV + tq * 4) = gvec[kc0 + tq] * (sc1[(size_t)b * NADA + kc0 + tq] + 1.0f);
        f32x4 acc[2][2][4][2];
#pragma unroll
        for (int a = 0; a < 2; ++a)
#pragma unroll
            for (int bb = 0; bb < 2; ++bb)
#pragma unroll
                for (int m = 0; m < 4; ++m)
#pragma unroll
                    for (int n = 0; n < 2; ++n) acc[a][bb][m][n] = (f32x4){0.f, 0.f, 0.f, 0.f};
#pragma unroll 1
        for (int kt = 0; kt < 8; ++kt) {
            asm volatile("s_waitcnt vmcnt(0)" ::: "memory"); PGP_BAR;
            if (kt + 1 < 8) PGP_ISSUE_B(kt + 1);
            {   const LAS char* Yb = (const LAS char*)(lds + YOFF + cg * 8); const LAS float* rsd = (const LAS float*)(lds + RSD);
                const int r0 = seg * 8;
                const f32x4 gm = *(const LAS f32x4*)(lds + GMV + (kt * 64 + cg * 4) * 4);
                f32x4 Sv = {0.f, 0.f, 0.f, 0.f};
                for (int u = -hw; u < hw; ++u) Sv += pgp_y(Yb, rsd, r0 + 8 + u);
                LAS unsigned char* arow = lds + SA0 + (r0 >> 7) * 16384 + lds_byte(r0 & 127, cg * 4);
                const LAS char* yq = Yb + (r0 + 8) * 128; const LAS float* rq = rsd + r0 + 8;
#pragma unroll 1
                for (int r = 0; r < 8; ++r) { const int t = t0 + r0 + r; int lo = t - hw, hi = t + hw; lo = lo < 0 ? 0 : lo; hi = hi > SEQ ? SEQ : hi;
                    const f32x4 own = pgp_y(yq, rq, 0);
                    const f32x4 p = (Sv * __builtin_amdgcn_rcpf((float)(hi - lo)) - own) * gm;
                    u32x2 o; o.x = pk2(p.x, p.y); o.y = pk2(p.z, p.w);
                    *(LAS u32x2*)arow = o;
                    Sv += pgp_y(yq, rq, hw) - pgp_y(yq, rq, -hw);
                    arow += 64; yq += 128; rq += 1; }
            }
            PGP_BAR;
            if (kt + 1 < 8) PGP_ISSUE_Y(kt + 1);
            {   const int sb = SB0 + (kt & 1) * 32768; bf16x8 At[4][2], B0[2][2], B1[2][2];
#pragma unroll
                for (int n = 0; n < 2; ++n)
#pragma unroll
                    for (int k = 0; k < 2; ++k) { B0[n][k] = *(const LAS bf16x8*)(lds + sb + boff + n * 2048 + k * 1024); B1[n][k] = *(const LAS bf16x8*)(lds + sb + 16384 + boff + n * 2048 + k * 1024); }
#pragma unroll
                for (int ai = 0; ai < 2; ++ai) {
#pragma unroll
                    for (int m = 0; m < 4; ++m)
#pragma unroll
                        for (int k = 0; k < 2; ++k) At[m][k] = *(const LAS bf16x8*)(lds + SA0 + ai * 16384 + aoff + m * 2048 + k * 1024);
                    asm volatile("s_waitcnt lgkmcnt(0)" ::: "memory");
#pragma unroll
                    for (int m = 0; m < 4; ++m)
#pragma unroll
                        for (int n = 0; n < 2; ++n)
#pragma unroll
                            for (int k = 0; k < 2; ++k) { acc[ai][0][m][n] = __builtin_amdgcn_mfma_f32_16x16x32_bf16(B0[n][k], At[m][k], acc[ai][0][m][n], 0, 0, 0);
                                                          acc[ai][1][m][n] = __builtin_amdgcn_mfma_f32_16x16x32_bf16(B1[n][k], At[m][k], acc[ai][1][m][n], 0, 0, 0); }
                }
            }
        }
        asm volatile("s_waitcnt vmcnt(0)" ::: "memory"); PGP_BAR;
        {
            const EpiResidNorm E{nullptr, XB, XB2, ADA + 5 * NADA + 2 * DM, pool_scale, 512, norm2_g + DM, ADA + 5 * NADA + 3 * DM, ADA + 5 * NADA + 4 * DM, H, nullptr,
                                 (float*)(ws + WS_SLOTS), (unsigned*)(ws + WS_CTL + 16384) + 32 * 64};
            E.fused(acc, cur, wr, wc, fr, fq, lds, wid, lane); }
        asm volatile("s_waitcnt vmcnt(0)" ::: "memory"); PGP_BAR;
    }
#undef PGP_BAR
#undef PGP_ISSUE_B
#undef PGP_ISSUE_Y
}
__device__ __forceinline__ void phase_GEMM_RN(PH_PARAMS) {
    pg8::Gemm g; pg8::TileOrder S; pg8::EpiResidNorm E;
    float* slots = (float*)(ws + WS_SLOTS); unsigned* cntb = (unsigned*)(ws + WS_CTL + 16384);
    if (ph == PH_G4) { g = pg8::Gemm{MIX, WOUT, DM, DM, DM, 0, 0}; S.init(MLAT / 256, DM / 256, 1, G, bid);
        E = pg8::EpiResidNorm{x_in, nullptr, XB, ADA + 2 * DM, nullptr, 0, norm2_g, ADA + 3 * DM, ADA + 4 * DM, H, nullptr, slots, cntb}; }
    else if (ph == PH_G7) { return; }
    else { g = pg8::Gemm{ACT, WDN + (size_t)DM * FF, FF, FF, FF, 0, 0}; S.init(MLAT / 256, DM / 256, 1, G, bid);
        E = pg8::EpiResidNorm{nullptr, XB2, nullptr, ADA + 5 * NADA + 5 * DM, nullptr, 0, final_g, nullptr, nullptr, nullptr, X, slots, cntb + 64 * 64}; }
    if (ph == PH_G9) { pg8::Unit uu; for (int i = 0; S.next(i, uu); ++i) conv_fixup(args, ws, lds, lds_raw, tid, lane, wave, bid, G, gw, NGW, ph, uu.pm);
        asm volatile("s_waitcnt vmcnt(0)" ::: "memory"); __syncthreads(); }
    pg8::gemm_phase<pg8::EpiResidNorm, false>(lds, g, S, E, tid);
}
__global__ void __launch_bounds__(512, 2) mega(Args args) {
    extern __shared__ __attribute__((aligned(16))) unsigned char lds_raw[];
    LAS unsigned char* lds = (LAS unsigned char*)lds_raw;
    const int G = gridDim.x, bid = blockIdx.x;
    const int NGW = G * 8;
#define PH_LOCALS int tid_ = threadIdx.x; asm volatile("" : "+v"(tid_)); const int tid = tid_, lane = tid & 63, wave = __builtin_amdgcn_readfirstlane(tid >> 6), gw = bid * 8 + wave; (void)lane; (void)gw;
    unsigned char* ws = args.ws;
    const int lo = args.ph_lo, hi = args.ph_hi;
    volatile LAS unsigned* MISC = (volatile LAS unsigned*)(lds + MISC_OFF);
    if (threadIdx.x < 64) MISC[threadIdx.x] = 0u;
    __syncthreads();
    XcdBarrier bar; bar.bar = (unsigned*)(ws + WS_CTL); bar.x = 0; bar.st = nullptr;
    if (hi - lo > 1) bar = xcd_barrier_post((unsigned*)(ws + WS_CTL), MISC + 8);
#define IN(k) (EN(k) && lo <= (k) && (k) < hi)
#define SEAM(k) do { if ((k) + 1 < hi) xcd_barrier(bar); else __syncthreads(); } while (0)
    if (IN(PH_PREP)) { { PH_LOCALS phase_PREP(PH_CALL(PH_PREP)); } { PH_LOCALS phase_NORM(PH_CALL(PH_NORM1)); } SEAM(PH_NORM1); }
    if (IN(PH_G1)) { PH_LOCALS phase_GEMM_G1(PH_CALL(PH_G1)); SEAM(PH_G1); }
    if (IN(PH_G2)) { { PH_LOCALS phase_GEMM_LR(PH_CALL(PH_G2)); } { PH_LOCALS phase_GEMM_LR(PH_CALL(PH_G3)); } __syncthreads(); { PH_LOCALS phase_R1(PH_CALL(PH_R1)); } SEAM(PH_G2); }
    if (IN(PH_R2)) { { PH_LOCALS phase_R2(PH_CALL(PH_R2)); }
        asm volatile("s_waitcnt vmcnt(0)" ::: "memory"); __syncthreads();
        if (threadIdx.x == 0) { __builtin_amdgcn_fence(__ATOMIC_RELEASE, "agent"); asm volatile("s_waitcnt vmcnt(0)" ::: "memory"); __hip_atomic_fetch_add((unsigned*)(ws + WS_CTL + 49152 + 256), 1u, __ATOMIC_RELAXED, __HIP_MEMORY_SCOPE_AGENT); }
        { PH_LOCALS phase_ATTN(PH_CALL(PH_ATTN)); }
        if (threadIdx.x == 0) { unsigned spins = 0; while (__hip_atomic_load((unsigned*)(ws + WS_CTL + 49152 + 256), __ATOMIC_RELAXED, __HIP_MEMORY_SCOPE_AGENT) < (unsigned)G) { __builtin_amdgcn_s_sleep(2); if (++spins > (1u << 20)) break; }
            __builtin_amdgcn_fence(__ATOMIC_ACQUIRE, "agent"); asm volatile("s_waitcnt vmcnt(0)" ::: "memory"); }
        __syncthreads();
        { PH_LOCALS phase_R3(PH_CALL(PH_R3)); }
        SEAM(PH_R3); }
    if (IN(PH_G4)) { PH_LOCALS phase_GEMM_RN(PH_CALL(PH_G4)); SEAM(PH_G4); }
    if (IN(PH_G5)) { PH_LOCALS phase_GEMM_UP(PH_CALL(PH_G5)); if (REP(PH_G5)) { __syncthreads(); phase_GEMM_UP(PH_CALL(PH_G5)); } SEAM(PH_G5); }
    if (IN(PH_G6)) { PH_LOCALS phase_GEMM_RES(PH_CALL(PH_G6)); SEAM(PH_G6); }
    if (IN(PH_G7)) { PH_LOCALS phase_GEMM_POOL(PH_CALL(PH_G7)); SEAM(PH_G7); }
    if (IN(PH_G8)) { PH_LOCALS phase_GEMM_UP(PH_CALL(PH_G8)); if (REP(PH_G8)) { __syncthreads(); phase_GEMM_UP(PH_CALL(PH_G8)); } SEAM(PH_G8); }
    if (IN(PH_G9)) { PH_LOCALS phase_GEMM_RN(PH_CALL(PH_G9)); }
}

extern "C" void kernel_launch(void* const* d_in, const int* in_sizes, int n_in, void* d_out, int out_size, void* d_ws, size_t ws_size, hipStream_t stream) {
    static int ok = 0;
    if (ok == 0) {
        if (n_in != 23 || out_size != MLAT * DM || ws_size < WS_END) { fprintf(stderr, "kernel_launch: unexpected shapes: n_in %d out %d ws %zu (need %zu)\n", n_in, out_size, ws_size, (size_t)WS_END); ok = -1; return; }
        if (hipFuncSetAttribute((const void*)mega, hipFuncAttributeMaxDynamicSharedMemorySize, LDS_BYTES) != hipSuccess) { fprintf(stderr, "kernel_launch: hipFuncSetAttribute failed\n"); ok = -1; return; }
        int dev = 0, cus = 0, per_cu = 0;
        if (hipGetDevice(&dev) != hipSuccess || hipDeviceGetAttribute(&cus, hipDeviceAttributeMultiprocessorCount, dev) != hipSuccess ||
            hipOccupancyMaxActiveBlocksPerMultiprocessor(&per_cu, (const void*)mega, 512, LDS_BYTES) != hipSuccess || per_cu < 1 || (long)cus * per_cu < 256) {
            fprintf(stderr, "kernel_launch: the 256-workgroup persistent grid is not resident on this device (CUs %d, workgroups per CU %d); nothing launched\n", cus, per_cu); ok = -1; return; }
        ok = 1;
    }
    if (ok < 0) return;
    Args a{};
    for (int i = 0; i < 23; ++i) a.in[i] = (const float*)d_in[i];
    a.out = (float*)d_out; a.ws = (unsigned char*)d_ws;
    if (hipMemsetAsync((char*)d_ws + WS_CTL, 0, CTL_ZERO_BYTES, stream) != hipSuccess) { fprintf(stderr, "kernel_launch: hipMemsetAsync failed\n"); return; }
    a.ph_lo = 0; a.ph_hi = PH_COUNT;
    hipLaunchKernelGGL(mega, dim3(256), dim3(512), LDS_BYTES, stream, a);
    const hipError_t le = hipPeekAtLastError();
    if (le != hipSuccess) fprintf(stderr, "kernel_launch: launch failed: %s\n", hipGetErrorName(le));
}
```

```cpp
#include <hip/hip_runtime.h>
#include <cstdio>
#include <cstdint>

#define GAS __attribute__((address_space(1)))
#define LAS __attribute__((address_space(3)))
typedef unsigned short bf16_t;
typedef short bf16x8 __attribute__((ext_vector_type(8)));
typedef short s16x4 __attribute__((ext_vector_type(4)));
typedef float f32x2 __attribute__((ext_vector_type(2)));
typedef float f32x4 __attribute__((ext_vector_type(4)));
typedef float f32x16 __attribute__((ext_vector_type(16)));
typedef unsigned u32x2 __attribute__((ext_vector_type(2)));
typedef unsigned u32x4 __attribute__((ext_vector_type(4)));

constexpr int DM = 2048, NB = 4, SEQ = 2048, CTX = 256, NH = 8, HD = 128;
constexpr int MLAT = NB * SEQ;
constexpr int MCTX = NB * CTX;
constexpr int MALL = MLAT + MCTX;
constexpr int NKEY = CTX + SEQ;
constexpr int FF = 5632, FF2 = 11264;
constexpr int INC = 4928, INP = 5120;
constexpr int QRANK = 512, KVRANK = 256, DR = 64;
constexpr int NADA = 6 * DM;
constexpr float EPS = 1e-6f;
constexpr int NCHUNK = 18;

constexpr size_t MiB = 1u << 20;
constexpr size_t WS_CTL = 0;
constexpr size_t WS_ADA = 1 * MiB;
constexpr size_t WS_RT128 = 2 * MiB;
constexpr size_t WS_RT64 = 3 * MiB;
constexpr size_t WS_RSTDQ = 3 * MiB + 512 * 1024;
constexpr size_t WS_RSTDKV = WS_RSTDQ + 64 * 1024;
constexpr size_t WS_RSTDX = WS_RSTDKV + 64 * 1024;
constexpr size_t WS_WIN = 4 * MiB;
constexpr size_t WS_WUQ = 24 * MiB;
constexpr size_t WS_WUKV = 26 * MiB;
constexpr size_t WS_WPOOL = 27 * MiB;
constexpr size_t WS_WOUT = 29 * MiB;
constexpr size_t WS_WUP = 37 * MiB;
constexpr size_t WS_WDN = 125 * MiB;
constexpr size_t WS_H = 169 * MiB;
constexpr size_t WS_RQ = 205 * MiB;
constexpr size_t WS_RK = 221 * MiB;
constexpr size_t WS_RV = 239 * MiB;
constexpr size_t WS_RG = 257 * MiB;
constexpr size_t WS_CQ = 273 * MiB;
constexpr size_t WS_CKV = 281 * MiB;
constexpr size_t WS_QN = 286 * MiB;
constexpr size_t WS_QR = 302 * MiB;
constexpr size_t WS_KN = 310 * MiB;
constexpr size_t WS_KR = 328 * MiB;
constexpr size_t WS_VC = 330 * MiB;
constexpr size_t WS_KVB = 348 * MiB;
constexpr size_t WS_ST = 420 * MiB;
constexpr size_t WS_MIX = 452 * MiB;
constexpr size_t WS_ACT = 484 * MiB;
constexpr size_t WS_Z = 572 * MiB;
constexpr size_t WS_Z3 = WS_Z + 48 * MiB;
constexpr size_t WS_SLOTS = 578 * MiB;
constexpr size_t WS_XB = 592 * MiB;
constexpr size_t WS_END = 752 * MiB;

constexpr int LDS_BYTES = 147456;

__device__ __forceinline__ unsigned f2bf(float f) { unsigned u = __builtin_bit_cast(unsigned, f); return (u + 0x7fffu + ((u >> 16) & 1u)) >> 16; }
__device__ __forceinline__ unsigned pk2(float lo, float hi) { return f2bf(lo) | (f2bf(hi) << 16); }
__device__ __forceinline__ float bf2f(unsigned short h) { return __builtin_bit_cast(float, (unsigned)h << 16); }
__device__ __forceinline__ float bflo(unsigned w) { return __builtin_bit_cast(float, w << 16); }
__device__ __forceinline__ float bfhi(unsigned w) { return __builtin_bit_cast(float, w & 0xffff0000u); }
__device__ __forceinline__ unsigned cvtpk(float lo, float hi) { unsigned r; asm volatile("v_cvt_pk_bf16_f32 %0, %1, %2" : "=v"(r) : "v"(lo), "v"(hi)); return r; }
__device__ __forceinline__ f32x4 ldbf4(const bf16_t* p) { const u32x2 w = *(const u32x2*)p; return (f32x4){bflo(w.x), bfhi(w.x), bflo(w.y), bfhi(w.y)}; }
__device__ __forceinline__ void stbf4(bf16_t* p, f32x4 v) { u32x2 w; w.x = cvtpk(v.x, v.y); w.y = cvtpk(v.z, v.w); *(u32x2*)p = w; }
__device__ __forceinline__ float wave_sum(float v) {
#pragma unroll
    for (int o = 1; o < 64; o <<= 1) v += __shfl_xor(v, o);
    return v;
}
__device__ __forceinline__ float silu_f(float v) { return v * __builtin_amdgcn_rcpf(1.f + __builtin_amdgcn_exp2f(v * -1.4426950408889634f)); }
__device__ __forceinline__ void sincos_acc(float x, float& s, float& c) {
    const double xd = (double)x; const double kq = __builtin_rint(xd * 0.63661977236758134308);
    const double r = (xd - kq * 1.57079632679489655800) - kq * 6.12323399573676603587e-17; const int q = ((int)kq) & 3;
    const double r2 = r * r;
    const double sp = r * (1.0 + r2 * (-1.0 / 6 + r2 * (1.0 / 120 + r2 * (-1.0 / 5040 + r2 * (1.0 / 362880 + r2 * (-1.0 / 39916800 + r2 * (1.0 / 6227020800.0)))))));
    const double cp = 1.0 + r2 * (-0.5 + r2 * (1.0 / 24 + r2 * (-1.0 / 720 + r2 * (1.0 / 40320 + r2 * (-1.0 / 3628800 + r2 * (1.0 / 479001600.0 + r2 * (-1.0 / 87178291200.0)))))));
    double sd, cd;
    if (q == 0) { sd = sp; cd = cp; } else if (q == 1) { sd = cp; cd = -sp; } else if (q == 2) { sd = -sp; cd = -cp; } else { sd = -cp; cd = sp; }
    s = (float)sd; c = (float)cd;
}

namespace pg8 {
constexpr int BM = 256, BK = 64, HALF = 128, HTB = HALF * BK * 2, STAGE_BYTES = 8 * HTB, NXCD = 8, WGM = 8;
__host__ __device__ __forceinline__ int lds_byte(int r, int c) { const int st = (r >> 4) * 2 + (c >> 5), rr = r & 15, cc = c & 31, ob = rr * 64 + cc * 2; return st * 1024 + (ob ^ (((ob >> 9) & 1) << 5)); }
__host__ __device__ __forceinline__ void stage_rc(int b, int& R, int& C) { const int st = b / 1024, sb = b % 1024, swz = sb ^ (((sb >> 9) & 1) << 5); R = (st >> 1) * 16 + swz / 64; C = (st & 1) * 32 + (swz % 64) / 2; }
__host__ __device__ __forceinline__ int perm32(int rho) { const int n = rho >> 4, i = rho & 15; return 8 * (i >> 2) + 4 * n + (i & 3); }

struct Unit { int pm, pn, g; };
struct Gemm { const bf16_t* A; const bf16_t* Bt; int K, lda, ldb; size_t a_g, b_g; };

struct TileOrder {
    int nM, nN, nwg, G, c;
    __device__ void init(int nM_, int nN_, int nG_, int G_, int c_) { nM = nM_; nN = nN_; nwg = nM_ * nN_ * nG_; G = G_; c = c_; }
    __device__ bool next(int i, Unit& u) const {
        const long L = (long)i * G + c; if (L >= nwg) return false;
        int wgid = (int)L; { const int q = nwg / NXCD, r = nwg % NXCD, xcd = wgid % NXCD, off = wgid / NXCD; wgid = (xcd < r ? xcd * (q + 1) : r * (q + 1) + (xcd - r) * q) + off; }
        const int per_g = nM * nN; u.g = wgid / per_g; const int w = wgid % per_g;
        const int nig = WGM * nN, gid = w / nig, fm = gid * WGM, gsz = (nM - fm) < WGM ? (nM - fm) : WGM;
        u.pm = fm + ((w % nig) % gsz); u.pn = (w % nig) / gsz; return true;
    }
};

struct EpiF32 {
    static constexpr bool PERM = false, AFTER_DRAIN = false, APERM = false;
    float* C; int ldc;
    __device__ __forceinline__ void operator()(const f32x4 (&acc)[2][2][4][2], const Unit& u, int wr, int wc, int fr, int fq) const {
        const int row0 = u.pm * BM + wr * 64 + fr, col0 = u.pn * BM + wc * 32 + 4 * fq;
#pragma unroll
        for (int ai = 0; ai < 2; ++ai)
#pragma unroll
            for (int m = 0; m < 4; ++m) { float* rowp = C + (size_t)(row0 + ai * HALF + m * 16) * ldc + col0;
#pragma unroll
                for (int bj = 0; bj < 2; ++bj)
#pragma unroll
                    for (int n = 0; n < 2; ++n) *(f32x4*)(rowp + bj * HALF + n * 16) = acc[ai][bj][m][n]; }
    }
};
struct EpiBf16 {
    static constexpr bool PERM = true, AFTER_DRAIN = false, APERM = false;
    bf16_t* O; int ldc;
    __device__ __forceinline__ void operator()(const f32x4 (&acc)[2][2][4][2], const Unit& u, int wr, int wc, int fr, int fq) const {
        const int row0 = u.pm * BM + wr * 64 + fr, col0 = u.pn * BM + wc * 32 + 8 * fq;
#pragma unroll
        for (int ai = 0; ai < 2; ++ai)
#pragma unroll
            for (int m = 0; m < 4; ++m) { bf16_t* rowp = O + (size_t)(row0 + ai * HALF + m * 16) * ldc + col0;
#pragma unroll
                for (int bj = 0; bj < 2; ++bj) { const f32x4 v0 = acc[ai][bj][m][0], v1 = acc[ai][bj][m][1];
                    u32x4 w; w.x = cvtpk(v0[0], v0[1]); w.y = cvtpk(v0[2], v0[3]); w.z = cvtpk(v1[0], v1[1]); w.w = cvtpk(v1[2], v1[3]);
                    *(u32x4*)(rowp + bj * HALF) = w; } }
    }
};
struct EpiResid {
    static constexpr bool PERM = true, AFTER_DRAIN = false, APERM = false;
    const bf16_t* base; bf16_t* out; const float* gate; const float* cscale; int gcols; float* ssq;
    __device__ __forceinline__ void operator()(const f32x4 (&acc)[2][2][4][2], const Unit& u, int wr, int wc, int fr, int fq) const {
        const int row0 = u.pm * BM + wr * 64 + fr, col0 = u.g * gcols + u.pn * BM + wc * 32 + 8 * fq;
        const float* gv = gate + (size_t)(u.pm >> 3) * NADA + col0;
        f32x4 gg[2][2];
#pragma unroll
        for (int bj = 0; bj < 2; ++bj)
#pragma unroll
            for (int n = 0; n < 2; ++n) { gg[bj][n] = *(const f32x4*)(gv + bj * HALF + n * 4); if (cscale) gg[bj][n] *= *(const f32x4*)(cscale + col0 + bj * HALF + n * 4); }
        u32x4 bsr[2][4][2];
#pragma unroll
        for (int ai = 0; ai < 2; ++ai)
#pragma unroll
            for (int m = 0; m < 4; ++m)
#pragma unroll
                for (int bj = 0; bj < 2; ++bj) bsr[ai][m][bj] = *(const u32x4*)(base + (size_t)(row0 + ai * HALF + m * 16) * DM + col0 + bj * HALF);
#pragma unroll
        for (int ai = 0; ai < 2; ++ai)
#pragma unroll
            for (int m = 0; m < 4; ++m) { const size_t off = (size_t)(row0 + ai * HALF + m * 16) * DM + col0; float sq = 0.f;
#pragma unroll
                for (int bj = 0; bj < 2; ++bj) { const u32x4 w = bsr[ai][m][bj];
                    const f32x4 o0 = (f32x4){bflo(w.x), bfhi(w.x), bflo(w.y), bfhi(w.y)} + gg[bj][0] * acc[ai][bj][m][0];
                    const f32x4 o1 = (f32x4){bflo(w.z), bfhi(w.z), bflo(w.w), bfhi(w.w)} + gg[bj][1] * acc[ai][bj][m][1];
                    sq += ((o0.x * o0.x + o0.y * o0.y) + (o0.z * o0.z + o0.w * o0.w)) + ((o1.x * o1.x + o1.y * o1.y) + (o1.z * o1.z + o1.w * o1.w));
                    u32x4 ov; ov.x = cvtpk(o0.x, o0.y); ov.y = cvtpk(o0.z, o0.w); ov.z = cvtpk(o1.x, o1.y); ov.w = cvtpk(o1.z, o1.w);
                    *(u32x4*)(out + off + bj * HALF) = ov; }
                if (ssq) { sq += __shfl_xor(sq, 16); sq += __shfl_xor(sq, 32); if (fq == 0) atomicAdd(ssq + row0 + ai * HALF + m * 16, sq); } }
    }
};

struct EpiSplit1 {
    static constexpr bool PERM = true, AFTER_DRAIN = false, APERM = false;
    unsigned char* ws;
    __device__ __forceinline__ void operator()(const f32x4 (&acc)[2][2][4][2], const Unit& u, int wr, int wc, int fr, int fq) const {
        const int pn = u.pn, pm = u.pm; const bool lat = pm < 32;
        const int b = lat ? (pm >> 3) : (pm - 32); const int t0 = lat ? ((pm & 7) * 256) : 0;
        const int rloc0 = wr * 64 + fr, j8 = wc * 32 + fq * 8;
        if (pn < 8) {
            const bool isk = pn >= 4; if (!isk && !lat) return;
            const float ksc = isk ? 0.08838834764831845f : 1.0f;
            f32x4 cs[2][4][2];
#pragma unroll
            for (int ai = 0; ai < 2; ++ai)
#pragma unroll
                for (int m = 0; m < 4; ++m) { const int tt = t0 + rloc0 + ai * HALF + m * 16;
                    cs[ai][m][0] = (f32x4){1.f, 0.f, 1.f, 0.f}; cs[ai][m][1] = (f32x4){1.f, 0.f, 1.f, 0.f};
                    if (lat) { const f32x4* rt = (const f32x4*)(ws + WS_RT128) + ((tt * 64 + (j8 >> 1)) >> 1); cs[ai][m][0] = rt[0]; cs[ai][m][1] = rt[1]; } }
#pragma unroll
            for (int ai = 0; ai < 2; ++ai)
#pragma unroll
                for (int m = 0; m < 4; ++m) { const int tt = t0 + rloc0 + ai * HALF + m * 16;
                    const f32x4 c0 = cs[ai][m][0], c1 = cs[ai][m][1];
#pragma unroll
                    for (int bj = 0; bj < 2; ++bj) { const int h = 2 * (pn & 3) + bj; const f32x4 v0 = acc[ai][bj][m][0], v1 = acc[ai][bj][m][1];
                        u32x4 w;
                        w.x = cvtpk((v0.x * c0.x - v0.y * c0.y) * ksc, (v0.x * c0.y + v0.y * c0.x) * ksc); w.y = cvtpk((v0.z * c0.z - v0.w * c0.w) * ksc, (v0.z * c0.w + v0.w * c0.z) * ksc);
                        w.z = cvtpk((v1.x * c1.x - v1.y * c1.y) * ksc, (v1.x * c1.y + v1.y * c1.x) * ksc); w.w = cvtpk((v1.z * c1.z - v1.w * c1.w) * ksc, (v1.z * c1.w + v1.w * c1.z) * ksc);
                        bf16_t* dst = isk ? (bf16_t*)(ws + WS_RK) + ((size_t)(b * NH + h) * NKEY + (lat ? CTX + tt : tt)) * HD + j8 : (bf16_t*)(ws + WS_RQ) + ((size_t)(b * NH + h) * SEQ + tt) * HD + j8;
                        *(u32x4*)dst = w; } }
        } else if (pn < 12) {
#pragma unroll
            for (int ai = 0; ai < 2; ++ai)
#pragma unroll
                for (int m = 0; m < 4; ++m) { const int tt = t0 + rloc0 + ai * HALF + m * 16;
#pragma unroll
                    for (int bj = 0; bj < 2; ++bj) { const int h = 2 * (pn - 8) + bj; const f32x4 v0 = acc[ai][bj][m][0], v1 = acc[ai][bj][m][1];
                        u32x4 w; w.x = cvtpk(v0.x, v0.y); w.y = cvtpk(v0.z, v0.w); w.z = cvtpk(v1.x, v1.y); w.w = cvtpk(v1.z, v1.w);
                        *(u32x4*)((bf16_t*)(ws + WS_RV) + ((size_t)(b * NH + h) * NKEY + (lat ? CTX + tt : tt)) * HD + j8) = w; } }
        } else if (pn < 18) {
            if (!lat) return;
            const bool isg = pn < 16; float* ssq = (float*)(ws + WS_RSTDQ);
#pragma unroll
            for (int ai = 0; ai < 2; ++ai)
#pragma unroll
                for (int m = 0; m < 4; ++m) { const int row = pm * 256 + rloc0 + ai * HALF + m * 16; float s = 0.f;
#pragma unroll
                    for (int bj = 0; bj < 2; ++bj) { const f32x4 v0 = acc[ai][bj][m][0], v1 = acc[ai][bj][m][1];
                        u32x4 w; w.x = cvtpk(v0.x, v0.y); w.y = cvtpk(v0.z, v0.w); w.z = cvtpk(v1.x, v1.y); w.w = cvtpk(v1.z, v1.w);
                        s += (v0.x * v0.x + v0.y * v0.y) + (v0.z * v0.z + v0.w * v0.w) + (v1.x * v1.x + v1.y * v1.y) + (v1.z * v1.z + v1.w * v1.w);
                        bf16_t* dst = isg ? (bf16_t*)(ws + WS_RG) + (size_t)row * 1024 + (pn - 12) * 256 + bj * HALF + j8 : (bf16_t*)(ws + WS_CQ) + (size_t)row * QRANK + (pn - 16) * 256 + bj * HALF + j8;
                        *(u32x4*)dst = w; }
                    if (!isg) { s += __shfl_xor(s, 16); s += __shfl_xor(s, 32); if (fq == 0) atomicAdd(ssq + row, s); } }
        } else if (pn == 18) {
            float* ssq = (float*)(ws + WS_RSTDKV);
#pragma unroll
            for (int ai = 0; ai < 2; ++ai)
#pragma unroll
                for (int m = 0; m < 4; ++m) { const int row = pm * 256 + rloc0 + ai * HALF + m * 16; float s = 0.f;
#pragma unroll
                    for (int bj = 0; bj < 2; ++bj) { const f32x4 v0 = acc[ai][bj][m][0], v1 = acc[ai][bj][m][1];
                        u32x4 w; w.x = cvtpk(v0.x, v0.y); w.y = cvtpk(v0.z, v0.w); w.z = cvtpk(v1.x, v1.y); w.w = cvtpk(v1.z, v1.w);
                        s += (v0.x * v0.x + v0.y * v0.y) + (v0.z * v0.z + v0.w * v0.w) + (v1.x * v1.x + v1.y * v1.y) + (v1.z * v1.z + v1.w * v1.w);
                        *(u32x4*)((bf16_t*)(ws + WS_CKV) + (size_t)row * KVRANK + bj * HALF + j8) = w; }
                    s += __shfl_xor(s, 16); s += __shfl_xor(s, 32); if (fq == 0) atomicAdd(ssq + row, s); }
        } else {
            if (wc >= 2) return;
#pragma unroll
            for (int ai = 0; ai < 2; ++ai)
#pragma unroll
                for (int m = 0; m < 4; ++m) { const int tt = t0 + rloc0 + ai * HALF + m * 16;
                    f32x4 c0 = {1.f, 0.f, 1.f, 0.f}, c1 = {1.f, 0.f, 1.f, 0.f};
                    if (lat) { const f32x4* rt = (const f32x4*)(ws + WS_RT64) + ((tt * 32 + (j8 >> 1)) >> 1); c0 = rt[0]; c1 = rt[1]; }
                    const f32x4 v0 = acc[ai][0][m][0], v1 = acc[ai][0][m][1];
                    u32x4 w;
                    w.x = cvtpk(v0.x * c0.x - v0.y * c0.y, v0.x * c0.y + v0.y * c0.x); w.y = cvtpk(v0.z * c0.z - v0.w * c0.w, v0.z * c0.w + v0.w * c0.z);
                    w.z = cvtpk(v1.x * c1.x - v1.y * c1.y, v1.x * c1.y + v1.y * c1.x); w.w = cvtpk(v1.z * c1.z - v1.w * c1.w, v1.z * c1.w + v1.w * c1.z);
                    *(u32x4*)((bf16_t*)(ws + WS_KR) + ((size_t)b * NKEY + (lat ? CTX + tt : tt)) * DR + j8) = w; }
        }
    }
};
struct EpiLowRank {
    static constexpr bool PERM = true, AFTER_DRAIN = false, APERM = false;
    unsigned char* ws; int mode;
    __device__ __forceinline__ void operator()(const f32x4 (&acc)[2][2][4][2], const Unit& u, int wr, int wc, int fr, int fq) const {
        const int pn = u.pn, pm = u.pm; const bool lat = pm < 32;
        const int b = lat ? (pm >> 3) : (pm - 32); const int t0 = lat ? ((pm & 7) * 256) : 0;
        const int rloc0 = wr * 64 + fr, j8 = wc * 32 + fq * 8;
        const float* ssq = (const float*)(ws + (mode == 0 ? WS_RSTDQ : WS_RSTDKV)); const float invn = mode == 0 ? 1.0f / QRANK : 1.0f / KVRANK;
#pragma unroll
        for (int ai = 0; ai < 2; ++ai)
#pragma unroll
            for (int m = 0; m < 4; ++m) { const int rl = rloc0 + ai * HALF + m * 16, tt = t0 + rl; const float rs = 1.0f / sqrtf(ssq[pm * 256 + rl] * invn + EPS);
                if (mode == 0 && pn >= 4) {
#pragma unroll
                    for (int bj = 0; bj < 2; ++bj) { const int o = 256 * (pn - 4) + HALF * bj + j8, h = o >> 6, jj = o & 63;
                        const f32x4* rt = (const f32x4*)(ws + WS_RT64) + ((tt * 32 + (jj >> 1)) >> 1); const f32x4 c0 = rt[0], c1 = rt[1];
                        const f32x4 v0 = acc[ai][bj][m][0] * rs, v1 = acc[ai][bj][m][1] * rs;
                        u32x4 w;
                        w.x = cvtpk(v0.x * c0.x - v0.y * c0.y, v0.x * c0.y + v0.y * c0.x); w.y = cvtpk(v0.z * c0.z - v0.w * c0.w, v0.z * c0.w + v0.w * c0.z);
                        w.z = cvtpk(v1.x * c1.x - v1.y * c1.y, v1.x * c1.y + v1.y * c1.x); w.w = cvtpk(v1.z * c1.z - v1.w * c1.w, v1.z * c1.w + v1.w * c1.z);
                        *(u32x4*)((bf16_t*)(ws + WS_QR) + ((size_t)(b * NH + h) * SEQ + tt) * DR + jj) = w; }
                } else {
#pragma unroll
                    for (int bj = 0; bj < 2; ++bj) { const int h = 2 * (pn & 3) + bj; const f32x4 v0 = acc[ai][bj][m][0] * rs, v1 = acc[ai][bj][m][1] * rs;
                        u32x4 w; w.x = cvtpk(v0.x, v0.y); w.y = cvtpk(v0.z, v0.w); w.z = cvtpk(v1.x, v1.y); w.w = cvtpk(v1.z, v1.w);
                        bf16_t* dst = mode == 0 ? (bf16_t*)(ws + WS_QN) + ((size_t)(b * NH + h) * SEQ + tt) * HD + j8
                                                : (bf16_t*)(ws + (pn < 4 ? WS_KN : WS_VC)) + ((size_t)(b * NH + h) * NKEY + (lat ? CTX + tt : tt)) * HD + j8;
                        *(u32x4*)dst = w; } }
            }
    }
};

__device__ __forceinline__ float dpp_shr1(float x) { return __builtin_bit_cast(float, __builtin_amdgcn_update_dpp(0, __builtin_bit_cast(int, x), 0x111, 0xf, 0xf, true)); }
__device__ __forceinline__ float dpp_shl1(float x) { return __builtin_bit_cast(float, __builtin_amdgcn_update_dpp(0, __builtin_bit_cast(int, x), 0x101, 0xf, 0xf, true)); }
__device__ __forceinline__ float dpp_ror1(float x) { return __builtin_bit_cast(float, __builtin_amdgcn_update_dpp(0, __builtin_bit_cast(int, x), 0x121, 0xf, 0xf, false)); }
__device__ __forceinline__ float dpp_ror15(float x) { return __builtin_bit_cast(float, __builtin_amdgcn_update_dpp(0, __builtin_bit_cast(int, x), 0x12f, 0xf, 0xf, false)); }
__device__ __forceinline__ float dpp_shr1_old(float o, float x) { const int oi = __builtin_bit_cast(int, o), xi = __builtin_bit_cast(int, x); return __builtin_bit_cast(float, __builtin_amdgcn_update_dpp(oi, xi, 0x111, 0xf, 0xf, false)); }
__device__ __forceinline__ float dpp_shl1_old(float o, float x) { const int oi = __builtin_bit_cast(int, o), xi = __builtin_bit_cast(int, x); return __builtin_bit_cast(float, __builtin_amdgcn_update_dpp(oi, xi, 0x101, 0xf, 0xf, false)); }
struct EpiConv {
    static constexpr bool PERM = true, AFTER_DRAIN = false, APERM = true;
    const float* cw; const float* cb; bf16_t* act; float* halo; LAS float* ex;
    __device__ __forceinline__ void operator()(const f32x4 (&acc)[2][2][4][2], const Unit& u, int wr, int wc, int fr, int fq) const {
        const int wid = wr * 4 + wc;
        LAS float* mine = ex + wid * 256;
        if (fr == 0) {
#pragma unroll
            for (int ai = 0; ai < 2; ++ai)
#pragma unroll
                for (int bj = 0; bj < 2; ++bj)
#pragma unroll
                    for (int n = 0; n < 2; ++n) *(LAS f32x4*)(mine + (ai * 2 + 0) * 64 + (bj * 2 + n) * 16 + fq * 4) = acc[ai][bj][0][n]; }
        if (fr == 15) {
#pragma unroll
            for (int ai = 0; ai < 2; ++ai)
#pragma unroll
                for (int bj = 0; bj < 2; ++bj)
#pragma unroll
                    for (int n = 0; n < 2; ++n) *(LAS f32x4*)(mine + (ai * 2 + 1) * 64 + (bj * 2 + n) * 16 + fq * 4) = acc[ai][bj][3][n]; }
        if (wr == 0 && fr == 0) { float* hp = halo + (size_t)(u.pm * 4) * FF2 + u.pn * 256 + wc * 32 + fq * 8;
#pragma unroll
            for (int bj = 0; bj < 2; ++bj)
#pragma unroll
                for (int n = 0; n < 2; ++n) { *(f32x4*)(hp + bj * HALF + n * 4) = acc[0][bj][0][n]; *(f32x4*)(hp + FF2 + bj * HALF + n * 4) = acc[0][bj][1][n]; } }
        if (wr == 1 && fr == 15) { float* hp = halo + (size_t)(u.pm * 4 + 2) * FF2 + u.pn * 256 + wc * 32 + fq * 8;
#pragma unroll
            for (int bj = 0; bj < 2; ++bj)
#pragma unroll
                for (int n = 0; n < 2; ++n) { *(f32x4*)(hp + bj * HALF + n * 4) = acc[1][bj][2][n]; *(f32x4*)(hp + FF2 + bj * HALF + n * 4) = acc[1][bj][3][n]; } }
        const int f0 = u.pn * 128 + wc * 32 + fq * 8;
        f32x4 W0[2][2], W1[2][2], W2[2][2], BB[2][2];
#pragma unroll
        for (int n = 0; n < 2; ++n)
#pragma unroll
            for (int bj = 0; bj < 2; ++bj) { const float* p = cw + bj * FF + f0 + 4 * n; W0[n][bj] = *(const f32x4*)p; W1[n][bj] = *(const f32x4*)(p + FF2); W2[n][bj] = *(const f32x4*)(p + 2 * FF2); BB[n][bj] = *(const f32x4*)(cb + bj * FF + f0 + 4 * n); }
        asm volatile("s_waitcnt lgkmcnt(0)" ::: "memory"); __builtin_amdgcn_s_barrier(); asm volatile("" ::: "memory");
        const LAS float* theirs = ex + (wid ^ 4) * 256;
        const int row0 = u.pm * BM + wr * 64 + 4 * fr;
#pragma unroll
        for (int ai = 0; ai < 2; ++ai) {
            f32x4 vpe[2][2], vne[2][2];
#pragma unroll
            for (int n = 0; n < 2; ++n)
#pragma unroll
                for (int bj = 0; bj < 2; ++bj) {
                    const bool hasp = (wr == 1) || (ai == 1); const int slotp = (wr == 1) ? (ai * 2 + 1) : 1;
                    const bool hasn = (wr == 0) || (ai == 0); const int slotn = (wr == 0) ? (ai * 2) : 2;
                    const f32x4 bp = hasp ? *(const LAS f32x4*)(theirs + slotp * 64 + (bj * 2 + n) * 16 + fq * 4) : (f32x4){0.f, 0.f, 0.f, 0.f};
                    const f32x4 bn = hasn ? *(const LAS f32x4*)(theirs + slotn * 64 + (bj * 2 + n) * 16 + fq * 4) : (f32x4){0.f, 0.f, 0.f, 0.f};
#pragma unroll
                    for (int j = 0; j < 4; ++j) { const float lastv = acc[ai][bj][3][n][j], firstv = acc[ai][bj][0][n][j];
                        vpe[n][bj][j] = dpp_shr1_old(bp[j], lastv); vne[n][bj][j] = dpp_shl1_old(bn[j], firstv); } }
#pragma unroll
            for (int m = 0; m < 4; ++m) {
                u32x4 w;
#pragma unroll
                for (int n = 0; n < 2; ++n) {
                    f32x4 up[2];
#pragma unroll
                    for (int bj = 0; bj < 2; ++bj) { const f32x4 v = acc[ai][bj][m][n];
                        const f32x4 vp = (m > 0) ? acc[ai][bj][m > 0 ? m - 1 : 0][n] : vpe[n][bj];
                        const f32x4 vn = (m < 3) ? acc[ai][bj][m < 3 ? m + 1 : 3][n] : vne[n][bj];
                        up[bj] = BB[n][bj] + W1[n][bj] * v + W0[n][bj] * vp + W2[n][bj] * vn; }
                    const f32x4 a = up[0], gt = up[1];
                    const unsigned lo = cvtpk(a.x * silu_f(gt.x), a.y * silu_f(gt.y)), hi = cvtpk(a.z * silu_f(gt.z), a.w * silu_f(gt.w));
                    if (n == 0) { w.x = lo; w.y = hi; } else { w.z = lo; w.w = hi; } }
                *(u32x4*)(act + (size_t)(row0 + ai * HALF + m) * FF + f0) = w; }
        }
    }
};

struct EpiResidNorm {
    static constexpr bool PERM = true, AFTER_DRAIN = true, APERM = false;
    const float* base; const bf16_t* baseb; bf16_t* xout; const float* gate; const float* cscale; int gcols;
    const float* nw; const float* msh; const float* msc; bf16_t* hout; float* fout;
    float* slots; unsigned* cnt;
    __device__ __forceinline__ void fused(f32x4 (&acc)[2][2][4][2], const Unit& u, int wr, int wc, int fr, int fq, LAS unsigned char* lds, int wid, int lane) const {
        LAS float* P = (LAS float*)lds; LAS float* S = (LAS float*)(lds + 4096); LAS unsigned* flag = (LAS unsigned*)(lds + 4096 + 1024);
        const int rl0 = wr * 64 + fr, row0 = u.pm * BM + rl0, col0 = u.g * gcols + u.pn * BM + wc * 32 + 8 * fq;
        const int b = u.pm >> 3, tile = (u.g * gcols) / 256 + u.pn, tid = wid * 64 + lane;
        {   const float* gv = gate + (size_t)b * NADA + col0;
            f32x4 gg[2][2];
#pragma unroll
            for (int bj = 0; bj < 2; ++bj)
#pragma unroll
                for (int n = 0; n < 2; ++n) { gg[bj][n] = *(const f32x4*)(gv + bj * HALF + n * 4); if (cscale) gg[bj][n] *= *(const f32x4*)(cscale + col0 + bj * HALF + n * 4); }
#pragma unroll
            for (int ai = 0; ai < 2; ++ai) {
                if (baseb) {
                    u32x4 bsr[4][2];
#pragma unroll
                    for (int m = 0; m < 4; ++m)
#pragma unroll
                        for (int bj = 0; bj < 2; ++bj) bsr[m][bj] = *(const u32x4*)(baseb + (size_t)(row0 + ai * HALF + m * 16) * DM + col0 + bj * HALF);
#pragma unroll
                    for (int m = 0; m < 4; ++m) { const size_t off = (size_t)(row0 + ai * HALF + m * 16) * DM + col0; float sq = 0.f;
#pragma unroll
                        for (int bj = 0; bj < 2; ++bj) { const u32x4 w = bsr[m][bj];
                            const f32x4 o0 = (f32x4){bflo(w.x), bfhi(w.x), bflo(w.y), bfhi(w.y)} + gg[bj][0] * acc[ai][bj][m][0];
                            const f32x4 o1 = (f32x4){bflo(w.z), bfhi(w.z), bflo(w.w), bfhi(w.w)} + gg[bj][1] * acc[ai][bj][m][1];
                            sq += ((o0.x * o0.x + o0.y * o0.y) + (o0.z * o0.z + o0.w * o0.w)) + ((o1.x * o1.x + o1.y * o1.y) + (o1.z * o1.z + o1.w * o1.w));
                            acc[ai][bj][m][0] = o0; acc[ai][bj][m][1] = o1;
                            if (xout) { u32x4 ov; ov.x = cvtpk(o0.x, o0.y); ov.y = cvtpk(o0.z, o0.w); ov.z = cvtpk(o1.x, o1.y); ov.w = cvtpk(o1.z, o1.w); *(u32x4*)(xout + off + bj * HALF) = ov; } }
                        sq += __shfl_xor(sq, 16); sq += __shfl_xor(sq, 32);
                        if (fq == 0) P[(rl0 + ai * HALF + m * 16) * 4 + wc] = sq; }
                } else {
                    f32x4 bsf[4][2][2];
#pragma unroll
                    for (int m = 0; m < 4; ++m)
#pragma unroll
                        for (int bj = 0; bj < 2; ++bj)
#pragma unroll
                            for (int n = 0; n < 2; ++n) bsf[m][bj][n] = *(const f32x4*)(base + (size_t)(row0 + ai * HALF + m * 16) * DM + col0 + bj * HALF + n * 4);
#pragma unroll
                    for (int m = 0; m < 4; ++m) { const size_t off = (size_t)(row0 + ai * HALF + m * 16) * DM + col0; float sq = 0.f;
#pragma unroll
                        for (int bj = 0; bj < 2; ++bj)
#pragma unroll
                            for (int n = 0; n < 2; ++n) { const f32x4 o = bsf[m][bj][n] + gg[bj][n] * acc[ai][bj][m][n];
                                sq += (o.x * o.x + o.y * o.y) + (o.z * o.z + o.w * o.w); acc[ai][bj][m][n] = o;
                                if (xout) stbf4(xout + off + bj * HALF + n * 4, o); }
                        sq += __shfl_xor(sq, 16); sq += __shfl_xor(sq, 32);
                        if (fq == 0) P[(rl0 + ai * HALF + m * 16) * 4 + wc] = sq; }
                }
                asm volatile("" ::: "memory");
            }
        }
        asm volatile("s_waitcnt lgkmcnt(0)" ::: "memory"); __builtin_amdgcn_s_barrier(); asm volatile("" ::: "memory");
        if (tid < 256) { const float tot = (P[tid * 4 + 0] + P[tid * 4 + 1]) + (P[tid * 4 + 2] + P[tid * 4 + 3]);
            __hip_atomic_store(slots + (size_t)(u.pm * BM + tid) * 8 + tile, tot, __ATOMIC_RELAXED, __HIP_MEMORY_SCOPE_AGENT); }
        asm volatile("s_waitcnt vmcnt(0)" ::: "memory");
        if (wid < 4 && lane == 0) __hip_atomic_fetch_add(cnt + 64 * u.pm, 1u, __ATOMIC_RELAXED, __HIP_MEMORY_SCOPE_AGENT);
        if (wid == 0) {
            unsigned spins = 0;
            while ((unsigned)__builtin_amdgcn_readfirstlane(__hip_atomic_load(cnt + 64 * u.pm, __ATOMIC_RELAXED, __HIP_MEMORY_SCOPE_AGENT)) < 32u) { __builtin_amdgcn_s_sleep(2); if (++spins > (1u << 20)) break; }
            __builtin_amdgcn_fence(__ATOMIC_ACQUIRE, "agent");
            if (lane == 0) flag[0] = 1u;
        }
        asm volatile("s_waitcnt vmcnt(0) lgkmcnt(0)" ::: "memory"); __builtin_amdgcn_s_barrier(); asm volatile("" ::: "memory");
        if (tid < 256) { const float* sl = slots + (size_t)(u.pm * BM + tid) * 8; float tot = 0.f;
#pragma unroll
            for (int t = 0; t < 8; ++t) tot += __hip_atomic_load(sl + t, __ATOMIC_RELAXED, __HIP_MEMORY_SCOPE_AGENT);
            S[tid] = 1.0f / sqrtf(tot * (1.0f / DM) + EPS); }
        asm volatile("s_waitcnt lgkmcnt(0)" ::: "memory"); __builtin_amdgcn_s_barrier(); asm volatile("" ::: "memory");
        f32x4 ma[2][2], mb[2][2];
#pragma unroll
        for (int bj = 0; bj < 2; ++bj)
#pragma unroll
            for (int n = 0; n < 2; ++n) { const int c = col0 + bj * HALF + n * 4; ma[bj][n] = *(const f32x4*)(nw + c); mb[bj][n] = (f32x4){0.f, 0.f, 0.f, 0.f};
                if (msc) { ma[bj][n] *= (*(const f32x4*)(msc + (size_t)b * NADA + c) + 1.0f); mb[bj][n] = *(const f32x4*)(msh + (size_t)b * NADA + c); } }
#pragma unroll
        for (int ai = 0; ai < 2; ++ai)
#pragma unroll
            for (int m = 0; m < 4; ++m) { const float rs = S[rl0 + ai * HALF + m * 16]; const size_t off = (size_t)(row0 + ai * HALF + m * 16) * DM + col0;
#pragma unroll
                for (int bj = 0; bj < 2; ++bj) { const f32x4 y0 = (acc[ai][bj][m][0] * rs) * ma[bj][0] + mb[bj][0], y1 = (acc[ai][bj][m][1] * rs) * ma[bj][1] + mb[bj][1];
                    if (hout) { u32x4 w; w.x = cvtpk(y0.x, y0.y); w.y = cvtpk(y0.z, y0.w); w.z = cvtpk(y1.x, y1.y); w.w = cvtpk(y1.z, y1.w); *(u32x4*)(hout + off + bj * HALF) = w; }
                    else { *(f32x4*)(fout + off + bj * HALF) = y0; *(f32x4*)(fout + off + bj * HALF + 4) = y1; } } }
    }
};

template <class Epi, bool ALIGN_EPI>
__device__ __forceinline__ void gemm_phase(LAS unsigned char* lds, const Gemm g, const TileOrder& S, const Epi& E, const int tid) {
    const int wid = __builtin_amdgcn_readfirstlane(tid >> 6), lane = tid & 63, wr = wid >> 2, wc = wid & 3, fr = lane & 15, fq = lane >> 4;
    const int K = g.K, nt = K / BK;
    unsigned voffA[2], voffB[2];
#pragma unroll
    for (int i = 0; i < 2; ++i) { int R, C; stage_rc(wid * 2048 + i * 1024 + lane * 16, R, C); const int Rb = Epi::PERM ? ((R & ~31) + perm32(R & 31)) : R;
        const int Ra = Epi::APERM ? ((R & ~63) + 4 * (R & 15) + ((R >> 4) & 3)) : R;
        voffA[i] = (unsigned)(Ra * g.lda + C) * 2u; voffB[i] = (unsigned)(Rb * g.ldb + C) * 2u; }
    const size_t kstep = (size_t)(BK * 2);
    const size_t hstepA = (size_t)HALF * g.lda * 2, hstepB = (size_t)HALF * g.ldb * 2;
    const unsigned ldsw = (unsigned)wid * 2048u, ldsbase = (unsigned)__builtin_amdgcn_readfirstlane((int)(unsigned)(uintptr_t)lds);
    const int aoff = lds_byte(wr * 64 + fr, fq * 8), boff = lds_byte(wc * 32 + fr, fq * 8);
#define PG8_SA(b, h) (((b) * 2 + (h)) * HTB)
#define PG8_SB(b, h) ((4 + (b) * 2 + (h)) * HTB)
#define PG8_STAGE(bufoff, gbase, voff) do { const char* gb_ = (const char*)(gbase); const char* gb1_ = gb_ - 1024; const unsigned m0v_ = ldsbase + (unsigned)(bufoff) + ldsw; \
          \
        asm volatile("s_mov_b32 m0, %0\n\ts_nop 0\n\tglobal_load_lds_dwordx4 %1, %3\n\tglobal_load_lds_dwordx4 %2, %4 offset:1024" \
                     :: "s"(m0v_), "v"((voff)[0]), "v"((voff)[1]), "s"(gb_), "s"(gb1_) : "memory", "m0"); } while (0)
#define PG8_LDA(dst, b, h) do { _Pragma("unroll") for (int m = 0; m < 4; ++m) _Pragma("unroll") for (int k = 0; k < 2; ++k) dst[m][k] = *(const LAS bf16x8*)(lds + PG8_SA(b, h) + aoff + m * 2048 + k * 1024); } while (0)
#define PG8_LDB(dst, b, h) do { _Pragma("unroll") for (int n = 0; n < 2; ++n) _Pragma("unroll") for (int k = 0; k < 2; ++k) dst[n][k] = *(const LAS bf16x8*)(lds + PG8_SB(b, h) + boff + n * 2048 + k * 1024); } while (0)
#define PG8_MMA(ai, bj, At, Bt) do { __builtin_amdgcn_s_setprio(1); _Pragma("unroll") for (int m = 0; m < 4; ++m) _Pragma("unroll") for (int n = 0; n < 2; ++n) _Pragma("unroll") for (int k = 0; k < 2; ++k) \
        acc[ai][bj][m][n] = __builtin_amdgcn_mfma_f32_16x16x32_bf16(Bt[n][k], At[m][k], acc[ai][bj][m][n], 0, 0, 0); __builtin_amdgcn_s_setprio(0); } while (0)
#define PG8_WAIT_V(n) asm volatile("s_waitcnt vmcnt(" #n ")" ::: "memory")
#define PG8_WAIT_VL8 asm volatile("s_waitcnt vmcnt(8) lgkmcnt(0)" ::: "memory")
#define PG8_WAIT_VL84 asm volatile("s_waitcnt vmcnt(8) lgkmcnt(4)" ::: "memory")
#define PG8_WAIT_L(n) asm volatile("s_waitcnt lgkmcnt(" #n ")" ::: "memory")
#define PG8_BAR __builtin_amdgcn_s_barrier()
#define PG8_SCHED __builtin_amdgcn_sched_barrier(0)
    Unit cur, nxt; int ui = 0;
    if (!S.next(0, cur)) return;
    f32x4 acc[2][2][4][2];
#pragma unroll
    for (int a = 0; a < 2; ++a)
#pragma unroll
        for (int b = 0; b < 2; ++b)
#pragma unroll
            for (int m = 0; m < 4; ++m)
#pragma unroll
                for (int n = 0; n < 2; ++n) acc[a][b][m][n] = (f32x4){0.f, 0.f, 0.f, 0.f};
    bf16x8 At[4][2], B0[2][2], B1[2][2];
    const char* cA = (const char*)g.A + (size_t)cur.g * g.a_g + (size_t)cur.pm * 2 * hstepA; const char* cB = (const char*)g.Bt + (size_t)cur.g * g.b_g + (size_t)cur.pn * 2 * hstepB;
    PG8_STAGE(PG8_SB(0, 0), cB, voffB); PG8_STAGE(PG8_SB(0, 1), cB + hstepB, voffB); PG8_STAGE(PG8_SA(0, 0), cA, voffA); PG8_STAGE(PG8_SA(0, 1), cA + hstepA, voffA);
    if (wr == 1) PG8_BAR;
    PG8_WAIT_V(2); PG8_BAR;
    PG8_STAGE(PG8_SB(1, 0), cB + kstep, voffB); PG8_STAGE(PG8_SA(1, 0), cA + kstep, voffA); PG8_STAGE(PG8_SB(1, 1), cB + hstepB + kstep, voffB);
    PG8_WAIT_V(6); PG8_BAR;
    for (;;) {
        const bool has_next = S.next(ui + 1, nxt);
        const char* nA = has_next ? (const char*)g.A + (size_t)nxt.g * g.a_g + (size_t)nxt.pm * 2 * hstepA : cA;
        const char* nB = has_next ? (const char*)g.Bt + (size_t)nxt.g * g.b_g + (size_t)nxt.pn * 2 * hstepB : cB;
        for (int t = 0; t < nt; t += 2) {
            const bool last = (t == nt - 2);
            const char* a1 = cA + (size_t)(t + 1) * kstep;
            const char* a2 = last ? nA : cA + (size_t)(t + 2) * kstep; const char* b2 = last ? nB : cB + (size_t)(t + 2) * kstep;
            const char* a3 = a2 + kstep; const char* b3 = b2 + kstep;
            PG8_LDB(B0, 0, 0); PG8_SCHED; PG8_LDA(At, 0, 0); PG8_SCHED; PG8_LDB(B1, 0, 1); PG8_STAGE(PG8_SA(1, 1), a1 + hstepA, voffA);
            PG8_WAIT_VL84; PG8_BAR; PG8_MMA(0, 0, At, B0); PG8_WAIT_L(0); PG8_MMA(0, 1, At, B1); PG8_BAR; PG8_SCHED;
            PG8_STAGE(PG8_SA(0, 0), a2, voffA); PG8_SCHED; PG8_LDA(At, 0, 1); PG8_STAGE(PG8_SB(0, 0), b2, voffB); PG8_STAGE(PG8_SB(0, 1), b2 + hstepB, voffB);
            PG8_WAIT_VL8; PG8_BAR; PG8_MMA(1, 0, At, B0); PG8_MMA(1, 1, At, B1); PG8_BAR; PG8_SCHED;
            PG8_LDB(B0, 1, 0); PG8_SCHED; PG8_LDA(At, 1, 0); PG8_SCHED; PG8_LDB(B1, 1, 1); PG8_STAGE(PG8_SA(0, 1), a2 + hstepA, voffA);
            PG8_WAIT_VL84; PG8_BAR; PG8_MMA(0, 0, At, B0); PG8_WAIT_L(0); PG8_MMA(0, 1, At, B1); PG8_BAR; PG8_SCHED;
            PG8_STAGE(PG8_SA(1, 0), a3, voffA); PG8_SCHED; PG8_LDA(At, 1, 1); PG8_STAGE(PG8_SB(1, 0), b3, voffB); PG8_STAGE(PG8_SB(1, 1), b3 + hstepB, voffB);
            PG8_WAIT_VL8; PG8_BAR; PG8_MMA(1, 0, At, B0); PG8_MMA(1, 1, At, B1); PG8_BAR; PG8_SCHED;
        }
        if constexpr (ALIGN_EPI) { if (wr == 0) PG8_BAR; }
        if constexpr (!Epi::AFTER_DRAIN) E(acc, cur, wr, wc, fr, fq);
        if (!has_next) break;
#pragma unroll
        for (int a = 0; a < 2; ++a)
#pragma unroll
            for (int b = 0; b < 2; ++b)
#pragma unroll
                for (int m = 0; m < 4; ++m)
#pragma unroll
                    for (int n = 0; n < 2; ++n) acc[a][b][m][n] = (f32x4){0.f, 0.f, 0.f, 0.f};
        cur = nxt; cA = nA; cB = nB; ++ui;
        if constexpr (ALIGN_EPI) { if (wr == 1) PG8_BAR; }
    }
    PG8_WAIT_V(0);
    if constexpr (!ALIGN_EPI) { if (wr == 0) PG8_BAR; }
    PG8_BAR;
    if constexpr (Epi::AFTER_DRAIN) E.fused(acc, cur, wr, wc, fr, fq, lds, wid, lane);
#undef PG8_SA
#undef PG8_SB
#undef PG8_STAGE
#undef PG8_LDA
#undef PG8_LDB
#undef PG8_MMA
#undef PG8_WAIT_V
#undef PG8_WAIT_L
#undef PG8_WAIT_VL8
#undef PG8_WAIT_VL84
#undef PG8_BAR
#undef PG8_SCHED
}
__device__ __forceinline__ f32x4 pgp_y(const LAS char* Yb, const LAS float* rsd, const int j) {
    const u32x2 w = *(const LAS u32x2*)(Yb + j * 128); const float sc = rsd[j];
    return (f32x4){bflo(w.x) * sc, bfhi(w.x) * sc, bflo(w.y) * sc, bfhi(w.y) * sc};
}
}

namespace att {
constexpr int QBLK = 32, KVBLK = 64;
constexpr float SCALE = 0.072168783648703220f;
constexpr float THR = 8.f;
constexpr int SHM_V = 16384, SHM_KN = 16384, SHM_KR = 8192;
#define KSWZ(row, colB) ((row) * 256 + ((colB) ^ (((row) & 7) << 4)))
#define KRSWZ(row, colB) ((row) * 128 + ((colB) ^ (((row) & 7) << 4)))
#define SBAR() __builtin_amdgcn_sched_barrier(0)
#define LDS_BAR() asm volatile("s_waitcnt lgkmcnt(0)\n\ts_barrier" ::: "memory")
__device__ __forceinline__ int crow(int r, int hi) { return (r & 3) + 8 * (r >> 2) + 4 * hi; }
__device__ __forceinline__ void partialSM(f32x16& p0, f32x16& p1, float& m_reg, float& mn, float& alpha) {
  constexpr float C = SCALE * 1.4426950408889634f;
  float pmax = p0[0];
#pragma unroll
  for (int r = 1; r < 16; ++r) pmax = fmaxf(pmax, p0[r]);
#pragma unroll
  for (int r = 0; r < 16; ++r) pmax = fmaxf(pmax, p1[r]);
  { auto rr = __builtin_amdgcn_permlane32_swap(__float_as_uint(pmax), __float_as_uint(pmax), false, false);
    pmax = fmaxf(__uint_as_float(rr[0]), __uint_as_float(rr[1])); }
  if (__builtin_expect(__all(pmax - m_reg <= THR / SCALE), 1)) { mn = m_reg; alpha = 1.f; }
  else { mn = fmaxf(m_reg, pmax); alpha = __builtin_amdgcn_exp2f((m_reg - mn) * C); m_reg = mn; }
  float mnC = -mn * C;
#pragma unroll
  for (int r = 0; r < 16; ++r) p0[r] = fmaf(p0[r], C, mnC);
#pragma unroll
  for (int r = 0; r < 16; ++r) p1[r] = fmaf(p1[r], C, mnC);
#pragma unroll
  for (int r = 0; r < 16; ++r) p0[r] = __builtin_amdgcn_exp2f(p0[r]);
}
#define PK4(P, BASE, OUT) do { unsigned a0 = cvtpk(P[BASE + 0], P[BASE + 1]), a1 = cvtpk(P[BASE + 2], P[BASE + 3]);   \
    unsigned b0 = cvtpk(P[BASE + 4], P[BASE + 5]), b1 = cvtpk(P[BASE + 6], P[BASE + 7]);                              \
    auto r0 = __builtin_amdgcn_permlane32_swap(a0, b0, false, false); auto r1 = __builtin_amdgcn_permlane32_swap(a1, b1, false, false); \
    u32x4 w = {r0[0], r1[0], r0[1], r1[1]}; OUT = *reinterpret_cast<bf16x8*>(&w); } while (0)
__device__ __forceinline__ void finishSM(f32x16& p0, f32x16& p1, float alpha, float& l_reg, bf16x8& pa0, bf16x8& pa1, bf16x8& pa2, bf16x8& pa3) {
#pragma unroll
  for (int r = 0; r < 16; ++r) p1[r] = __builtin_amdgcn_exp2f(p1[r]);
  float ps = 0;
#pragma unroll
  for (int r = 0; r < 16; ++r) ps += p0[r];
#pragma unroll
  for (int r = 0; r < 16; ++r) ps += p1[r];
  { auto rr = __builtin_amdgcn_permlane32_swap(__float_as_uint(ps), __float_as_uint(ps), false, false);
    ps = __uint_as_float(rr[0]) + __uint_as_float(rr[1]); }
  l_reg = l_reg * alpha + ps;
  PK4(p0, 0, pa0); PK4(p0, 8, pa1); PK4(p1, 0, pa2); PK4(p1, 8, pa3);
}
__device__ __forceinline__ void qkt128(f32x16& p0, f32x16& p1, const char* Ks, const bf16x8* qr, int r32, int hi) {
#pragma unroll
  for (int d0 = 0; d0 < 8; ++d0) { int cb = (d0 * 16 + hi * 8) * 2;
    bf16x8 b0 = *reinterpret_cast<const bf16x8*>(Ks + KSWZ(r32, cb));
    bf16x8 b1 = *reinterpret_cast<const bf16x8*>(Ks + KSWZ(32 + r32, cb));
    p0 = __builtin_amdgcn_mfma_f32_32x32x16_bf16(b0, qr[d0], p0, 0, 0, 0);
    p1 = __builtin_amdgcn_mfma_f32_32x32x16_bf16(b1, qr[d0], p1, 0, 0, 0); }
}
__device__ __forceinline__ void qkt64(f32x16& p0, f32x16& p1, const char* Ks, const bf16x8* qr, int r32, int hi) {
#pragma unroll
  for (int d0 = 0; d0 < 4; ++d0) { int cb = (d0 * 16 + hi * 8) * 2;
    bf16x8 b0 = *reinterpret_cast<const bf16x8*>(Ks + KRSWZ(r32, cb));
    bf16x8 b1 = *reinterpret_cast<const bf16x8*>(Ks + KRSWZ(32 + r32, cb));
    p0 = __builtin_amdgcn_mfma_f32_32x32x16_bf16(b0, qr[d0], p0, 0, 0, 0);
    p1 = __builtin_amdgcn_mfma_f32_32x32x16_bf16(b1, qr[d0], p1, 0, 0, 0); }
}
__device__ __forceinline__ int v_st(int k, int c) { const int kk = (k & ~0xC) | ((k & 4) << 1) | ((k & 8) >> 1); return ((kk >> 3) * 4 + (c >> 5)) * 512 + ((kk & 7) * 32 + (c & 31)) * 2; }
__device__ __forceinline__ int v_rd_base(int lane) { return ((lane & 3) << 3) | (((lane >> 2) & 3) << 6) | (((lane >> 4) & 1) << 5) | (((lane >> 5) & 1) << 8); }
constexpr int v_rd_off(int d0, int ks, int half) { return d0 * 512 + ks * 4096 + half * 2048; }
template <int OFF> __device__ __forceinline__ s16x4 tr_read(int vb) {
  s16x4 r; asm volatile("ds_read_b64_tr_b16 %0, %1 offset:%2" : "=&v"(r) : "v"(vb), "i"(OFF) : "memory"); return r;
}
#define PKLH(L, H) (bf16x8){L[0], L[1], L[2], L[3], H[0], H[1], H[2], H[3]}
template <int D0> __device__ __forceinline__ void pv_one(f32x16& od, int vb, bf16x8 pa0, bf16x8 pa1, bf16x8 pa2, bf16x8 pa3) {
  const s16x4 l0 = tr_read<v_rd_off(D0, 0, 0)>(vb), h0 = tr_read<v_rd_off(D0, 0, 1)>(vb), l1 = tr_read<v_rd_off(D0, 1, 0)>(vb), h1 = tr_read<v_rd_off(D0, 1, 1)>(vb);
  const s16x4 l2 = tr_read<v_rd_off(D0, 2, 0)>(vb), h2 = tr_read<v_rd_off(D0, 2, 1)>(vb), l3 = tr_read<v_rd_off(D0, 3, 0)>(vb), h3 = tr_read<v_rd_off(D0, 3, 1)>(vb);
  asm volatile("s_waitcnt lgkmcnt(0)" ::: "memory"); SBAR();
  od = __builtin_amdgcn_mfma_f32_32x32x16_bf16(pa0, PKLH(l0, h0), od, 0, 0, 0);
  od = __builtin_amdgcn_mfma_f32_32x32x16_bf16(pa1, PKLH(l1, h1), od, 0, 0, 0);
  od = __builtin_amdgcn_mfma_f32_32x32x16_bf16(pa2, PKLH(l2, h2), od, 0, 0, 0);
  od = __builtin_amdgcn_mfma_f32_32x32x16_bf16(pa3, PKLH(l3, h3), od, 0, 0, 0);
}
__device__ __forceinline__ void pv_d0(f32x16* o, int vb, bf16x8 pa0, bf16x8 pa1, bf16x8 pa2, bf16x8 pa3) {
  pv_one<0>(o[0], vb, pa0, pa1, pa2, pa3); pv_one<1>(o[1], vb, pa0, pa1, pa2, pa3); pv_one<2>(o[2], vb, pa0, pa1, pa2, pa3); pv_one<3>(o[3], vb, pa0, pa1, pa2, pa3);
}

__device__ __forceinline__ void mla_body(const bf16_t* __restrict__ Qn, const bf16_t* __restrict__ Qr, const bf16_t* __restrict__ Kn, const bf16_t* __restrict__ Kr,
                                         const bf16_t* __restrict__ Vh, bf16_t* __restrict__ Ob, int ldo, int seq, char* lds, const int tid) {
  const int wid = tid >> 6, lane = tid & 63, r32 = lane & 31, hi = lane >> 5;
  char* V_lds = lds; char* K_lds = lds + 2 * SHM_V; char* R_lds = lds + 2 * SHM_V + 2 * SHM_KN;
  float* ws = (float*)(lds + 2 * SHM_V + 2 * SHM_KN + 2 * SHM_KR) + wid * 64; float* li_l = ws; float* al_l = ws + 32;
  float m_reg = -1e30f, l_reg = 0; f32x16 o[4] = {}; bf16x8 qr[12];
  { const bf16_t* Qw = Qn + (long)(wid * QBLK + r32) * 128 + hi * 8;
#pragma unroll
    for (int d0 = 0; d0 < 8; ++d0) qr[d0] = *reinterpret_cast<const bf16x8*>(Qw + d0 * 16);
    const bf16_t* Qw2 = Qr + (long)(wid * QBLK + r32) * 64 + hi * 8;
#pragma unroll
    for (int d0 = 0; d0 < 4; ++d0) qr[8 + d0] = *reinterpret_cast<const bf16x8*>(Qw2 + d0 * 16); }
  const int sr = tid >> 4, sc = (tid & 15) * 8, vst0 = v_st(sr, sc), vst1 = v_st(32 + sr, sc);
  const int rr = tid >> 3, rc = (tid & 7) * 8;
  const int vb0 = (int)(uintptr_t)V_lds + v_rd_base(lane);
  bf16x8 svs0, svs1, sks0, sks1, skr;
#define SLOAD(k0) do { svs0 = *reinterpret_cast<const bf16x8*>(&Vh[(long)((k0) + sr) * 128 + sc]); svs1 = *reinterpret_cast<const bf16x8*>(&Vh[(long)((k0) + 32 + sr) * 128 + sc]); \
    sks0 = *reinterpret_cast<const bf16x8*>(&Kn[(long)((k0) + sr) * 128 + sc]); sks1 = *reinterpret_cast<const bf16x8*>(&Kn[(long)((k0) + 32 + sr) * 128 + sc]); \
    skr = *reinterpret_cast<const bf16x8*>(&Kr[(long)((k0) + rr) * 64 + rc]); } while (0)
#define SWRITE(b) do { *(bf16x8*)(V_lds + (b) * SHM_V + vst0) = svs0; *(bf16x8*)(V_lds + (b) * SHM_V + vst1) = svs1; int kc = sc * 2;               \
    *(bf16x8*)(K_lds + (b) * SHM_KN + KSWZ(sr, kc)) = sks0; *(bf16x8*)(K_lds + (b) * SHM_KN + KSWZ(32 + sr, kc)) = sks1;                       \
    *(bf16x8*)(R_lds + (b) * SHM_KR + KRSWZ(rr, rc * 2)) = skr; } while (0)
#define RESC(a) do { if (__any((a) < 1.f)) { if (hi == 0) al_l[r32] = (a); asm volatile("s_waitcnt lgkmcnt(0)" ::: "memory"); \
    _Pragma("unroll") for (int d = 0; d < 4; ++d) _Pragma("unroll") for (int r = 0; r < 16; ++r) o[d][r] *= al_l[crow(r, hi)]; } } while (0)
  const int NT = seq / KVBLK;
  SLOAD(0); asm volatile("s_waitcnt vmcnt(0)" ::: "memory"); SWRITE(0); __syncthreads();
  for (int j = 0; j < NT; ++j) {
    const int buf = j & 1;
    if (j + 1 < NT) SLOAD((j + 1) * KVBLK);
    f32x16 p0 = {}, p1 = {}; float mn, al; bf16x8 pa0, pa1, pa2, pa3;
    qkt128(p0, p1, K_lds + buf * SHM_KN, qr, r32, hi); qkt64(p0, p1, R_lds + buf * SHM_KR, qr + 8, r32, hi);
    partialSM(p0, p1, m_reg, mn, al);
    RESC(al);
    finishSM(p0, p1, al, l_reg, pa0, pa1, pa2, pa3); SBAR();
    pv_d0(o, vb0 + buf * SHM_V, pa0, pa1, pa2, pa3);
    if (j + 1 < NT) { asm volatile("s_waitcnt vmcnt(0)" ::: "memory"); SWRITE(buf ^ 1); }
    __syncthreads();
  }
  if (hi == 0) li_l[r32] = l_reg; asm volatile("s_waitcnt lgkmcnt(0)" ::: "memory");
  float rli[16];
#pragma unroll
  for (int r = 0; r < 16; ++r) rli[r] = __builtin_amdgcn_rcpf(li_l[crow(r, hi)]);
  char* OT = lds + wid * 8704;
  { char* OTw = OT + (4 * hi) * 272 + r32 * 2; asm volatile("" : "+v"(OTw));
#pragma unroll
    for (int r = 0; r < 16; ++r) { const int rc = (r & 3) + 8 * (r >> 2);
#pragma unroll
      for (int d0 = 0; d0 < 4; ++d0) *(unsigned short*)(OTw + rc * 272 + d0 * 64) = (unsigned short)f2bf(o[d0][r] * rli[r]); } }
  asm volatile("s_waitcnt lgkmcnt(0)" ::: "memory");
  bf16_t* Ow = Ob + (long)(wid * QBLK) * ldo;
  { int ln = r32 + 32 * hi; asm volatile("" : "+v"(ln));
    const int rw = ln >> 4, ch = ln & 15;
#pragma unroll
    for (int i = 0; i < 8; ++i) { const int row = i * 4 + rw;
      *(u32x4*)(Ow + (long)row * ldo + ch * 8) = *(const u32x4*)(OT + row * 272 + ch * 16); } }
#undef SLOAD
#undef SWRITE
#undef RESC
}
}


#define XB_TMO      128
#define XB_XCNT(j)  (256  + 64 * (j))
#define XB_XSUB(j)  (1280 + 64 * (j))
#define XB_XGEN(j)  (2304 + 64 * (j))
#define XB_TOP      3328
#define XB_TOPGEN   3392
#define XCD_BAR_WORDS 3456
#define XB_SPIN_CAP (1u << 18)
__device__ __forceinline__ unsigned xb_ld(unsigned* p)              { return __hip_atomic_load(p, __ATOMIC_RELAXED, __HIP_MEMORY_SCOPE_AGENT); }
__device__ __forceinline__ unsigned xb_add(unsigned* p, unsigned v) { return __hip_atomic_fetch_add(p, v, __ATOMIC_RELAXED, __HIP_MEMORY_SCOPE_AGENT); }
__device__ __forceinline__ unsigned xb_xcc_id() { return (unsigned)__builtin_amdgcn_s_getreg((3 << 11) | 20) & 0xFu; }
#define XB_SPIN(cond, bar) do { unsigned _sp = 0; while (cond) { __builtin_amdgcn_s_sleep(1); \
    if ((++_sp & 255u) == 0u) { if (xb_ld(&(bar)[XB_TMO])) break; if (_sp > XB_SPIN_CAP) { atomicAdd(&(bar)[XB_TMO], 1u); break; } } } } while (0)
struct XcdBarrier { unsigned* bar; unsigned x; volatile LAS unsigned* st; };
__device__ __forceinline__ XcdBarrier xcd_barrier_post(unsigned* bar, volatile LAS unsigned* st) {
    XcdBarrier b; b.bar = bar; b.x = xb_xcc_id(); b.st = st;
    if (threadIdx.x == 0) (void)xb_add(&bar[XB_XCNT(b.x)], 1u);
    return b;
}
__device__ __forceinline__ void xcd_barrier_complete(unsigned* bar, unsigned x, unsigned& nloc, unsigned& nx) {
    const unsigned G = gridDim.x * gridDim.y * gridDim.z;
    unsigned sum, cnt, mine, sp = 0u;
    for (;;) {
        sum = 0u; cnt = 0u; mine = 0u;
#pragma unroll
        for (unsigned j = 0; j < 16; ++j) { const unsigned c = xb_ld(&bar[XB_XCNT(j)]); sum += c; cnt += (c > 0u) ? 1u : 0u; mine = (j == x) ? c : mine; }
        if (sum == G) break;
        __builtin_amdgcn_s_sleep(1);
        if ((++sp & 255u) == 0u) { if (xb_ld(&bar[XB_TMO])) break; if (sp > XB_SPIN_CAP) { atomicAdd(&bar[XB_TMO], 1u); break; } }
    }
    nloc = mine > 0u ? mine : 1u; nx = cnt > 0u ? cnt : 1u;
}
__device__ __forceinline__ void xcd_barrier(const XcdBarrier& b) {
    asm volatile("s_waitcnt vmcnt(0)" ::: "memory");
    __syncthreads();
    if (threadIdx.x == 0) {
        unsigned* bar = b.bar;
        __builtin_amdgcn_s_waitcnt(0);
        unsigned nloc = b.st[0], nx = b.st[1];
        if (nloc == 0u) { xcd_barrier_complete(bar, b.x, nloc, nx); b.st[0] = nloc; b.st[1] = nx; }
        const unsigned old = xb_add(&bar[XB_XSUB(b.x)], 1u);
        const unsigned gen = old / nloc;
        if (old + 1u == (gen + 1u) * nloc) {
            __builtin_amdgcn_fence(__ATOMIC_RELEASE, "agent");
            asm volatile("s_waitcnt vmcnt(0)" ::: "memory");
            const unsigned og = xb_add(&bar[XB_TOP], 1u);
            const unsigned tg = og / nx;
            if (og + 1u == (tg + 1u) * nx) xb_add(&bar[XB_TOPGEN], 1u);
            else XB_SPIN(xb_ld(&bar[XB_TOPGEN]) == tg, bar);
            __builtin_amdgcn_fence(__ATOMIC_ACQUIRE, "agent");
            xb_add(&bar[XB_XGEN(b.x)], 1u);
            asm volatile("s_waitcnt vmcnt(0)" ::: "memory");
        } else {
            XB_SPIN(xb_ld(&bar[XB_XGEN(b.x)]) == gen, bar);
            __builtin_amdgcn_fence(__ATOMIC_ACQUIRE, "agent");
            asm volatile("s_waitcnt vmcnt(0)" ::: "memory");
        }
    }
    __syncthreads();
}
constexpr int MISC_OFF = LDS_BYTES - 256;
constexpr size_t CTL_ZERO_BYTES = 64 * 1024;

struct Args { const float* in[23]; float* out; unsigned char* ws; int ph_lo, ph_hi; };

#ifndef ONLYMASK
#define ONLYMASK 0xffffffffu
#endif
#define EN(p) (((ONLYMASK) >> (p)) & 1u)
#ifndef REPMASK
#define REPMASK 0u
#endif
#define REP(p) (((REPMASK) >> (p)) & 1u)
enum Phase { PH_PREP = 0, PH_NORM1, PH_G1, PH_SPLIT1, PH_G2, PH_G3, PH_SPLIT2, PH_R1, PH_R2, PH_ATTN, PH_R3, PH_G4, PH_NORM2A, PH_G5, PH_CONVA, PH_G6,
             PH_RSTD, PH_POOL, PH_G7, PH_NORM2B, PH_G8, PH_CONVB, PH_G9, PH_FINAL, PH_COUNT };

__device__ __forceinline__ int map_col(int id, int n) {
    if (id == 0) return n;
    if (id == 1) { if (n < 2048) { const int j = n & 127; return (n & ~127) + (j >> 1) + (j & 1) * 64; } if (n < 4864) return n; if (n < INC) { const int j = n - 4864; return 4864 + (j >> 1) + (j & 1) * 32; } return -1; }
    if (id == 2) { if (n < 1024) return (n >> 7) * 192 + (n & 127); const int j = n - 1024, h = j >> 6, jj = j & 63; return h * 192 + 128 + (jj >> 1) + (jj & 1) * 32; }
    if (id == 3) { if (n < 1024) return (n >> 7) * 256 + (n & 127); const int j = n - 1024; return (j >> 7) * 256 + 128 + (j & 127); }
    return ((n >> 7) & 1) * FF + (n >> 8) * 128 + (n & 127);
}
__device__ __forceinline__ bool map_contig(int id, int n0) { return id == 1 ? (n0 >= 2048 && n0 + 32 <= 4864) : (id == 2 ? n0 < 1024 : true); }
struct TItem { const float* W; bf16_t* WT; const float* ks; int K, N, k0, n0, src; bool fast; };
__device__ __forceinline__ void titem_load(const TItem& t, f32x4 (&v)[8], int lane) {
    if (t.fast) { const int kr = lane >> 3, c4 = (lane & 7) * 4;
#pragma unroll
        for (int i = 0; i < 8; ++i) v[i] = __builtin_nontemporal_load((const f32x4*)(t.W + (size_t)(t.k0 + 8 * i + kr) * t.N + t.src + c4)); }
}
__device__ __forceinline__ void titem_process(const TItem& t, const f32x4 (&v)[8], LAS float* scr, int lane) {
    if (t.fast) { const int kr = lane >> 3, c4 = (lane & 7) * 4;
#pragma unroll
        for (int i = 0; i < 8; ++i) { f32x4 x = v[i]; if (t.ks) x *= t.ks[t.k0 + 8 * i + kr]; LAS float* d = scr + (8 * i + kr) * 33 + c4; d[0] = x.x; d[1] = x.y; d[2] = x.z; d[3] = x.w; }
    } else {
#pragma unroll 8
        for (int i = 0; i < 32; ++i) { const int kk = 2 * i + (lane >> 5); float x = 0.f; if (t.src >= 0) { x = t.W[(size_t)(t.k0 + kk) * t.N + t.src]; if (t.ks) x *= t.ks[t.k0 + kk]; } scr[kk * 33 + (lane & 31)] = x; }
    }
    asm volatile("s_waitcnt lgkmcnt(0)" ::: "memory");
    const int c = lane & 7;
#pragma unroll
    for (int j = 0; j < 4; ++j) { const int n = (lane >> 3) + 8 * j; const LAS float* sp = scr + (8 * c) * 33 + n;
        u32x4 o; o.x = pk2(sp[0 * 33], sp[1 * 33]); o.y = pk2(sp[2 * 33], sp[3 * 33]); o.z = pk2(sp[4 * 33], sp[5 * 33]); o.w = pk2(sp[6 * 33], sp[7 * 33]);
        *(u32x4*)(t.WT + (size_t)(t.n0 + n) * t.K + t.k0 + 8 * c) = o; }
    asm volatile("s_waitcnt lgkmcnt(0)" ::: "memory");
}


#define x_in (args.in[0])
#define c_in (args.in[1])
#define ctx_in (args.in[2])
#define cctx_in (args.in[3])
#define ada_w (args.in[4])
#define ada_b (args.in[5])
#define norm1_g (args.in[6])
#define norm2_g (args.in[7])
#define w_up (args.in[8])
#define conv_w (args.in[9])
#define conv_b (args.in[10])
#define w_down (args.in[11])
#define w_in (args.in[12])
#define qn_g (args.in[13])
#define w_uq (args.in[14])
#define kvn_g (args.in[15])
#define w_ukv (args.in[16])
#define dec_f (args.in[17])
#define dec_b (args.in[18])
#define w_out (args.in[19])
#define pool_w (args.in[20])
#define pool_scale (args.in[21])
#define final_g (args.in[22])
#define X (args.out)
#define ADA ((float*)(ws + WS_ADA))
#define RT128 ((f32x2*)(ws + WS_RT128))
#define RT64 ((f32x2*)(ws + WS_RT64))
#define RSTDQ ((float*)(ws + WS_RSTDQ))
#define RSTDKV ((float*)(ws + WS_RSTDKV))
#define RSTDX ((float*)(ws + WS_RSTDX))
#define WIN ((bf16_t*)(ws + WS_WIN))
#define WUQ ((bf16_t*)(ws + WS_WUQ))
#define WUKV ((bf16_t*)(ws + WS_WUKV))
#define WPOOL ((bf16_t*)(ws + WS_WPOOL))
#define WOUT ((bf16_t*)(ws + WS_WOUT))
#define WUP ((bf16_t*)(ws + WS_WUP))
#define WDN ((bf16_t*)(ws + WS_WDN))
#define H ((bf16_t*)(ws + WS_H))
#define XB2 ((bf16_t*)(ws + WS_MIX))
#define RQ ((bf16_t*)(ws + WS_RQ))
#define RK ((bf16_t*)(ws + WS_RK))
#define RV ((bf16_t*)(ws + WS_RV))
#define RG ((bf16_t*)(ws + WS_RG))
#define CQ ((bf16_t*)(ws + WS_CQ))
#define CKV ((bf16_t*)(ws + WS_CKV))
#define QN ((bf16_t*)(ws + WS_QN))
#define QR ((bf16_t*)(ws + WS_QR))
#define KN ((bf16_t*)(ws + WS_KN))
#define KR ((bf16_t*)(ws + WS_KR))
#define VC ((bf16_t*)(ws + WS_VC))
#define KVB ((bf16_t*)(ws + WS_KVB))
#define ST ((bf16_t*)(ws + WS_ST))
#define MIX ((bf16_t*)(ws + WS_MIX))
#define ACT ((bf16_t*)(ws + WS_ACT))
#define Z1 ((float*)(ws + WS_Z))
#define Z2 ((float*)(ws + WS_Z))
#define Z3 ((float*)(ws + WS_Z3))
#define U ((bf16_t*)(ws + WS_Z))
#define HALO ((float*)(ws + WS_Z))
#define XB ((bf16_t*)(ws + WS_XB))
#define PH_PARAMS const Args& args, unsigned char* ws, LAS unsigned char* lds, unsigned char* lds_raw, const int tid, const int lane, const int wave, const int bid, const int G, const int gw, const int NGW, const int ph
#define PH_CALL(p) args, ws, lds, lds_raw, tid, lane, wave, bid, G, gw, NGW, (p)
constexpr int CV_I0 = 32 * 160, CV_I1 = 8 * 48, CV_I2 = 4 * 64, CV_I3 = 32 * 64, CV_I4 = 32 * 352, CV_I6 = 88 * 64, CV_I8 = 8 * 16;
constexpr int CV_N0 = CV_I0 + CV_I1 + CV_I2 + CV_I3 + CV_I4 + CV_I6, CV_N1 = CV_I4 + CV_I6 + 4 * CV_I8;
__device__ __forceinline__ void convert_weights(PH_PARAMS, const int set, const int lo, const int hi, const int vw, const int nvw) {
    LAS float* scr = (LAS float*)(lds + wave * 16896);
    auto decode = [&](int it) -> TItem {
        TItem t; int r = it, nblk, id;
        if (set == 0) {
            if (r < CV_I0) { t.W = w_in; t.K = DM; t.N = INC; t.WT = WIN; t.ks = nullptr; nblk = 160; id = 1; }
            else if ((r -= CV_I0) < CV_I1) { t.W = w_uq; t.K = QRANK; t.N = 1536; t.WT = WUQ; t.ks = qn_g; nblk = 48; id = 2; }
            else if ((r -= CV_I1) < CV_I2) { t.W = w_ukv; t.K = KVRANK; t.N = 2048; t.WT = WUKV; t.ks = kvn_g; nblk = 64; id = 3; }
            else if ((r -= CV_I2) < CV_I3) { t.W = w_out; t.K = DM; t.N = DM; t.WT = WOUT; t.ks = nullptr; nblk = 64; id = 0; }
            else if ((r -= CV_I3) < CV_I4) { t.W = w_up; t.K = DM; t.N = FF2; t.WT = WUP; t.ks = nullptr; nblk = 352; id = 4; }
            else { r -= CV_I4; t.W = w_down; t.K = FF; t.N = DM; t.WT = WDN; t.ks = nullptr; nblk = 64; id = 0; }
        } else {
            if (r < CV_I4) { t.W = w_up + (size_t)DM * FF2; t.K = DM; t.N = FF2; t.WT = WUP + (size_t)FF2 * DM; t.ks = nullptr; nblk = 352; id = 4; }
            else if ((r -= CV_I4) < CV_I6) { t.W = w_down + (size_t)FF * DM; t.K = FF; t.N = DM; t.WT = WDN + (size_t)DM * FF; t.ks = nullptr; nblk = 64; id = 0; }
            else { r -= CV_I6; const int gi = r / CV_I8; r %= CV_I8; t.W = pool_w + (size_t)gi * 512 * 512; t.K = 512; t.N = 512; t.WT = WPOOL + (size_t)gi * 512 * 512; t.ks = nullptr; nblk = 16; id = 0; }
        }
        t.k0 = 64 * (r / nblk); t.n0 = 32 * (r % nblk); t.fast = map_contig(id, t.n0); t.src = map_col(id, t.fast ? t.n0 : t.n0 + (lane & 31));
        return t; };
    for (int it = lo + vw; it < hi; it += 2 * nvw) {
        const bool hb = it + nvw < hi;
        const TItem ta = decode(it), tb = decode(hb ? it + nvw : it);
        f32x4 va[8], vb[8];
        titem_load(ta, va, lane); if (hb) titem_load(tb, vb, lane);
        titem_process(ta, va, scr, lane); if (hb) titem_process(tb, vb, scr + 2112, lane);
    }
}

constexpr int CT_W_IN = 16 * 40, CT_W_UQ = 4 * 12, CT_W_UKV = 2 * 16, CT_W_OUT = 16 * 16, CT_W_UP = 16 * 88, CT_W_DN = 44 * 16, CT_POOL = 4 * 4;
constexpr int CT_N0 = CT_W_IN + CT_W_UQ + CT_W_UKV + CT_W_OUT + CT_W_UP + CT_W_DN, CT_N1 = CT_W_UP + CT_W_DN + 4 * CT_POOL;
struct CTile { const float* W; bf16_t* WT; const float* ks; int K, N, k0, n0, runA, runB, mode; };
__device__ __forceinline__ const float* ct_opaque(const float* p) { asm volatile("" : "+s"(p)); return p; }
__device__ __forceinline__ void ct_decode(const Args& args, unsigned char* ws, const int set, int r, CTile& t) {
    int ntn, nt, kt; t.ks = nullptr; t.mode = 0;
    if (set == 0 && r < CT_W_IN) { ntn = 40; kt = r / ntn; nt = r % ntn; t.W = ct_opaque(w_in); t.K = DM; t.N = INC; t.WT = WIN;
        if (nt < 16) { t.runA = nt * 128; t.runB = t.runA + 64; t.mode = 1; } else if (nt < 38) { t.runA = nt * 128; t.runB = t.runA + 64; } else if (nt == 38) { t.runA = 4864; t.runB = -1; t.mode = 2; } else { t.runA = -1; t.runB = -1; } }
    else if (set == 0 && (r -= CT_W_IN) < CT_W_UQ) { ntn = 12; kt = r / ntn; nt = r % ntn; t.W = ct_opaque(w_uq); t.K = QRANK; t.N = 1536; t.WT = WUQ; t.ks = qn_g;
        if (nt < 8) { t.runA = nt * 192; t.runB = t.runA + 64; } else { const int h0 = 2 * (nt - 8); t.runA = h0 * 192 + 128; t.runB = (h0 + 1) * 192 + 128; t.mode = 2; } }
    else if (set == 0 && (r -= CT_W_UQ) < CT_W_UKV) { ntn = 16; kt = r / ntn; nt = r % ntn; t.W = ct_opaque(w_ukv); t.K = KVRANK; t.N = 2048; t.WT = WUKV; t.ks = kvn_g;
        t.runA = nt < 8 ? nt * 256 : (nt - 8) * 256 + 128; t.runB = t.runA + 64; }
    else if (set == 0 && (r -= CT_W_UKV) < CT_W_OUT) { ntn = 16; kt = r / ntn; nt = r % ntn; t.W = ct_opaque(w_out); t.K = DM; t.N = DM; t.WT = WOUT; t.runA = nt * 128; t.runB = t.runA + 64; }
    else if (set == 0 ? (r -= CT_W_OUT) < CT_W_UP : r < CT_W_UP) { ntn = 88; kt = r / ntn; nt = r % ntn; const int l = set; t.W = ct_opaque(w_up + (size_t)l * DM * FF2); t.K = DM; t.N = FF2; t.WT = WUP + (size_t)l * FF2 * DM;
        t.runA = (nt & 1) * FF + (nt >> 1) * 128; t.runB = t.runA + 64; }
    else if ((r -= CT_W_UP) < CT_W_DN) { ntn = 16; kt = r / ntn; nt = r % ntn; const int l = set; t.W = ct_opaque(w_down + (size_t)l * FF * DM); t.K = FF; t.N = DM; t.WT = WDN + (size_t)l * DM * FF; t.runA = nt * 128; t.runB = t.runA + 64; }
    else { r -= CT_W_DN; const int gi = r / CT_POOL; r %= CT_POOL; ntn = 4; kt = r / ntn; nt = r % ntn; t.W = ct_opaque(pool_w + (size_t)gi * 512 * 512); t.K = 512; t.N = 512; t.WT = WPOOL + (size_t)gi * 512 * 512; t.runA = nt * 128; t.runB = t.runA + 64; }
    t.k0 = kt * 128; t.n0 = nt * 128;
}
__device__ __forceinline__ void ct_load(const CTile& t, f32x4 (&v)[8], const int wave, const int lane) {
    const int c = (lane & 31) * 4, run = c < 64 ? t.runA : t.runB;
    if (t.runA < 0 && t.runB < 0) {
#pragma unroll
        for (int i = 0; i < 8; ++i) v[i] = (f32x4){0.f, 0.f, 0.f, 0.f};
        return; }
    const int runc = run >= 0 ? run : t.runA;
    const float* p = t.W + (size_t)(t.k0 + wave * 16 + (lane >> 5)) * t.N + runc + (c & 63);
#pragma unroll
    for (int i = 0; i < 8; ++i) v[i] = __builtin_nontemporal_load((const f32x4*)(p + (size_t)(2 * i) * t.N));
    if (run < 0) {
#pragma unroll
        for (int i = 0; i < 8; ++i) v[i] = (f32x4){0.f, 0.f, 0.f, 0.f}; }
}
__device__ __forceinline__ void ct_put(const CTile& t, const f32x4 (&v)[8], LAS float* T, const int wave, const int lane) {
    const int c = (lane & 31) * 4, row0 = wave * 16 + (lane >> 5);
#pragma unroll
    for (int i = 0; i < 8; ++i) { f32x4 x = v[i]; const int row = row0 + 2 * i; if (t.ks) x *= t.ks[t.k0 + row]; LAS float* d = T + row * 129 + c; d[0] = x.x; d[1] = x.y; d[2] = x.z; d[3] = x.w; }
}
__device__ __forceinline__ void ct_store(const CTile& t, const LAS float* T, const int wave, const int lane) {
    const int c8 = lane & 7;
#pragma unroll
    for (int j = 0; j < 4; ++j) { const int half = j & 1, n = wave * 16 + (j >> 1) * 8 + (lane >> 3), kk0 = half * 64 + c8 * 8;
        const int lc = t.mode == 0 ? n : (t.mode == 1 ? (n >> 1) + (n & 1) * 64 : (n & 64) + ((n & 63) >> 1) + (n & 1) * 32);
        const LAS float* sp = T + kk0 * 129 + lc;
        u32x4 o; o.x = pk2(sp[0 * 129], sp[1 * 129]); o.y = pk2(sp[2 * 129], sp[3 * 129]); o.z = pk2(sp[4 * 129], sp[5 * 129]); o.w = pk2(sp[6 * 129], sp[7 * 129]);
        *(u32x4*)(t.WT + (size_t)(t.n0 + n) * t.K + t.k0 + kk0) = o; }
}
__device__ __forceinline__ void convert_tiles2(PH_PARAMS, const int set, const int lo1, const int hi1, const int lo2, const int hi2, const int vb, const int nvb) {
    const int n1 = hi1 - lo1, hi = n1 + (hi2 - lo2), lo = 0;
#define CT_IDX(v) ((v) < n1 ? lo1 + (v) : lo2 + ((v) - n1))
    LAS float* T0 = (LAS float*)lds; LAS float* T1 = (LAS float*)(lds + 66048);
    const int it = lo + vb; if (it >= hi) return;
    CTile tc, ta, tb; f32x4 vA[8], vB[8];
    ct_decode(args, ws, set, CT_IDX(it), tc); ct_load(tc, vA, wave, lane);
    __syncthreads();
    ct_put(tc, vA, T0, wave, lane);
    bool hasA = it + nvb < hi, hasB = it + 2 * nvb < hi; ta = tc; tb = tc;
    if (hasA) { ct_decode(args, ws, set, CT_IDX(it + nvb), ta); ct_load(ta, vA, wave, lane); }
    if (hasB) { ct_decode(args, ws, set, CT_IDX(it + 2 * nvb), tb); ct_load(tb, vB, wave, lane); }
    __syncthreads();
    int nx = it + 3 * nvb, cur = 0;
    for (;;) {
        ct_store(tc, cur ? T1 : T0, wave, lane);
        if (!hasA) break;
        ct_put(ta, vA, cur ? T0 : T1, wave, lane); tc = ta;
        hasA = hasB && nx < hi;
        if (hasA) { ct_decode(args, ws, set, CT_IDX(nx), ta); ct_load(ta, vA, wave, lane); }
        nx += nvb;
        __syncthreads(); cur ^= 1;
        ct_store(tc, cur ? T1 : T0, wave, lane);
        if (!hasB) break;
        ct_put(tb, vB, cur ? T0 : T1, wave, lane); tc = tb;
        hasB = hasA && nx < hi;
        if (hasB) { ct_decode(args, ws, set, CT_IDX(nx), tb); ct_load(tb, vB, wave, lane); }
        nx += nvb;
        __syncthreads(); cur ^= 1;
    }
    __syncthreads();
}
#undef CT_IDX
__device__ __forceinline__ void convert_tiles(PH_PARAMS, const int set, const int lo, const int hi, const int vb, const int nvb) { convert_tiles2(PH_CALL(ph), set, lo, hi, 0, 0, vb, nvb); }
__device__ __forceinline__ void ada_items(PH_PARAMS, const int l, const int vb, const int nvb) {
        {
            LAS float* sil = (LAS float*)lds; LAS float* red = (LAS float*)(lds + 5 * 2048 * 4);
            for (int i = tid; i < 5 * 2048; i += 512) { const int r = i >> 11, k = i & 2047; const float v = r < 4 ? c_in[r * 2048 + k] : cctx_in[k]; sil[i] = v / (1.f + expf(-v)); }
            __syncthreads();
            for (int item = vb; item < 128; item += nvb) {
                const int n0 = item * 96, kq = lane >> 3, c4 = (lane & 7) * 4;
                const float* Wp = ada_w + (size_t)l * DM * NADA + n0 + c4;
                f32x4 a[5][3];
#pragma unroll
                for (int r = 0; r < 5; ++r)
#pragma unroll
                    for (int j = 0; j < 3; ++j) a[r][j] = (f32x4){0.f, 0.f, 0.f, 0.f};
                const int kbeg = wave * 256 + kq;
                const float* wp = Wp + (size_t)kbeg * NADA; const LAS float* sp = sil + kbeg;
#define ADA_LOAD(W) do { _Pragma("unroll") for (int u = 0; u < 4; ++u) _Pragma("unroll") for (int j = 0; j < 3; ++j) W[u][j] = __builtin_nontemporal_load((const f32x4*)(wp + (size_t)(8 * u) * NADA + 32 * j)); wp += (size_t)32 * NADA; } while (0)
#define ADA_FMA(W) do { _Pragma("unroll") for (int u = 0; u < 4; ++u) _Pragma("unroll") for (int r = 0; r < 5; ++r) { const float sv = sp[r * 2048 + 8 * u]; \
                        _Pragma("unroll") for (int j = 0; j < 3; ++j) a[r][j] += W[u][j] * sv; } sp += 32; } while (0)
                f32x4 wv0[4][3], wv1[4][3];
                ADA_LOAD(wv0);
#pragma unroll 1
                for (int kk = 0; kk < 8; kk += 2) {
                    ADA_LOAD(wv1);
                    ADA_FMA(wv0);
                    if (kk + 2 < 8) ADA_LOAD(wv0);
                    ADA_FMA(wv1);
                }
#undef ADA_LOAD
#undef ADA_FMA
#pragma unroll
                for (int r = 0; r < 5; ++r)
#pragma unroll
                    for (int j = 0; j < 3; ++j) {
#pragma unroll
                        for (int q = 0; q < 4; ++q) { float v = a[r][j][q]; v += __shfl_xor(v, 8); v += __shfl_xor(v, 16); v += __shfl_xor(v, 32); a[r][j][q] = v; }
                        if (kq == 0) *(LAS f32x4*)(red + (wave * 5 + r) * 96 + 32 * j + c4) = a[r][j]; }
                __syncthreads();
                if (tid < 5 * 96) { const int r = tid / 96, j = tid % 96; float sum = ada_b[l * NADA + n0 + j];
#pragma unroll
                    for (int w = 0; w < 8; ++w) sum += red[(w * 5 + r) * 96 + j];
                    ADA[(size_t)(l * 5 + r) * NADA + n0 + j] = sum; }
                __syncthreads();
            }
            __syncthreads();
        }
}
__device__ __forceinline__ void phase_PREP(PH_PARAMS) {
        if (G == 256) ada_items(PH_CALL(ph), bid >> 7, bid & 127, 128);
        else { ada_items(PH_CALL(ph), 0, bid, G); __syncthreads(); ada_items(PH_CALL(ph), 1, bid, G); }
        asm volatile("s_waitcnt vmcnt(0)" ::: "memory"); __syncthreads();
        if (tid == 0) { __builtin_amdgcn_fence(__ATOMIC_RELEASE, "agent"); asm volatile("s_waitcnt vmcnt(0)" ::: "memory"); __hip_atomic_fetch_add((unsigned*)(ws + WS_CTL + 49152), 1u, __ATOMIC_RELAXED, __HIP_MEMORY_SCOPE_AGENT); }
    for (int i = bid * 512 + tid; i < 32768 + 8192; i += G * 512) ((float*)(ws + WS_RSTDQ))[i] = 0.f;
        for (int i = bid * 512 + tid; i < 2048 * 96; i += G * 512) {
            const int t = i / 96, e = i % 96; const float row = (float)(t >> 6), col = (float)(t & 63);
            float s, c;
            if (e < 64) { const int nf = 32; const int j = e < nf ? e : e - nf; const float inv = exp2f(-(float)j / (float)nf * 13.287712379549449f); const float ang = (e < nf ? row : col) * inv;
                sincos_acc(ang, s, c); RT128[t * 64 + e] = (f32x2){c, s}; }
            else { const int e2 = e - 64; const int nf = 16; const int j = e2 < nf ? e2 : e2 - nf; const float inv = exp2f(-(float)j / (float)nf * 13.287712379549449f); const float ang = (e2 < nf ? row : col) * inv;
                sincos_acc(ang, s, c); RT64[t * 32 + e2] = (f32x2){c, s}; }
        }
        if (G == 256) convert_tiles(PH_CALL(ph), 0, 0, CT_N0 - CT_W_DN, bid, G);
        else convert_tiles(PH_CALL(ph), 0, 0, CT_N0, bid, G);
        if (tid == 0) { unsigned spins = 0; while (__hip_atomic_load((unsigned*)(ws + WS_CTL + 49152), __ATOMIC_RELAXED, __HIP_MEMORY_SCOPE_AGENT) < (unsigned)G) { __builtin_amdgcn_s_sleep(2); if (++spins > (1u << 20)) break; }
            __builtin_amdgcn_fence(__ATOMIC_ACQUIRE, "agent"); asm volatile("s_waitcnt vmcnt(0)" ::: "memory"); }
        __syncthreads();
}
__device__ __forceinline__ void phase_NORM(PH_PARAMS) {
        const int l = (ph == PH_NORM2B); const int nrows = (ph == PH_NORM1) ? MALL : MLAT;
        const float* gvec = (ph == PH_NORM1 ? norm1_g : norm2_g) + l * DM;
        const int shc = (ph == PH_NORM1) ? 0 : 3;
        LAS float* gm = (LAS float*)lds; LAS float* sm = gm + 5 * DM;
        for (int i = tid; i < 5 * DM / 4; i += 512) { const int r = i / (DM / 4), c = (i % (DM / 4)) * 4;
            const float* sh = ADA + (size_t)(l * 5 + r) * NADA + shc * DM; const float* sc = sh + DM;
            *(LAS f32x4*)(gm + r * DM + c) = *(const f32x4*)(gvec + c) * (*(const f32x4*)(sc + c) + 1.0f); *(LAS f32x4*)(sm + r * DM + c) = *(const f32x4*)(sh + c); }
        __syncthreads();
#define NORM_ROW(m_) ((ph == PH_NORM1) ? ((m_) < MLAT ? x_in + (size_t)(m_) * DM : ctx_in + (size_t)((m_) - MLAT) * DM) : X + (size_t)(m_) * DM)
        int m = gw; if (m >= nrows) return;
        f32x4 v[8], vn[8];
        { const float* xrow = NORM_ROW(m);
#pragma unroll
          for (int j = 0; j < 8; ++j) v[j] = ((const f32x4*)xrow)[lane + 64 * j]; }
        for (;;) {
            const int mn = m + NGW; const bool more = mn < nrows;
            if (more) { const float* xn = NORM_ROW(mn);
#pragma unroll
                for (int j = 0; j < 8; ++j) vn[j] = ((const f32x4*)xn)[lane + 64 * j]; }
            const int r = (ph == PH_NORM1 && m >= MLAT) ? 4 : (m >> 11);
            float ss = 0.f;
#pragma unroll
            for (int j = 0; j < 8; ++j) ss += (v[j].x * v[j].x + v[j].y * v[j].y) + (v[j].z * v[j].z + v[j].w * v[j].w);
            const float rstd = 1.0f / sqrtf(wave_sum(ss) * (1.0f / DM) + EPS);
            bf16_t* orow = H + (size_t)m * DM;
#pragma unroll
            for (int j = 0; j < 8; ++j) { const int idx = 4 * (lane + 64 * j);
                const f32x4 y = (v[j] * rstd) * *(const LAS f32x4*)(gm + r * DM + idx) + *(const LAS f32x4*)(sm + r * DM + idx);
                u32x2 w; w.x = pk2(y.x, y.y); w.y = pk2(y.z, y.w); *(u32x2*)(orow + idx) = w; }
            if (!more) break;
#pragma unroll
            for (int j = 0; j < 8; ++j) v[j] = vn[j];
            m = mn;
        }
#undef NORM_ROW
}
__device__ __forceinline__ void phase_FINAL(PH_PARAMS) {
        for (int m = gw; m < MLAT; m += NGW) {
            float* xrow = X + (size_t)m * DM; f32x4 v[8]; float ss = 0.f;
#pragma unroll
            for (int j = 0; j < 8; ++j) { v[j] = ((const f32x4*)xrow)[lane + 64 * j]; ss += (v[j].x * v[j].x + v[j].y * v[j].y) + (v[j].z * v[j].z + v[j].w * v[j].w); }
            const float rstd = 1.0f / sqrtf(wave_sum(ss) * (1.0f / DM) + EPS);
#pragma unroll
            for (int j = 0; j < 8; ++j) { const int idx = 4 * (lane + 64 * j); const f32x4 gg = *(const f32x4*)(final_g + idx); ((f32x4*)xrow)[lane + 64 * j] = v[j] * rstd * gg; }
        }
}
__device__ __forceinline__ void phase_R1(PH_PARAMS) {
        char* ldsg = (char*)lds_raw;
        const int r32 = lane & 31, hi = lane >> 5;
        const int sr = tid >> 4, sc = (tid & 15) * 8;
        u32x4 kq[2][2], vq[2][2];
#define R1_LOAD(item_) do { const int bh_ = (item_) / NCHUNK, ci_ = (item_) % NCHUNK; const int key0_ = ci_ < 2 ? ci_ * 128 : CTX + (ci_ - 2) * 128; \
            const bf16_t* Kp_ = RK + ((size_t)bh_ * NKEY + key0_) * HD; const bf16_t* Vp_ = RV + ((size_t)bh_ * NKEY + key0_) * HD; \
            _Pragma("unroll") for (int tl = 0; tl < 2; ++tl) _Pragma("unroll") for (int hh = 0; hh < 2; ++hh) { const int m_ = 64 * tl + 32 * hh + sr; \
                kq[tl][hh] = *(const u32x4*)(Kp_ + (size_t)m_ * HD + sc); vq[tl][hh] = *(const u32x4*)(Vp_ + (size_t)m_ * HD + sc); } } while (0)
        if (bid < 32 * NCHUNK) R1_LOAD(bid);
        for (int item = bid; item < 32 * NCHUNK; item += G) {
            const int bh = item / NCHUNK, ci = item % NCHUNK, h = bh & 7;
            const float xf = dec_f[h], xb = dec_b[h];
            const float lf2 = -log1pf(expf(-xf)) * 1.4426950408889634f, lb2 = -log1pf(expf(-xb)) * 1.4426950408889634f;
#pragma unroll
            for (int tl = 0; tl < 2; ++tl)
#pragma unroll
                for (int hh = 0; hh < 2; ++hh) { const int row = 32 * hh + sr, m = 64 * tl + row;
                    const u32x4 kv = kq[tl][hh]; const u32x4 vv = vq[tl][hh];
                    const float ff = __builtin_amdgcn_exp2f((float)(127 - m) * lf2), fb = __builtin_amdgcn_exp2f((float)m * lb2);
                    u32x4 vf, vb;
                    vf.x = pk2(bflo(vv.x) * ff, bfhi(vv.x) * ff); vf.y = pk2(bflo(vv.y) * ff, bfhi(vv.y) * ff); vf.z = pk2(bflo(vv.z) * ff, bfhi(vv.z) * ff); vf.w = pk2(bflo(vv.w) * ff, bfhi(vv.w) * ff);
                    vb.x = pk2(bflo(vv.x) * fb, bfhi(vv.x) * fb); vb.y = pk2(bflo(vv.y) * fb, bfhi(vv.y) * fb); vb.z = pk2(bflo(vv.z) * fb, bfhi(vv.z) * fb); vb.w = pk2(bflo(vv.w) * fb, bfhi(vv.w) * fb);
                    const int o = att::v_st(row, sc);
                    *(u32x4*)(ldsg + tl * 16384 + o) = kv; *(u32x4*)(ldsg + 32768 + tl * 16384 + o) = vf; *(u32x4*)(ldsg + 65536 + tl * 16384 + o) = vb; }
            LDS_BAR();
            if (item + G < 32 * NCHUNK) R1_LOAD(item + G);
            const int D0 = wave & 3, eh = wave >> 2;
            const int base = (int)(uintptr_t)ldsg + att::v_rd_base(lane);
            const int kb = base + D0 * 512, fb0 = base + 32768 + (2 * eh) * 512, bb0 = base + 65536 + (2 * eh) * 512;
            f32x16 af0 = {}, af1 = {}, ab0 = {}, ab1 = {};
#define R1_STEP(TL, KS) do { const int off_ = (TL) * 16384; \
                const s16x4 kl = att::tr_read<att::v_rd_off(0, KS, 0)>(kb + off_), kh = att::tr_read<att::v_rd_off(0, KS, 1)>(kb + off_); \
                const s16x4 f0l = att::tr_read<att::v_rd_off(0, KS, 0)>(fb0 + off_), f0h = att::tr_read<att::v_rd_off(0, KS, 1)>(fb0 + off_); \
                const s16x4 f1l = att::tr_read<att::v_rd_off(1, KS, 0)>(fb0 + off_), f1h = att::tr_read<att::v_rd_off(1, KS, 1)>(fb0 + off_); \
                const s16x4 b0l = att::tr_read<att::v_rd_off(0, KS, 0)>(bb0 + off_), b0h = att::tr_read<att::v_rd_off(0, KS, 1)>(bb0 + off_); \
                const s16x4 b1l = att::tr_read<att::v_rd_off(1, KS, 0)>(bb0 + off_), b1h = att::tr_read<att::v_rd_off(1, KS, 1)>(bb0 + off_); \
                asm volatile("s_waitcnt lgkmcnt(0)" ::: "memory"); SBAR(); \
                const bf16x8 ka = PKLH(kl, kh); \
                af0 = __builtin_amdgcn_mfma_f32_32x32x16_bf16(ka, PKLH(f0l, f0h), af0, 0, 0, 0); af1 = __builtin_amdgcn_mfma_f32_32x32x16_bf16(ka, PKLH(f1l, f1h), af1, 0, 0, 0); \
                ab0 = __builtin_amdgcn_mfma_f32_32x32x16_bf16(ka, PKLH(b0l, b0h), ab0, 0, 0, 0); ab1 = __builtin_amdgcn_mfma_f32_32x32x16_bf16(ka, PKLH(b1l, b1h), ab1, 0, 0, 0); } while (0)
            R1_STEP(0, 0); R1_STEP(0, 1); R1_STEP(0, 2); R1_STEP(0, 3); R1_STEP(1, 0); R1_STEP(1, 1); R1_STEP(1, 2); R1_STEP(1, 3);
#undef R1_STEP
            LDS_BAR();
            { char* OT = ldsg + wave * 17408;
#pragma unroll
              for (int r = 0; r < 16; ++r) { const int rr = att::crow(r, hi);
                  *(float*)(OT + rr * 272 + r32 * 4) = af0[r]; *(float*)(OT + rr * 272 + (32 + r32) * 4) = af1[r];
                  *(float*)(OT + 8704 + rr * 272 + r32 * 4) = ab0[r]; *(float*)(OT + 8704 + rr * 272 + (32 + r32) * 4) = ab1[r]; }
              asm volatile("s_waitcnt lgkmcnt(0)" ::: "memory");
              bf16_t* of = KVB + ((size_t)(bh * NCHUNK + ci) * 2 + 0) * 16384 + (size_t)(32 * D0) * 128 + 64 * eh;
#pragma unroll
              for (int dir = 0; dir < 2; ++dir)
#pragma unroll
                  for (int i = 0; i < 8; ++i) { const int row = i * 4 + (lane >> 4), ch = lane & 15;
                      stbf4(of + (size_t)dir * 16384 + row * 128 + ch * 4, *(const f32x4*)(OT + dir * 8704 + row * 272 + ch * 16)); } }
            LDS_BAR();
        }
}
#undef R1_LOAD
__device__ __forceinline__ void phase_R2(PH_PARAMS) {
        for (int it = bid * 512 + tid; it < 64 * 4096; it += G * 512) {
            const int e4 = it & 4095, dir = (it >> 12) & 1, bh = it >> 13, h = bh & 7;
            const float xd = dir ? dec_b[h] : dec_f[h]; const float g128 = expf(128.f * -log1pf(expf(-xd)));
            const bf16_t* kv = KVB + ((size_t)bh * NCHUNK * 2 + dir) * 16384 + 4 * e4;
            bf16_t* st = ST + ((size_t)bh * 16 * 2 + dir) * 16384 + 4 * e4;
            u32x2 a[17];
#pragma unroll
            for (int i = 0; i < 17; ++i) { const int ci = dir == 0 ? i : (i == 0 ? 1 : (i == 1 ? 0 : 19 - i)); a[i] = *(const u32x2*)(kv + (size_t)ci * 32768); }
#define BF4(w) ((f32x4){bflo((w).x), bfhi((w).x), bflo((w).y), bfhi((w).y)})
            f32x4 S = BF4(a[0]) * g128 + BF4(a[1]);
#pragma unroll
            for (int k = 0; k < 16; ++k) { const int c = dir == 0 ? k : 15 - k; stbf4(st + (size_t)c * 32768, S);
                if (k < 15) S = S * g128 + BF4(a[2 + k]); }
#undef BF4
        }
}
__device__ __forceinline__ void phase_ATTN(PH_PARAMS) {
        for (int item = bid; item < 256; item += G) {
            const int xcd = item & 7, slot = item >> 3, bh = xcd * 4 + (slot >> 3), qb = slot & 7, b = bh >> 3, h = bh & 7;
            att::mla_body(QN + ((size_t)bh * SEQ + qb * 256) * HD, QR + ((size_t)bh * SEQ + qb * 256) * DR, KN + (size_t)bh * NKEY * HD, KR + (size_t)b * NKEY * DR, VC + (size_t)bh * NKEY * HD,
                          MIX + ((size_t)(b * SEQ + qb * 256)) * DM + 1024 + h * HD, DM, NKEY, (char*)lds_raw, tid);
            __syncthreads();
        }
}
__device__ __forceinline__ void phase_R3(PH_PARAMS) {
        char* ldsg = (char*)lds_raw;
        const int r32 = lane & 31, hi = lane >> 5;
        const int sr = tid >> 4, sc = (tid & 15) * 8;
        float* part = (float*)(ldsg + 131072);
        for (int item = bid; item < 32 * 16; item += G) {
            const int bh = item >> 4, c = item & 15, b = bh >> 3, h = bh & 7;
            const float xf = dec_f[h], xb = dec_b[h];
            const float lf2 = -log1pf(expf(-xf)) * 1.4426950408889634f, lb2 = -log1pf(expf(-xb)) * 1.4426950408889634f;
            const bf16_t* Kp = RK + ((size_t)bh * NKEY + CTX + c * 128) * HD; const bf16_t* Vp = RV + ((size_t)bh * NKEY + CTX + c * 128) * HD;
            const bf16_t* Sp = ST + (size_t)(bh * 16 + c) * 32768;
            { u32x4 t0[4], t1[4];
#pragma unroll
              for (int q = 0; q < 4; ++q) { const int tl = q >> 1, hh = q & 1; const int row = 32 * hh + sr, m = 64 * tl + row;
                  t0[q] = *(const u32x4*)(Kp + (size_t)m * HD + sc); t1[q] = *(const u32x4*)(Vp + (size_t)m * HD + sc); }
#pragma unroll
              for (int q = 0; q < 4; ++q) { const int tl = q >> 1, hh = q & 1; const int row = 32 * hh + sr;
                  *(u32x4*)(ldsg + tl * 16384 + KSWZ(row, sc * 2)) = t0[q]; *(u32x4*)(ldsg + 32768 + tl * 16384 + att::v_st(row, sc)) = t1[q]; }
              asm volatile("" ::: "memory");
#pragma unroll
              for (int q = 0; q < 8; ++q) { const int tl = q >> 1, hh = q & 1; const int row = 32 * hh + sr, m = 64 * tl + row;
                  if (q < 4) t0[q] = *(const u32x4*)(Sp + (size_t)m * 128 + sc); else t1[q - 4] = *(const u32x4*)(Sp + (size_t)m * 128 + sc); }
#pragma unroll
              for (int q = 0; q < 8; ++q) { const int tl = q >> 1, hh = q & 1; const int row = 32 * hh + sr;
                  *(u32x4*)(ldsg + 65536 + tl * 16384 + att::v_st(row, sc)) = (q < 4) ? t0[q] : t1[q - 4]; }
              asm volatile("" ::: "memory"); }
            const int qw = wave & 3, ch = wave >> 2; int n = 32 * qw + r32;
            asm volatile("" : "+v"(n));
            bf16x8 qr[8];
            { const bf16_t* Qw = RQ + ((size_t)bh * SEQ + c * 128 + n) * HD + hi * 8;
#pragma unroll
              for (int d0 = 0; d0 < 8; ++d0) qr[d0] = *reinterpret_cast<const bf16x8*>(Qw + d0 * 16); }
            __syncthreads();
            f32x16 o0 = {}, o1 = {};
            const int vb = (int)(uintptr_t)ldsg + att::v_rd_base(lane);
#pragma unroll
            for (int tl = 0; tl < 2; ++tl) {
                f32x16 p0 = {}, p1 = {};
                att::qkt128(p0, p1, ldsg + tl * 16384, qr, r32, hi);
#pragma unroll
                for (int r = 0; r < 16; ++r) { const float d0f = (float)(n - (64 * tl + att::crow(r, hi))), d1f = d0f - 32.f;
                    p0[r] *= __builtin_amdgcn_exp2f(fmaxf(d0f, 0.f) * lf2 + fmaxf(-d0f, 0.f) * lb2);
                    p1[r] *= __builtin_amdgcn_exp2f(fmaxf(d1f, 0.f) * lf2 + fmaxf(-d1f, 0.f) * lb2); }
                bf16x8 pa0, pa1, pa2, pa3;
                PK4(p0, 0, pa0); PK4(p0, 8, pa1); PK4(p1, 0, pa2); PK4(p1, 8, pa3);
                const int vt = vb + 32768 + tl * 16384;
                if (ch == 0) { att::pv_one<0>(o0, vt, pa0, pa1, pa2, pa3); att::pv_one<1>(o1, vt, pa0, pa1, pa2, pa3); }
                else { att::pv_one<2>(o0, vt, pa0, pa1, pa2, pa3); att::pv_one<3>(o1, vt, pa0, pa1, pa2, pa3); }
            }
#pragma unroll 1
            for (int dir = 0; dir < 2; ++dir) {
                const float sf = __builtin_amdgcn_exp2f(dir == 0 ? (float)(n + 1) * lf2 : (float)(128 - n) * lb2);
#pragma unroll
                for (int kt = 0; kt < 2; ++kt) {
                    bf16x8 qs[4];
#pragma unroll
                    for (int d0 = 0; d0 < 4; ++d0) { const u32x4 w = *reinterpret_cast<const u32x4*>(&qr[4 * kt + d0]); u32x4 o;
                        o.x = cvtpk(bflo(w.x) * sf, bfhi(w.x) * sf); o.y = cvtpk(bflo(w.y) * sf, bfhi(w.y) * sf); o.z = cvtpk(bflo(w.z) * sf, bfhi(w.z) * sf); o.w = cvtpk(bflo(w.w) * sf, bfhi(w.w) * sf);
                        qs[d0] = *reinterpret_cast<const bf16x8*>(&o); }
                    const int vt = vb + 65536 + (dir * 2 + kt) * 16384;
                    if (ch == 0) { att::pv_one<0>(o0, vt, qs[0], qs[1], qs[2], qs[3]); att::pv_one<1>(o1, vt, qs[0], qs[1], qs[2], qs[3]); }
                    else { att::pv_one<2>(o0, vt, qs[0], qs[1], qs[2], qs[3]); att::pv_one<3>(o1, vt, qs[0], qs[1], qs[2], qs[3]); } }
            }
            float sq[16];
#pragma unroll
            for (int r = 0; r < 16; ++r) { float v = o0[r] * o0[r] + o1[r] * o1[r];
                v += __shfl_xor(v, 1); v += __shfl_xor(v, 2); v += __shfl_xor(v, 4); v += __shfl_xor(v, 8); v += __shfl_xor(v, 16); sq[r] = v; }
            if (r32 == 0) {
#pragma unroll
                for (int r = 0; r < 16; ++r) part[ch * 128 + 32 * qw + att::crow(r, hi)] = sq[r]; }
            __syncthreads();
            { float* OT = (float*)ldsg;
              float* OTb = OT + (32 * qw + 4 * hi) * 132 + 64 * ch + r32; const float* pb = part + 32 * qw + 4 * hi;
              asm volatile("" : "+v"(OTb), "+v"(pb));
#pragma unroll
              for (int r = 0; r < 16; ++r) { const int rc = (r & 3) + 8 * (r >> 2); const float tot = pb[rc] + pb[128 + rc];
                  const float rn = 1.0f / sqrtf(tot * (1.0f / 128.f) + EPS);
                  OTb[rc * 132] = o0[r] * rn; OTb[rc * 132 + 32] = o1[r] * rn; }
              __syncthreads();
              const int orow = tid >> 2, oc0 = (tid & 3) * 32; const size_t grow = (size_t)b * SEQ + c * 128 + orow;
              const bf16_t* gp = RG + grow * 1024 + h * HD + oc0; bf16_t* mp = MIX + grow * DM + h * HD + oc0; const float* op = OT + orow * 132 + oc0;
#pragma unroll
              for (int q = 0; q < 4; ++q) { const u32x4 gw4 = *(const u32x4*)(gp + 8 * q); const f32x4 a = *(const f32x4*)(op + 8 * q), bq = *(const f32x4*)(op + 8 * q + 4);
                  u32x4 w; w.x = pk2(a.x * silu_f(bflo(gw4.x)), a.y * silu_f(bfhi(gw4.x))); w.y = pk2(a.z * silu_f(bflo(gw4.y)), a.w * silu_f(bfhi(gw4.y)));
                  w.z = pk2(bq.x * silu_f(bflo(gw4.z)), bq.y * silu_f(bfhi(gw4.z))); w.w = pk2(bq.z * silu_f(bflo(gw4.w)), bq.w * silu_f(bfhi(gw4.w)));
                  *(u32x4*)(mp + 8 * q) = w; } }
            __syncthreads();
        }
}
__device__ __forceinline__ void phase_POOL(PH_PARAMS) {
    LAS float* Y = (LAS float*)lds;
    const float* gvec = norm1_g + DM; const float* ssq = RSTDX;
    const int c4 = (tid & 63) * 4, rg = tid >> 6;
    u32x2 raw[10]; float q[10]; f32x4 g0, g1;
#define POOL_LOAD(item_) do { const int tt_ = (item_) >> 3, cb_ = (item_) & 7, b_ = tt_ >> 5, t0_ = (tt_ & 31) * 64; \
        _Pragma("unroll") for (int i = 0; i < 10; ++i) { const int t_ = t0_ - 8 + i * 8 + rg; raw[i] = (u32x2){0u, 0u}; q[i] = 1.0f; \
            if (t_ >= 0 && t_ < SEQ) { const size_t row_ = (size_t)b_ * SEQ + t_; raw[i] = *(const u32x2*)(XB + row_ * DM + cb_ * 256 + c4); q[i] = ssq[row_]; } } \
        g0 = *(const f32x4*)(gvec + cb_ * 256 + c4); g1 = *(const f32x4*)(ADA + (size_t)(5 + b_) * NADA + DM + cb_ * 256 + c4); } while (0)
    int item = bid; if (item >= 1024) return;
    POOL_LOAD(item);
    for (;;) {
        const int tt = item >> 3, cb = item & 7, b = tt >> 5, t0 = (tt & 31) * 64, gi = cb >> 1, hw = 1 << gi;
#pragma unroll
        for (int i = 0; i < 10; ++i) { const int lr = i * 8 + rg; const float rs = 1.0f / sqrtf(q[i] * (1.0f / DM) + EPS);
            *(LAS f32x4*)(Y + lr * 256 + c4) = (f32x4){bflo(raw[i].x), bfhi(raw[i].x), bflo(raw[i].y), bfhi(raw[i].y)} * rs; }
        const f32x4 gm = g0 * (g1 + 1.0f);
        LDS_BAR();
        const int nitem = item + G; const bool more = nitem < 1024;
        if (more) POOL_LOAD(nitem);
        const int r0 = rg * 8;
        f32x4 S = {0.f, 0.f, 0.f, 0.f};
        for (int u = -hw; u < hw; ++u) S += *(const LAS f32x4*)(Y + (r0 + 8 + u) * 256 + c4);
#pragma unroll
        for (int r = 0; r < 8; ++r) { const int t = t0 + r0 + r; int lo = t - hw, hi = t + hw; lo = lo < 0 ? 0 : lo; hi = hi > SEQ ? SEQ : hi;
            const f32x4 own = *(const LAS f32x4*)(Y + (r0 + r + 8) * 256 + c4);
            const f32x4 p = (S * (1.0f / (float)(hi - lo)) - own) * gm;
            u32x2 o; o.x = pk2(p.x, p.y); o.y = pk2(p.z, p.w); *(u32x2*)(MIX + ((size_t)b * SEQ + t) * DM + cb * 256 + c4) = o;
            S += *(const LAS f32x4*)(Y + (r0 + r + 8 + hw) * 256 + c4) - *(const LAS f32x4*)(Y + (r0 + r + 8 - hw) * 256 + c4); }
        LDS_BAR();
        if (!more) break;
        item = nitem;
    }
#undef POOL_LOAD
}
__device__ __forceinline__ void phase_GEMM_G1(PH_PARAMS) {
    pg8::Gemm g{H, WIN, DM, DM, DM, 0, 0}; pg8::TileOrder S; S.init(MALL / 256, INP / 256, 1, G, bid); pg8::EpiSplit1 E{ws};
    pg8::gemm_phase<pg8::EpiSplit1, true>(lds, g, S, E, tid);
    if (G == 256 && bid >= 208) convert_tiles(PH_CALL(ph), 0, CT_N0 - CT_W_DN, CT_N0, bid - 208, 48);
}
__device__ __forceinline__ void phase_GEMM_LR(PH_PARAMS) {
    pg8::Gemm g; pg8::TileOrder S; pg8::EpiLowRank E;
    if (ph == PH_G2) { g = pg8::Gemm{CQ, WUQ, QRANK, QRANK, QRANK, 0, 0}; S.init(MLAT / 256, 1536 / 256, 1, G, bid); E = pg8::EpiLowRank{ws, 0}; }
    else { g = pg8::Gemm{CKV, WUKV, KVRANK, KVRANK, KVRANK, 0, 0}; S.init(MALL / 256, 2048 / 256, 1, G, (bid + 64) % G); E = pg8::EpiLowRank{ws, 1}; }
    pg8::gemm_phase<pg8::EpiLowRank, true>(lds, g, S, E, tid);
}
__device__ __forceinline__ void phase_GEMM_UP(PH_PARAMS) {
    const int l = (ph == PH_G8);
    pg8::Gemm g{H, WUP + (size_t)l * FF2 * DM, DM, DM, DM, 0, 0}; pg8::TileOrder S; S.init(MLAT / 256, FF2 / 256, 1, G, bid);
    pg8::EpiConv E{conv_w + (size_t)l * 3 * FF2, conv_b + (size_t)l * FF2, ACT, HALO, (LAS float*)(lds + 131072)};
    pg8::gemm_phase<pg8::EpiConv, true>(lds, g, S, E, tid);
    if (ph == PH_G5) { if (G == 256 && bid >= 128) { convert_tiles(PH_CALL(ph), 1, 0, CT_W_UP, bid - 128, 128); convert_tiles(PH_CALL(ph), 1, CT_W_UP + CT_W_DN, CT_N1, bid - 128, 128);
                                                    }
                       else if (G != 256) convert_tiles(PH_CALL(ph), 1, 0, CT_N1, bid, G); }
    if (ph == PH_G8 && G == 256 && bid >= 128) convert_tiles(PH_CALL(ph), 1, CT_W_UP, CT_W_UP + CT_W_DN, bid - 128, 128);
}
__device__ __forceinline__ void conv_fixup(PH_PARAMS, const int pm) {
    const int l = (ph == PH_G9); const float* cw = conv_w + (size_t)l * 3 * FF2; const float* cb = conv_b + (size_t)l * FF2;
    const int pmm = pm & 7;
    for (int idx = tid; idx < 2 * (FF / 4); idx += 512) {
        const int which = idx / (FF / 4), f = (idx % (FF / 4)) * 4; const int cd = 256 * (f >> 7) + (f & 127);
        const float* hup; const float* hcur; const float* hdn; bool zup = false, zdn = false;
        if (which == 0) { hup = HALO + (size_t)((pm - 1) * 4 + 3) * FF2; hcur = HALO + (size_t)(pm * 4 + 0) * FF2; hdn = HALO + (size_t)(pm * 4 + 1) * FF2; zup = (pmm == 0); if (zup) hup = hcur; }
        else { hup = HALO + (size_t)(pm * 4 + 2) * FF2; hcur = HALO + (size_t)(pm * 4 + 3) * FF2; hdn = HALO + (size_t)((pm + 1) * 4 + 0) * FF2; zdn = (pmm == 7); if (zdn) hdn = hcur; }
        f32x4 up[2];
#pragma unroll
        for (int bj = 0; bj < 2; ++bj) { const int c = cd + bj * 128; const float* p = cw + bj * FF + f;
            f32x4 vu = *(const f32x4*)(hup + c), vc = *(const f32x4*)(hcur + c), vd = *(const f32x4*)(hdn + c);
            if (zup) vu = (f32x4){0.f, 0.f, 0.f, 0.f}; if (zdn) vd = (f32x4){0.f, 0.f, 0.f, 0.f};
            up[bj] = *(const f32x4*)(cb + bj * FF + f) + *(const f32x4*)p * vu + *(const f32x4*)(p + FF2) * vc + *(const f32x4*)(p + 2 * FF2) * vd; }
        const f32x4 a = up[0], gt = up[1];
        u32x2 w; w.x = pk2(a.x * silu_f(gt.x), a.y * silu_f(gt.y)); w.y = pk2(a.z * silu_f(gt.z), a.w * silu_f(gt.w));
        *(u32x2*)(ACT + (size_t)(pm * 256 + (which ? 255 : 0)) * FF + f) = w;
    }
}
__device__ __forceinline__ void phase_GEMM_RES(PH_PARAMS) {
    pg8::Gemm g{ACT, WDN, FF, FF, FF, 0, 0}; pg8::TileOrder S; S.init(MLAT / 256, DM / 256, 1, G, bid); pg8::EpiResid E{XB, XB, ADA + 5 * DM, nullptr, 0, RSTDX};
    { pg8::Unit uu; for (int i = 0; S.next(i, uu); ++i) conv_fixup(args, ws, lds, lds_raw, tid, lane, wave, bid, G, gw, NGW, ph, uu.pm);
        asm volatile("s_waitcnt vmcnt(0)" ::: "memory"); __syncthreads(); }
    pg8::gemm_phase<pg8::EpiResid, false>(lds, g, S, E, tid);
}
__device__ __forceinline__ void phase_GEMM_POOL(PH_PARAMS) {
    using namespace pg8;
    TileOrder S; S.init(MLAT / 256, 2, 4, G, bid);
    const bf16_t* xb = XB; const float* ssq = RSTDX; const float* gvec = norm1_g + DM; const float* sc1 = ADA + 5 * NADA + DM; const bf16_t* Wp = WPOOL;
    constexpr int SA0 = 0, SB0 = 32768, YOFF = 98304, RSD = YOFF + 272 * 128, GMV = RSD + 272 * 4;
    static_assert(GMV + 512 * 4 <= 147456 - 256, "pool GEMM LDS map");
#define PGP_BAR asm volatile("s_waitcnt lgkmcnt(0)\n\ts_barrier" ::: "memory")
#define PGP_ISSUE_B(kt_) do { const int slot_ = (kt_) & 1; \
        _Pragma("unroll") for (int h_ = 0; h_ < 2; ++h_) _Pragma("unroll") for (int i_ = 0; i_ < 2; ++i_) \
            __builtin_amdgcn_global_load_lds((const unsigned*)(cB + (size_t)h_ * (128 * 512 * 2) + (size_t)(kt_) * 128 + voffB[i_]), (LAS unsigned*)(lds + SB0 + slot_ * 32768 + h_ * 16384 + ldsw + i_ * 8192), 16, 0, 0); } while (0)
#define PGP_ISSUE_Y(kt_) do { \
        _Pragma("unroll") for (int q_ = 0; q_ < 5; ++q_) { const int iq_ = wid + 8 * q_; if (iq_ < 34) { int t_ = t0 - 8 + iq_ * 8 + (lane >> 3); t_ = t_ < 0 ? 0 : (t_ > SEQ - 1 ? SEQ - 1 : t_); \
            __builtin_amdgcn_global_load_lds((const unsigned*)(xrow0 + (size_t)t_ * DM + (kt_) * 64 + (lane & 7) * 8), (LAS unsigned*)(lds + YOFF + iq_ * 1024), 16, 0, 0); } } } while (0)
    Unit cur;
    for (int ui = 0; S.next(ui, cur); ++ui) {
        int tq = threadIdx.x; asm volatile("" : "+v"(tq));
        const int wid = __builtin_amdgcn_readfirstlane(tq >> 6), lane = tq & 63, wr = wid >> 2, wc = wid & 3, fr = lane & 15, fq = lane >> 4;
        unsigned voffB[2];
#pragma unroll
        for (int i = 0; i < 2; ++i) { int R, C; stage_rc(tq * 16 + i * 8192, R, C); const int Rb = (R & ~31) + perm32(R & 31); voffB[i] = (unsigned)(Rb * 512 + C) * 2u; }
        const unsigned ldsw = (unsigned)wid * 1024u;
        const int aoff = lds_byte(wr * 64 + fr, fq * 8), boff = lds_byte(wc * 32 + fr, fq * 8);
        const int cg = tq & 15, seg = tq >> 4;
        const int b = cur.pm >> 3, t0 = (cur.pm & 7) * 256, hw = 1 << cur.g, kc0 = cur.g * 512;
        const bf16_t* xrow0 = xb + (size_t)b * SEQ * DM + kc0;
        const char* cB = (const char*)(Wp + (size_t)cur.g * 512 * 512 + (size_t)cur.pn * 256 * 512);
        PGP_ISSUE_Y(0); PGP_ISSUE_B(0);
        if (tq < 272) { const int t = t0 - 8 + tq; float rs = 0.f; if (t >= 0 && t < SEQ) rs = 1.0f / sqrtf(ssq[(size_t)b * SEQ + t] * (1.0f / DM) + EPS); *(LAS float*)(lds + RSD + tq * 4) = rs; }
        *(LAS float*)(lds + GMV + tq * 4) = gvec[kc0 + tq] * (sc1[(size_t)b * NADA + kc0 + tq] + 1.0f);
        f32x4 acc[2][2][4][2];
#pragma unroll
        for (int a = 0; a < 2; ++a)
#pragma unroll
            for (int bb = 0; bb < 2; ++bb)
#pragma unroll
                for (int m = 0; m < 4; ++m)
#pragma unroll
                    for (int n = 0; n < 2; ++n) acc[a][bb][m][n] = (f32x4){0.f, 0.f, 0.f, 0.f};
#pragma unroll 1
        for (int kt = 0; kt < 8; ++kt) {
            asm volatile("s_waitcnt vmcnt(0)" ::: "memory"); PGP_BAR;
            if (kt + 1 < 8) PGP_ISSUE_B(kt + 1);
            {   const LAS char* Yb = (const LAS char*)(lds + YOFF + cg * 8); const LAS float* rsd = (const LAS float*)(lds + RSD);
                const int r0 = seg * 8;
                const f32x4 gm = *(const LAS f32x4*)(lds + GMV + (kt * 64 + cg * 4) * 4);
                f32x4 Sv = {0.f, 0.f, 0.f, 0.f};
                for (int u = -hw; u < hw; ++u) Sv += pgp_y(Yb, rsd, r0 + 8 + u);
                LAS unsigned char* arow = lds + SA0 + (r0 >> 7) * 16384 + lds_byte(r0 & 127, cg * 4);
                const LAS char* yq = Yb + (r0 + 8) * 128; const LAS float* rq = rsd + r0 + 8;
#pragma unroll 1
                for (int r = 0; r < 8; ++r) { const int t = t0 + r0 + r; int lo = t - hw, hi = t + hw; lo = lo < 0 ? 0 : lo; hi = hi > SEQ ? SEQ : hi;
                    const f32x4 own = pgp_y(yq, rq, 0);
                    const f32x4 p = (Sv * __builtin_amdgcn_rcpf((float)(hi - lo)) - own) * gm;
                    u32x2 o; o.x = pk2(p.x, p.y); o.y = pk2(p.z, p.w);
                    *(LAS u32x2*)arow = o;
                    Sv += pgp_y(yq, rq, hw) - pgp_y(yq, rq, -hw);
                    arow += 64; yq += 128; rq += 1; }
            }
            PGP_BAR;
            if (kt + 1 < 8) PGP_ISSUE_Y(kt + 1);
            {   const int sb = SB0 + (kt & 1) * 32768; bf16x8 At[4][2], B0[2][2], B1[2][2];
#pragma unroll
                for (int n = 0; n < 2; ++n)
#pragma unroll
                    for (int k = 0; k < 2; ++k) { B0[n][k] = *(const LAS bf16x8*)(lds + sb + boff + n * 2048 + k * 1024); B1[n][k] = *(const LAS bf16x8*)(lds + sb + 16384 + boff + n * 2048 + k * 1024); }
#pragma unroll
                for (int ai = 0; ai < 2; ++ai) {
#pragma unroll
                    for (int m = 0; m < 4; ++m)
#pragma unroll
                        for (int k = 0; k < 2; ++k) At[m][k] = *(const LAS bf16x8*)(lds + SA0 + ai * 16384 + aoff + m * 2048 + k * 1024);
                    asm volatile("s_waitcnt lgkmcnt(0)" ::: "memory");
#pragma unroll
                    for (int m = 0; m < 4; ++m)
#pragma unroll
                        for (int n = 0; n < 2; ++n)
#pragma unroll
                            for (int k = 0; k < 2; ++k) { acc[ai][0][m][n] = __builtin_amdgcn_mfma_f32_16x16x32_bf16(B0[n][k], At[m][k], acc[ai][0][m][n], 0, 0, 0);
                                                          acc[ai][1][m][n] = __builtin_amdgcn_mfma_f32_16x16x32_bf16(B1[n][k], At[m][k], acc[ai][1][m][n], 0, 0, 0); }
                }
            }
        }
        asm volatile("s_waitcnt vmcnt(0)" ::: "memory"); PGP_BAR;
        {
            const EpiResidNorm E{nullptr, XB, XB2, ADA + 5 * NADA + 2 * DM, pool_scale, 512, norm2_g + DM, ADA + 5 * NADA + 3 * DM, ADA + 5 * NADA + 4 * DM, H, nullptr,
                                 (float*)(ws + WS_SLOTS), (unsigned*)(ws + WS_CTL + 16384) + 32 * 64};
            E.fused(acc, cur, wr, wc, fr, fq, lds, wid, lane); }
        asm volatile("s_waitcnt vmcnt(0)" ::: "memory"); PGP_BAR;
    }
#undef PGP_BAR
#undef PGP_ISSUE_B
#undef PGP_ISSUE_Y
}
__device__ __forceinline__ void phase_GEMM_RN(PH_PARAMS) {
    pg8::Gemm g; pg8::TileOrder S; pg8::EpiResidNorm E;
    float* slots = (float*)(ws + WS_SLOTS); unsigned* cntb = (unsigned*)(ws + WS_CTL + 16384);
    if (ph == PH_G4) { g = pg8::Gemm{MIX, WOUT, DM, DM, DM, 0, 0}; S.init(MLAT / 256, DM / 256, 1, G, bid);
        E = pg8::EpiResidNorm{x_in, nullptr, XB, ADA + 2 * DM, nullptr, 0, norm2_g, ADA + 3 * DM, ADA + 4 * DM, H, nullptr, slots, cntb}; }
    else if (ph == PH_G7) { return; }
    else { g = pg8::Gemm{ACT, WDN + (size_t)DM * FF, FF, FF, FF, 0, 0}; S.init(MLAT / 256, DM / 256, 1, G, bid);
        E = pg8::EpiResidNorm{nullptr, XB2, nullptr, ADA + 5 * NADA + 5 * DM, nullptr, 0, final_g, nullptr, nullptr, nullptr, X, slots, cntb + 64 * 64}; }
    if (ph == PH_G9) { pg8::Unit uu; for (int i = 0; S.next(i, uu); ++i) conv_fixup(args, ws, lds, lds_raw, tid, lane, wave, bid, G, gw, NGW, ph, uu.pm);
        asm volatile("s_waitcnt vmcnt(0)" ::: "memory"); __syncthreads(); }
    pg8::gemm_phase<pg8::EpiResidNorm, false>(lds, g, S, E, tid);
}
__global__ void __launch_bounds__(512, 2) mega(Args args) {
    extern __shared__ __attribute__((aligned(16))) unsigned char lds_raw[];
    LAS unsigned char* lds = (LAS unsigned char*)lds_raw;
    const int G = gridDim.x, bid = blockIdx.x;
    const int NGW = G * 8;
#define PH_LOCALS int tid_ = threadIdx.x; asm volatile("" : "+v"(tid_)); const int tid = tid_, lane = tid & 63, wave = __builtin_amdgcn_readfirstlane(tid >> 6), gw = bid * 8 + wave; (void)lane; (void)gw;
    unsigned char* ws = args.ws;
    const int lo = args.ph_lo, hi = args.ph_hi;
    volatile LAS unsigned* MISC = (volatile LAS unsigned*)(lds + MISC_OFF);
    if (threadIdx.x < 64) MISC[threadIdx.x] = 0u;
    __syncthreads();
    XcdBarrier bar; bar.bar = (unsigned*)(ws + WS_CTL); bar.x = 0; bar.st = nullptr;
    if (hi - lo > 1) bar = xcd_barrier_post((unsigned*)(ws + WS_CTL), MISC + 8);
#define IN(k) (EN(k) && lo <= (k) && (k) < hi)
#define SEAM(k) do { if ((k) + 1 < hi) xcd_barrier(bar); else __syncthreads(); } while (0)
    if (IN(PH_PREP)) { { PH_LOCALS phase_PREP(PH_CALL(PH_PREP)); } { PH_LOCALS phase_NORM(PH_CALL(PH_NORM1)); } SEAM(PH_NORM1); }
    if (IN(PH_G1)) { PH_LOCALS phase_GEMM_G1(PH_CALL(PH_G1)); SEAM(PH_G1); }
    if (IN(PH_G2)) { { PH_LOCALS phase_GEMM_LR(PH_CALL(PH_G2)); } { PH_LOCALS phase_GEMM_LR(PH_CALL(PH_G3)); } __syncthreads(); { PH_LOCALS phase_R1(PH_CALL(PH_R1)); } SEAM(PH_G2); }
    if (IN(PH_R2)) { { PH_LOCALS phase_R2(PH_CALL(PH_R2)); }
        asm volatile("s_waitcnt vmcnt(0)" ::: "memory"); __syncthreads();
        if (threadIdx.x == 0) { __builtin_amdgcn_fence(__ATOMIC_RELEASE, "agent"); asm volatile("s_waitcnt vmcnt(0)" ::: "memory"); __hip_atomic_fetch_add((unsigned*)(ws + WS_CTL + 49152 + 256), 1u, __ATOMIC_RELAXED, __HIP_MEMORY_SCOPE_AGENT); }
        { PH_LOCALS phase_ATTN(PH_CALL(PH_ATTN)); }
        if (threadIdx.x == 0) { unsigned spins = 0; while (__hip_atomic_load((unsigned*)(ws + WS_CTL + 49152 + 256), __ATOMIC_RELAXED, __HIP_MEMORY_SCOPE_AGENT) < (unsigned)G) { __builtin_amdgcn_s_sleep(2); if (++spins > (1u << 20)) break; }
            __builtin_amdgcn_fence(__ATOMIC_ACQUIRE, "agent"); asm volatile("s_waitcnt vmcnt(0)" ::: "memory"); }
        __syncthreads();
        { PH_LOCALS phase_R3(PH_CALL(PH_R3)); }
        SEAM(PH_R3); }
    if (IN(PH_G4)) { PH_LOCALS phase_GEMM_RN(PH_CALL(PH_G4)); SEAM(PH_G4); }
    if (IN(PH_G5)) { PH_LOCALS phase_GEMM_UP(PH_CALL(PH_G5)); if (REP(PH_G5)) { __syncthreads(); phase_GEMM_UP(PH_CALL(PH_G5)); } SEAM(PH_G5); }
    if (IN(PH_G6)) { PH_LOCALS phase_GEMM_RES(PH_CALL(PH_G6)); SEAM(PH_G6); }
    if (IN(PH_G7)) { PH_LOCALS phase_GEMM_POOL(PH_CALL(PH_G7)); SEAM(PH_G7); }
    if (IN(PH_G8)) { PH_LOCALS phase_GEMM_UP(PH_CALL(PH_G8)); if (REP(PH_G8)) { __syncthreads(); phase_GEMM_UP(PH_CALL(PH_G8)); } SEAM(PH_G8); }
    if (IN(PH_G9)) { PH_LOCALS phase_GEMM_RN(PH_CALL(PH_G9)); }
}

extern "C" void kernel_launch(void* const* d_in, const int* in_sizes, int n_in, void* d_out, int out_size, void* d_ws, size_t ws_size, hipStream_t stream) {
    static int ok = 0;
    if (ok == 0) {
        if (n_in != 23 || out_size != MLAT * DM || ws_size < WS_END) { fprintf(stderr, "kernel_launch: unexpected shapes: n_in %d out %d ws %zu (need %zu)\n", n_in, out_size, ws_size, (size_t)WS_END); ok = -1; return; }
        if (hipFuncSetAttribute((const void*)mega, hipFuncAttributeMaxDynamicSharedMemorySize, LDS_BYTES) != hipSuccess) { fprintf(stderr, "kernel_launch: hipFuncSetAttribute failed\n"); ok = -1; return; }
        int dev = 0, cus = 0, per_cu = 0;
        if (hipGetDevice(&dev) != hipSuccess || hipDeviceGetAttribute(&cus, hipDeviceAttributeMultiprocessorCount, dev) != hipSuccess ||
            hipOccupancyMaxActiveBlocksPerMultiprocessor(&per_cu, (const void*)mega, 512, LDS_BYTES) != hipSuccess || per_cu < 1 || (long)cus * per_cu < 256) {
            fprintf(stderr, "kernel_launch: the 256-workgroup persistent grid is not resident on this device (CUs %d, workgroups per CU %d); nothing launched\n", cus, per_cu); ok = -1; return; }
        ok = 1;
    }
    if (ok < 0) return;
    Args a{};
    for (int i = 0; i < 23; ++i) a.in[i] = (const float*)d_in[i];
    a.out = (float*)d_out; a.ws = (unsigned char*)d_ws;
    if (hipMemsetAsync((char*)d_ws + WS_CTL, 0, CTL_ZERO_BYTES, stream) != hipSuccess) { fprintf(stderr, "kernel_launch: hipMemsetAsync failed\n"); return; }
    a.ph_lo = 0; a.ph_hi = PH_COUNT;
    hipLaunchKernelGGL(mega, dim3(256), dim3(512), LDS_BYTES, stream, a);
    const hipError_t le = hipPeekAtLastError();
    if (le != hipSuccess) fprintf(stderr, "kernel_launch: launch failed: %s\n", hipGetErrorName(le));
}
```

```cpp
#include <hip/hip_runtime.h>
#include <cstdio>
#include <cstdint>

#define GAS __attribute__((address_space(1)))
#define LAS __attribute__((address_space(3)))
typedef unsigned short bf16_t;
typedef short bf16x8 __attribute__((ext_vector_type(8)));
typedef short s16x4 __attribute__((ext_vector_type(4)));
typedef float f32x2 __attribute__((ext_vector_type(2)));
typedef float f32x4 __attribute__((ext_vector_type(4)));
typedef float f32x16 __attribute__((ext_vector_type(16)));
typedef unsigned u32x2 __attribute__((ext_vector_type(2)));
typedef unsigned u32x4 __attribute__((ext_vector_type(4)));

constexpr int DM = 2048, NB = 4, SEQ = 2048, CTX = 256, NH = 8, HD = 128;
constexpr int MLAT = NB * SEQ;
constexpr int MCTX = NB * CTX;
constexpr int MALL = MLAT + MCTX;
constexpr int NKEY = CTX + SEQ;
constexpr int FF = 5632, FF2 = 11264;
constexpr int INC = 4928, INP = 5120;
constexpr int QRANK = 512, KVRANK = 256, DR = 64;
constexpr int NADA = 6 * DM;
constexpr float EPS = 1e-6f;
constexpr int NCHUNK = 18;

constexpr size_t MiB = 1u << 20;
constexpr size_t WS_CTL = 0;
constexpr size_t WS_ADA = 1 * MiB;
constexpr size_t WS_RT128 = 2 * MiB;
constexpr size_t WS_RT64 = 3 * MiB;
constexpr size_t WS_RSTDQ = 3 * MiB + 512 * 1024;
constexpr size_t WS_RSTDKV = WS_RSTDQ + 64 * 1024;
constexpr size_t WS_RSTDX = WS_RSTDKV + 64 * 1024;
constexpr size_t WS_WIN = 4 * MiB;
constexpr size_t WS_WUQ = 24 * MiB;
constexpr size_t WS_WUKV = 26 * MiB;
constexpr size_t WS_WPOOL = 27 * MiB;
constexpr size_t WS_WOUT = 29 * MiB;
constexpr size_t WS_WUP = 37 * MiB;
constexpr size_t WS_WDN = 125 * MiB;
constexpr size_t WS_H = 169 * MiB;
constexpr size_t WS_RQ = 205 * MiB;
constexpr size_t WS_RK = 221 * MiB;
constexpr size_t WS_RV = 239 * MiB;
constexpr size_t WS_RG = 257 * MiB;
constexpr size_t WS_CQ = 273 * MiB;
constexpr size_t WS_CKV = 281 * MiB;
constexpr size_t WS_QN = 286 * MiB;
constexpr size_t WS_QR = 302 * MiB;
constexpr size_t WS_KN = 310 * MiB;
constexpr size_t WS_KR = 328 * MiB;
constexpr size_t WS_VC = 330 * MiB;
constexpr size_t WS_KVB = 348 * MiB;
constexpr size_t WS_ST = 420 * MiB;
constexpr size_t WS_MIX = 452 * MiB;
constexpr size_t WS_ACT = 484 * MiB;
constexpr size_t WS_Z = 572 * MiB;
constexpr size_t WS_Z3 = WS_Z + 48 * MiB;
constexpr size_t WS_SLOTS = 578 * MiB;
constexpr size_t WS_XB = 592 * MiB;
constexpr size_t WS_END = 752 * MiB;

constexpr int LDS_BYTES = 147456;

__device__ __forceinline__ unsigned f2bf(float f) { unsigned u = __builtin_bit_cast(unsigned, f); return (u + 0x7fffu + ((u >> 16) & 1u)) >> 16; }
__device__ __forceinline__ unsigned pk2(float lo, float hi) { return f2bf(lo) | (f2bf(hi) << 16); }
__device__ __forceinline__ float bf2f(unsigned short h) { return __builtin_bit_cast(float, (unsigned)h << 16); }
__device__ __forceinline__ float bflo(unsigned w) { return __builtin_bit_cast(float, w << 16); }
__device__ __forceinline__ float bfhi(unsigned w) { return __builtin_bit_cast(float, w & 0xffff0000u); }
__device__ __forceinline__ unsigned cvtpk(float lo, float hi) { unsigned r; asm volatile("v_cvt_pk_bf16_f32 %0, %1, %2" : "=v"(r) : "v"(lo), "v"(hi)); return r; }
__device__ __forceinline__ f32x4 ldbf4(const bf16_t* p) { const u32x2 w = *(const u32x2*)p; return (f32x4){bflo(w.x), bfhi(w.x), bflo(w.y), bfhi(w.y)}; }
__device__ __forceinline__ void stbf4(bf16_t* p, f32x4 v) { u32x2 w; w.x = cvtpk(v.x, v.y); w.y = cvtpk(v.z, v.w); *(u32x2*)p = w; }
__device__ __forceinline__ float wave_sum(float v) {
#pragma unroll
    for (int o = 1; o < 64; o <<= 1) v += __shfl_xor(v, o);
    return v;
}
__device__ __forceinline__ float silu_f(float v) { return v * __builtin_amdgcn_rcpf(1.f + __builtin_amdgcn_exp2f(v * -1.4426950408889634f)); }
__device__ __forceinline__ void sincos_acc(float x, float& s, float& c) {
    const double xd = (double)x; const double kq = __builtin_rint(xd * 0.63661977236758134308);
    const double r = (xd - kq * 1.57079632679489655800) - kq * 6.12323399573676603587e-17; const int q = ((int)kq) & 3;
    const double r2 = r * r;
    const double sp = r * (1.0 + r2 * (-1.0 / 6 + r2 * (1.0 / 120 + r2 * (-1.0 / 5040 + r2 * (1.0 / 362880 + r2 * (-1.0 / 39916800 + r2 * (1.0 / 6227020800.0)))))));
    const double cp = 1.0 + r2 * (-0.5 + r2 * (1.0 / 24 + r2 * (-1.0 / 720 + r2 * (1.0 / 40320 + r2 * (-1.0 / 3628800 + r2 * (1.0 / 479001600.0 + r2 * (-1.0 / 87178291200.0)))))));
    double sd, cd;
    if (q == 0) { sd = sp; cd = cp; } else if (q == 1) { sd = cp; cd = -sp; } else if (q == 2) { sd = -sp; cd = -cp; } else { sd = -cp; cd = sp; }
    s = (float)sd; c = (float)cd;
}

namespace pg8 {
constexpr int BM = 256, BK = 64, HALF = 128, HTB = HALF * BK * 2, STAGE_BYTES = 8 * HTB, NXCD = 8, WGM = 8;
__host__ __device__ __forceinline__ int lds_byte(int r, int c) { const int st = (r >> 4) * 2 + (c >> 5), rr = r & 15, cc = c & 31, ob = rr * 64 + cc * 2; return st * 1024 + (ob ^ (((ob >> 9) & 1) << 5)); }
__host__ __device__ __forceinline__ void stage_rc(int b, int& R, int& C) { const int st = b / 1024, sb = b % 1024, swz = sb ^ (((sb >> 9) & 1) << 5); R = (st >> 1) * 16 + swz / 64; C = (st & 1) * 32 + (swz % 64) / 2; }
__host__ __device__ __forceinline__ int perm32(int rho) { const int n = rho >> 4, i = rho & 15; return 8 * (i >> 2) + 4 * n + (i & 3); }

struct Unit { int pm, pn, g; };
struct Gemm { const bf16_t* A; const bf16_t* Bt; int K, lda, ldb; size_t a_g, b_g; };

struct TileOrder {
    int nM, nN, nwg, G, c, wgm;
    __device__ void init(int nM_, int nN_, int nG_, int G_, int c_) { nM = nM_; nN = nN_; nwg = nM_ * nN_ * nG_; G = G_; c = c_; wgm = WGM; }
    __device__ bool next(int i, Unit& u) const {
        const long L = (long)i * G + c; if (L >= nwg) return false;
        int wgid = (int)L; { const int q = nwg / NXCD, r = nwg % NXCD, xcd = wgid % NXCD, off = wgid / NXCD; wgid = (xcd < r ? xcd * (q + 1) : r * (q + 1) + (xcd - r) * q) + off; }
        const int per_g = nM * nN; u.g = wgid / per_g; const int w = wgid % per_g;
        const int nig = wgm * nN, gid = w / nig, fm = gid * wgm, gsz = (nM - fm) < wgm ? (nM - fm) : wgm;
        u.pm = fm + ((w % nig) % gsz); u.pn = (w % nig) / gsz; return true;
    }
};

struct EpiF32 {
    static constexpr bool PERM = false, AFTER_DRAIN = false, APERM = false;
    float* C; int ldc;
    __device__ __forceinline__ void operator()(const f32x4 (&acc)[2][2][4][2], const Unit& u, int wr, int wc, int fr, int fq) const {
        const int row0 = u.pm * BM + wr * 64 + fr, col0 = u.pn * BM + wc * 32 + 4 * fq;
#pragma unroll
        for (int ai = 0; ai < 2; ++ai)
#pragma unroll
            for (int m = 0; m < 4; ++m) { float* rowp = C + (size_t)(row0 + ai * HALF + m * 16) * ldc + col0;
#pragma unroll
                for (int bj = 0; bj < 2; ++bj)
#pragma unroll
                    for (int n = 0; n < 2; ++n) *(f32x4*)(rowp + bj * HALF + n * 16) = acc[ai][bj][m][n]; }
    }
};
struct EpiBf16 {
    static constexpr bool PERM = true, AFTER_DRAIN = false, APERM = false;
    bf16_t* O; int ldc;
    __device__ __forceinline__ void operator()(const f32x4 (&acc)[2][2][4][2], const Unit& u, int wr, int wc, int fr, int fq) const {
        const int row0 = u.pm * BM + wr * 64 + fr, col0 = u.pn * BM + wc * 32 + 8 * fq;
#pragma unroll
        for (int ai = 0; ai < 2; ++ai)
#pragma unroll
            for (int m = 0; m < 4; ++m) { bf16_t* rowp = O + (size_t)(row0 + ai * HALF + m * 16) * ldc + col0;
#pragma unroll
                for (int bj = 0; bj < 2; ++bj) { const f32x4 v0 = acc[ai][bj][m][0], v1 = acc[ai][bj][m][1];
                    u32x4 w; w.x = cvtpk(v0[0], v0[1]); w.y = cvtpk(v0[2], v0[3]); w.z = cvtpk(v1[0], v1[1]); w.w = cvtpk(v1[2], v1[3]);
                    *(u32x4*)(rowp + bj * HALF) = w; } }
    }
};
struct EpiResid {
    static constexpr bool PERM = true, AFTER_DRAIN = false, APERM = false;
    const bf16_t* base; bf16_t* out; const float* gate; const float* cscale; int gcols; float* ssq;
    __device__ __forceinline__ void operator()(const f32x4 (&acc)[2][2][4][2], const Unit& u, int wr, int wc, int fr, int fq) const {
        const int row0 = u.pm * BM + wr * 64 + fr, col0 = u.g * gcols + u.pn * BM + wc * 32 + 8 * fq;
        const float* gv = gate + (size_t)(u.pm >> 3) * NADA + col0;
        f32x4 gg[2][2];
#pragma unroll
        for (int bj = 0; bj < 2; ++bj)
#pragma unroll
            for (int n = 0; n < 2; ++n) { gg[bj][n] = *(const f32x4*)(gv + bj * HALF + n * 4); if (cscale) gg[bj][n] *= *(const f32x4*)(cscale + col0 + bj * HALF + n * 4); }
        u32x4 bsr[2][4][2];
#pragma unroll
        for (int ai = 0; ai < 2; ++ai)
#pragma unroll
            for (int m = 0; m < 4; ++m)
#pragma unroll
                for (int bj = 0; bj < 2; ++bj) bsr[ai][m][bj] = *(const u32x4*)(base + (size_t)(row0 + ai * HALF + m * 16) * DM + col0 + bj * HALF);
#pragma unroll
        for (int ai = 0; ai < 2; ++ai)
#pragma unroll
            for (int m = 0; m < 4; ++m) { const size_t off = (size_t)(row0 + ai * HALF + m * 16) * DM + col0; float sq = 0.f;
#pragma unroll
                for (int bj = 0; bj < 2; ++bj) { const u32x4 w = bsr[ai][m][bj];
                    const f32x4 o0 = (f32x4){bflo(w.x), bfhi(w.x), bflo(w.y), bfhi(w.y)} + gg[bj][0] * acc[ai][bj][m][0];
                    const f32x4 o1 = (f32x4){bflo(w.z), bfhi(w.z), bflo(w.w), bfhi(w.w)} + gg[bj][1] * acc[ai][bj][m][1];
                    sq += ((o0.x * o0.x + o0.y * o0.y) + (o0.z * o0.z + o0.w * o0.w)) + ((o1.x * o1.x + o1.y * o1.y) + (o1.z * o1.z + o1.w * o1.w));
                    u32x4 ov; ov.x = cvtpk(o0.x, o0.y); ov.y = cvtpk(o0.z, o0.w); ov.z = cvtpk(o1.x, o1.y); ov.w = cvtpk(o1.z, o1.w);
                    *(u32x4*)(out + off + bj * HALF) = ov; }
                if (ssq) { sq += __shfl_xor(sq, 16); sq += __shfl_xor(sq, 32); if (fq == 0) atomicAdd(ssq + row0 + ai * HALF + m * 16, sq); } }
    }
};

struct EpiSplit1 {
    static constexpr bool PERM = true, AFTER_DRAIN = false, APERM = false;
    unsigned char* ws;
    __device__ __forceinline__ void operator()(const f32x4 (&acc)[2][2][4][2], const Unit& u, int wr, int wc, int fr, int fq) const {
        const int pn = u.pn, pm = u.pm; const bool lat = pm < 32;
        const int b = lat ? (pm >> 3) : (pm - 32); const int t0 = lat ? ((pm & 7) * 256) : 0;
        const int rloc0 = wr * 64 + fr, j8 = wc * 32 + fq * 8;
        if (pn < 8) {
            const bool isk = pn >= 4; if (!isk && !lat) return;
            const float ksc = isk ? 0.08838834764831845f : 1.0f;
            f32x4 cs[2][4][2];
#pragma unroll
            for (int ai = 0; ai < 2; ++ai)
#pragma unroll
                for (int m = 0; m < 4; ++m) { const int tt = t0 + rloc0 + ai * HALF + m * 16;
                    cs[ai][m][0] = (f32x4){1.f, 0.f, 1.f, 0.f}; cs[ai][m][1] = (f32x4){1.f, 0.f, 1.f, 0.f};
                    if (lat) { const f32x4* rt = (const f32x4*)(ws + WS_RT128) + ((tt * 64 + (j8 >> 1)) >> 1); cs[ai][m][0] = rt[0]; cs[ai][m][1] = rt[1]; } }
#pragma unroll
            for (int ai = 0; ai < 2; ++ai)
#pragma unroll
                for (int m = 0; m < 4; ++m) { const int tt = t0 + rloc0 + ai * HALF + m * 16;
                    const f32x4 c0 = cs[ai][m][0], c1 = cs[ai][m][1];
#pragma unroll
                    for (int bj = 0; bj < 2; ++bj) { const int h = 2 * (pn & 3) + bj; const f32x4 v0 = acc[ai][bj][m][0], v1 = acc[ai][bj][m][1];
                        u32x4 w;
                        w.x = cvtpk((v0.x * c0.x - v0.y * c0.y) * ksc, (v0.x * c0.y + v0.y * c0.x) * ksc); w.y = cvtpk((v0.z * c0.z - v0.w * c0.w) * ksc, (v0.z * c0.w + v0.w * c0.z) * ksc);
                        w.z = cvtpk((v1.x * c1.x - v1.y * c1.y) * ksc, (v1.x * c1.y + v1.y * c1.x) * ksc); w.w = cvtpk((v1.z * c1.z - v1.w * c1.w) * ksc, (v1.z * c1.w + v1.w * c1.z) * ksc);
                        bf16_t* dst = isk ? (bf16_t*)(ws + WS_RK) + ((size_t)(b * NH + h) * NKEY + (lat ? CTX + tt : tt)) * HD + j8 : (bf16_t*)(ws + WS_RQ) + ((size_t)(b * NH + h) * SEQ + tt) * HD + j8;
                        *(u32x4*)dst = w; } }
        } else if (pn < 12) {
#pragma unroll
            for (int ai = 0; ai < 2; ++ai)
#pragma unroll
                for (int m = 0; m < 4; ++m) { const int tt = t0 + rloc0 + ai * HALF + m * 16;
#pragma unroll
                    for (int bj = 0; bj < 2; ++bj) { const int h = 2 * (pn - 8) + bj; const f32x4 v0 = acc[ai][bj][m][0], v1 = acc[ai][bj][m][1];
                        u32x4 w; w.x = cvtpk(v0.x, v0.y); w.y = cvtpk(v0.z, v0.w); w.z = cvtpk(v1.x, v1.y); w.w = cvtpk(v1.z, v1.w);
                        *(u32x4*)((bf16_t*)(ws + WS_RV) + ((size_t)(b * NH + h) * NKEY + (lat ? CTX + tt : tt)) * HD + j8) = w; } }
        } else if (pn < 18) {
            if (!lat) return;
            const bool isg = pn < 16; float* ssq = (float*)(ws + WS_RSTDQ);
#pragma unroll
            for (int ai = 0; ai < 2; ++ai)
#pragma unroll
                for (int m = 0; m < 4; ++m) { const int row = pm * 256 + rloc0 + ai * HALF + m * 16; float s = 0.f;
#pragma unroll
                    for (int bj = 0; bj < 2; ++bj) { const f32x4 v0 = acc[ai][bj][m][0], v1 = acc[ai][bj][m][1];
                        u32x4 w; w.x = cvtpk(v0.x, v0.y); w.y = cvtpk(v0.z, v0.w); w.z = cvtpk(v1.x, v1.y); w.w = cvtpk(v1.z, v1.w);
                        s += (v0.x * v0.x + v0.y * v0.y) + (v0.z * v0.z + v0.w * v0.w) + (v1.x * v1.x + v1.y * v1.y) + (v1.z * v1.z + v1.w * v1.w);
                        bf16_t* dst = isg ? (bf16_t*)(ws + WS_RG) + (size_t)row * 1024 + (pn - 12) * 256 + bj * HALF + j8 : (bf16_t*)(ws + WS_CQ) + (size_t)row * QRANK + (pn - 16) * 256 + bj * HALF + j8;
                        *(u32x4*)dst = w; }
                    if (!isg) { s += __shfl_xor(s, 16); s += __shfl_xor(s, 32); if (fq == 0) atomicAdd(ssq + row, s); } }
        } else if (pn == 18) {
            float* ssq = (float*)(ws + WS_RSTDKV);
#pragma unroll
            for (int ai = 0; ai < 2; ++ai)
#pragma unroll
                for (int m = 0; m < 4; ++m) { const int row = pm * 256 + rloc0 + ai * HALF + m * 16; float s = 0.f;
#pragma unroll
                    for (int bj = 0; bj < 2; ++bj) { const f32x4 v0 = acc[ai][bj][m][0], v1 = acc[ai][bj][m][1];
                        u32x4 w; w.x = cvtpk(v0.x, v0.y); w.y = cvtpk(v0.z, v0.w); w.z = cvtpk(v1.x, v1.y); w.w = cvtpk(v1.z, v1.w);
                        s += (v0.x * v0.x + v0.y * v0.y) + (v0.z * v0.z + v0.w * v0.w) + (v1.x * v1.x + v1.y * v1.y) + (v1.z * v1.z + v1.w * v1.w);
                        *(u32x4*)((bf16_t*)(ws + WS_CKV) + (size_t)row * KVRANK + bj * HALF + j8) = w; }
                    s += __shfl_xor(s, 16); s += __shfl_xor(s, 32); if (fq == 0) atomicAdd(ssq + row, s); }
        } else {
            if (wc >= 2) return;
#pragma unroll
            for (int ai = 0; ai < 2; ++ai)
#pragma unroll
                for (int m = 0; m < 4; ++m) { const int tt = t0 + rloc0 + ai * HALF + m * 16;
                    f32x4 c0 = {1.f, 0.f, 1.f, 0.f}, c1 = {1.f, 0.f, 1.f, 0.f};
                    if (lat) { const f32x4* rt = (const f32x4*)(ws + WS_RT64) + ((tt * 32 + (j8 >> 1)) >> 1); c0 = rt[0]; c1 = rt[1]; }
                    const f32x4 v0 = acc[ai][0][m][0], v1 = acc[ai][0][m][1];
                    u32x4 w;
                    w.x = cvtpk(v0.x * c0.x - v0.y * c0.y, v0.x * c0.y + v0.y * c0.x); w.y = cvtpk(v0.z * c0.z - v0.w * c0.w, v0.z * c0.w + v0.w * c0.z);
                    w.z = cvtpk(v1.x * c1.x - v1.y * c1.y, v1.x * c1.y + v1.y * c1.x); w.w = cvtpk(v1.z * c1.z - v1.w * c1.w, v1.z * c1.w + v1.w * c1.z);
                    *(u32x4*)((bf16_t*)(ws + WS_KR) + ((size_t)b * NKEY + (lat ? CTX + tt : tt)) * DR + j8) = w; }
        }
    }
};
struct EpiLowRank {
    static constexpr bool PERM = true, AFTER_DRAIN = false, APERM = false;
    unsigned char* ws; int mode;
    __device__ __forceinline__ void operator()(const f32x4 (&acc)[2][2][4][2], const Unit& u, int wr, int wc, int fr, int fq) const {
        const int pn = u.pn, pm = u.pm; const bool lat = pm < 32;
        const int b = lat ? (pm >> 3) : (pm - 32); const int t0 = lat ? ((pm & 7) * 256) : 0;
        const int rloc0 = wr * 64 + fr, j8 = wc * 32 + fq * 8;
        const float* ssq = (const float*)(ws + (mode == 0 ? WS_RSTDQ : WS_RSTDKV)); const float invn = mode == 0 ? 1.0f / QRANK : 1.0f / KVRANK;
#pragma unroll
        for (int ai = 0; ai < 2; ++ai)
#pragma unroll
            for (int m = 0; m < 4; ++m) { const int rl = rloc0 + ai * HALF + m * 16, tt = t0 + rl; const float rs = 1.0f / sqrtf(ssq[pm * 256 + rl] * invn + EPS);
                if (mode == 0 && pn >= 4) {
#pragma unroll
                    for (int bj = 0; bj < 2; ++bj) { const int o = 256 * (pn - 4) + HALF * bj + j8, h = o >> 6, jj = o & 63;
                        const f32x4* rt = (const f32x4*)(ws + WS_RT64) + ((tt * 32 + (jj >> 1)) >> 1); const f32x4 c0 = rt[0], c1 = rt[1];
                        const f32x4 v0 = acc[ai][bj][m][0] * rs, v1 = acc[ai][bj][m][1] * rs;
                        u32x4 w;
                        w.x = cvtpk(v0.x * c0.x - v0.y * c0.y, v0.x * c0.y + v0.y * c0.x); w.y = cvtpk(v0.z * c0.z - v0.w * c0.w, v0.z * c0.w + v0.w * c0.z);
                        w.z = cvtpk(v1.x * c1.x - v1.y * c1.y, v1.x * c1.y + v1.y * c1.x); w.w = cvtpk(v1.z * c1.z - v1.w * c1.w, v1.z * c1.w + v1.w * c1.z);
                        *(u32x4*)((bf16_t*)(ws + WS_QR) + ((size_t)(b * NH + h) * SEQ + tt) * DR + jj) = w; }
                } else {
#pragma unroll
                    for (int bj = 0; bj < 2; ++bj) { const int h = 2 * (pn & 3) + bj; const f32x4 v0 = acc[ai][bj][m][0] * rs, v1 = acc[ai][bj][m][1] * rs;
                        u32x4 w; w.x = cvtpk(v0.x, v0.y); w.y = cvtpk(v0.z, v0.w); w.z = cvtpk(v1.x, v1.y); w.w = cvtpk(v1.z, v1.w);
                        bf16_t* dst = mode == 0 ? (bf16_t*)(ws + WS_QN) + ((size_t)(b * NH + h) * SEQ + tt) * HD + j8
                                                : (bf16_t*)(ws + (pn < 4 ? WS_KN : WS_VC)) + ((size_t)(b * NH + h) * NKEY + (lat ? CTX + tt : tt)) * HD + j8;
                        *(u32x4*)dst = w; } }
            }
    }
};

__device__ __forceinline__ float dpp_shr1(float x) { return __builtin_bit_cast(float, __builtin_amdgcn_update_dpp(0, __builtin_bit_cast(int, x), 0x111, 0xf, 0xf, true)); }
__device__ __forceinline__ float dpp_shl1(float x) { return __builtin_bit_cast(float, __builtin_amdgcn_update_dpp(0, __builtin_bit_cast(int, x), 0x101, 0xf, 0xf, true)); }
__device__ __forceinline__ float dpp_ror1(float x) { return __builtin_bit_cast(float, __builtin_amdgcn_update_dpp(0, __builtin_bit_cast(int, x), 0x121, 0xf, 0xf, false)); }
__device__ __forceinline__ float dpp_ror15(float x) { return __builtin_bit_cast(float, __builtin_amdgcn_update_dpp(0, __builtin_bit_cast(int, x), 0x12f, 0xf, 0xf, false)); }
__device__ __forceinline__ float dpp_shr1_old(float o, float x) { const int oi = __builtin_bit_cast(int, o), xi = __builtin_bit_cast(int, x); return __builtin_bit_cast(float, __builtin_amdgcn_update_dpp(oi, xi, 0x111, 0xf, 0xf, false)); }
__device__ __forceinline__ float dpp_shl1_old(float o, float x) { const int oi = __builtin_bit_cast(int, o), xi = __builtin_bit_cast(int, x); return __builtin_bit_cast(float, __builtin_amdgcn_update_dpp(oi, xi, 0x101, 0xf, 0xf, false)); }
struct EpiConv {
    static constexpr bool PERM = true, AFTER_DRAIN = false, APERM = true;
    const float* cw; const float* cb; bf16_t* act; float* halo; LAS float* ex;
    __device__ __forceinline__ void operator()(const f32x4 (&acc)[2][2][4][2], const Unit& u, int wr, int wc, int fr, int fq) const {
        const int wid = wr * 4 + wc;
        LAS float* mine = ex + wid * 256;
        if (fr == 0) {
#pragma unroll
            for (int ai = 0; ai < 2; ++ai)
#pragma unroll
                for (int bj = 0; bj < 2; ++bj)
#pragma unroll
                    for (int n = 0; n < 2; ++n) *(LAS f32x4*)(mine + (ai * 2 + 0) * 64 + (bj * 2 + n) * 16 + fq * 4) = acc[ai][bj][0][n]; }
        if (fr == 15) {
#pragma unroll
            for (int ai = 0; ai < 2; ++ai)
#pragma unroll
                for (int bj = 0; bj < 2; ++bj)
#pragma unroll
                    for (int n = 0; n < 2; ++n) *(LAS f32x4*)(mine + (ai * 2 + 1) * 64 + (bj * 2 + n) * 16 + fq * 4) = acc[ai][bj][3][n]; }
        if (wr == 0 && fr == 0) { float* hp = halo + (size_t)(u.pm * 4) * FF2 + u.pn * 256 + wc * 32 + fq * 8;
#pragma unroll
            for (int bj = 0; bj < 2; ++bj)
#pragma unroll
                for (int n = 0; n < 2; ++n) { *(f32x4*)(hp + bj * HALF + n * 4) = acc[0][bj][0][n]; *(f32x4*)(hp + FF2 + bj * HALF + n * 4) = acc[0][bj][1][n]; } }
        if (wr == 1 && fr == 15) { float* hp = halo + (size_t)(u.pm * 4 + 2) * FF2 + u.pn * 256 + wc * 32 + fq * 8;
#pragma unroll
            for (int bj = 0; bj < 2; ++bj)
#pragma unroll
                for (int n = 0; n < 2; ++n) { *(f32x4*)(hp + bj * HALF + n * 4) = acc[1][bj][2][n]; *(f32x4*)(hp + FF2 + bj * HALF + n * 4) = acc[1][bj][3][n]; } }
        const int f0 = u.pn * 128 + wc * 32 + fq * 8;
        f32x4 W0[2][2], W1[2][2], W2[2][2], BB[2][2];
#pragma unroll
        for (int n = 0; n < 2; ++n)
#pragma unroll
            for (int bj = 0; bj < 2; ++bj) { const float* p = cw + bj * FF + f0 + 4 * n; W0[n][bj] = *(const f32x4*)p; W1[n][bj] = *(const f32x4*)(p + FF2); W2[n][bj] = *(const f32x4*)(p + 2 * FF2); BB[n][bj] = *(const f32x4*)(cb + bj * FF + f0 + 4 * n); }
        asm volatile("s_waitcnt lgkmcnt(0)" ::: "memory"); __builtin_amdgcn_s_barrier(); asm volatile("" ::: "memory");
        const LAS float* theirs = ex + (wid ^ 4) * 256;
        const int row0 = u.pm * BM + wr * 64 + 4 * fr;
#pragma unroll
        for (int ai = 0; ai < 2; ++ai) {
            f32x4 vpe[2][2], vne[2][2];
#pragma unroll
            for (int n = 0; n < 2; ++n)
#pragma unroll
                for (int bj = 0; bj < 2; ++bj) {
                    const bool hasp = (wr == 1) || (ai == 1); const int slotp = (wr == 1) ? (ai * 2 + 1) : 1;
                    const bool hasn = (wr == 0) || (ai == 0); const int slotn = (wr == 0) ? (ai * 2) : 2;
                    const f32x4 bp = hasp ? *(const LAS f32x4*)(theirs + slotp * 64 + (bj * 2 + n) * 16 + fq * 4) : (f32x4){0.f, 0.f, 0.f, 0.f};
                    const f32x4 bn = hasn ? *(const LAS f32x4*)(theirs + slotn * 64 + (bj * 2 + n) * 16 + fq * 4) : (f32x4){0.f, 0.f, 0.f, 0.f};
#pragma unroll
                    for (int j = 0; j < 4; ++j) { const float lastv = acc[ai][bj][3][n][j], firstv = acc[ai][bj][0][n][j];
                        vpe[n][bj][j] = dpp_shr1_old(bp[j], lastv); vne[n][bj][j] = dpp_shl1_old(bn[j], firstv); } }
#pragma unroll
            for (int m = 0; m < 4; ++m) {
                u32x4 w;
#pragma unroll
                for (int n = 0; n < 2; ++n) {
                    f32x4 up[2];
#pragma unroll
                    for (int bj = 0; bj < 2; ++bj) { const f32x4 v = acc[ai][bj][m][n];
                        const f32x4 vp = (m > 0) ? acc[ai][bj][m > 0 ? m - 1 : 0][n] : vpe[n][bj];
                        const f32x4 vn = (m < 3) ? acc[ai][bj][m < 3 ? m + 1 : 3][n] : vne[n][bj];
                        up[bj] = BB[n][bj] + W1[n][bj] * v + W0[n][bj] * vp + W2[n][bj] * vn; }
                    const f32x4 a = up[0], gt = up[1];
                    const unsigned lo = cvtpk(a.x * silu_f(gt.x), a.y * silu_f(gt.y)), hi = cvtpk(a.z * silu_f(gt.z), a.w * silu_f(gt.w));
                    if (n == 0) { w.x = lo; w.y = hi; } else { w.z = lo; w.w = hi; } }
                *(u32x4*)(act + (size_t)(row0 + ai * HALF + m) * FF + f0) = w; }
        }
    }
};

struct EpiResidNorm {
    static constexpr bool PERM = true, AFTER_DRAIN = true, APERM = false;
    const float* base; const bf16_t* baseb; bf16_t* xout; const float* gate; const float* cscale; int gcols;
    const float* nw; const float* msh; const float* msc; bf16_t* hout; float* fout;
    float* slots; unsigned* cnt;
    __device__ __forceinline__ void fused(f32x4 (&acc)[2][2][4][2], const Unit& u, int wr, int wc, int fr, int fq, LAS unsigned char* lds, int wid, int lane) const {
        LAS float* P = (LAS float*)lds; LAS float* S = (LAS float*)(lds + 4096); LAS unsigned* flag = (LAS unsigned*)(lds + 4096 + 1024);
        const int rl0 = wr * 64 + fr, row0 = u.pm * BM + rl0, col0 = u.g * gcols + u.pn * BM + wc * 32 + 8 * fq;
        const int b = u.pm >> 3, tile = (u.g * gcols) / 256 + u.pn, tid = wid * 64 + lane;
        {   const float* gv = gate + (size_t)b * NADA + col0;
            f32x4 gg[2][2];
#pragma unroll
            for (int bj = 0; bj < 2; ++bj)
#pragma unroll
                for (int n = 0; n < 2; ++n) { gg[bj][n] = *(const f32x4*)(gv + bj * HALF + n * 4); if (cscale) gg[bj][n] *= *(const f32x4*)(cscale + col0 + bj * HALF + n * 4); }
#pragma unroll
            for (int ai = 0; ai < 2; ++ai) {
                if (baseb) {
                    u32x4 bsr[4][2];
#pragma unroll
                    for (int m = 0; m < 4; ++m)
#pragma unroll
                        for (int bj = 0; bj < 2; ++bj) bsr[m][bj] = *(const u32x4*)(baseb + (size_t)(row0 + ai * HALF + m * 16) * DM + col0 + bj * HALF);
#pragma unroll
                    for (int m = 0; m < 4; ++m) { const size_t off = (size_t)(row0 + ai * HALF + m * 16) * DM + col0; float sq = 0.f;
#pragma unroll
                        for (int bj = 0; bj < 2; ++bj) { const u32x4 w = bsr[m][bj];
                            const f32x4 o0 = (f32x4){bflo(w.x), bfhi(w.x), bflo(w.y), bfhi(w.y)} + gg[bj][0] * acc[ai][bj][m][0];
                            const f32x4 o1 = (f32x4){bflo(w.z), bfhi(w.z), bflo(w.w), bfhi(w.w)} + gg[bj][1] * acc[ai][bj][m][1];
                            sq += ((o0.x * o0.x + o0.y * o0.y) + (o0.z * o0.z + o0.w * o0.w)) + ((o1.x * o1.x + o1.y * o1.y) + (o1.z * o1.z + o1.w * o1.w));
                            acc[ai][bj][m][0] = o0; acc[ai][bj][m][1] = o1;
                            if (xout) { u32x4 ov; ov.x = cvtpk(o0.x, o0.y); ov.y = cvtpk(o0.z, o0.w); ov.z = cvtpk(o1.x, o1.y); ov.w = cvtpk(o1.z, o1.w); *(u32x4*)(xout + off + bj * HALF) = ov; } }
                        sq += __shfl_xor(sq, 16); sq += __shfl_xor(sq, 32);
                        if (fq == 0) P[(rl0 + ai * HALF + m * 16) * 4 + wc] = sq; }
                } else {
                    f32x4 bsf[4][2][2];
#pragma unroll
                    for (int m = 0; m < 4; ++m)
#pragma unroll
                        for (int bj = 0; bj < 2; ++bj)
#pragma unroll
                            for (int n = 0; n < 2; ++n) bsf[m][bj][n] = *(const f32x4*)(base + (size_t)(row0 + ai * HALF + m * 16) * DM + col0 + bj * HALF + n * 4);
#pragma unroll
                    for (int m = 0; m < 4; ++m) { const size_t off = (size_t)(row0 + ai * HALF + m * 16) * DM + col0; float sq = 0.f;
#pragma unroll
                        for (int bj = 0; bj < 2; ++bj)
#pragma unroll
                            for (int n = 0; n < 2; ++n) { const f32x4 o = bsf[m][bj][n] + gg[bj][n] * acc[ai][bj][m][n];
                                sq += (o.x * o.x + o.y * o.y) + (o.z * o.z + o.w * o.w); acc[ai][bj][m][n] = o;
                                if (xout) stbf4(xout + off + bj * HALF + n * 4, o); }
                        sq += __shfl_xor(sq, 16); sq += __shfl_xor(sq, 32);
                        if (fq == 0) P[(rl0 + ai * HALF + m * 16) * 4 + wc] = sq; }
                }
                asm volatile("" ::: "memory");
            }
        }
        f32x4 ma[2][2], mb[2][2];
#pragma unroll
        for (int bj = 0; bj < 2; ++bj)
#pragma unroll
            for (int n = 0; n < 2; ++n) { const int c = col0 + bj * HALF + n * 4; ma[bj][n] = *(const f32x4*)(nw + c); mb[bj][n] = (f32x4){0.f, 0.f, 0.f, 0.f};
                if (msc) { ma[bj][n] *= (*(const f32x4*)(msc + (size_t)b * NADA + c) + 1.0f); mb[bj][n] = *(const f32x4*)(msh + (size_t)b * NADA + c); } }
        asm volatile("s_waitcnt lgkmcnt(0)" ::: "memory"); __builtin_amdgcn_s_barrier(); asm volatile("" ::: "memory");
        if (tid < 256) { const float tot = (P[tid * 4 + 0] + P[tid * 4 + 1]) + (P[tid * 4 + 2] + P[tid * 4 + 3]);
            __hip_atomic_store(slots + (size_t)(u.pm * BM + tid) * 8 + tile, tot, __ATOMIC_RELAXED, __HIP_MEMORY_SCOPE_AGENT); }
        asm volatile("s_waitcnt vmcnt(0)" ::: "memory");
        if (wid < 4 && lane == 0) __hip_atomic_fetch_add(cnt + 64 * u.pm, 1u, __ATOMIC_RELAXED, __HIP_MEMORY_SCOPE_AGENT);
        if (wid == 0) {
            unsigned spins = 0;
            while ((unsigned)__builtin_amdgcn_readfirstlane(__hip_atomic_load(cnt + 64 * u.pm, __ATOMIC_RELAXED, __HIP_MEMORY_SCOPE_AGENT)) < 32u) { __builtin_amdgcn_s_sleep(2); if (++spins > (1u << 20)) break; }
            __builtin_amdgcn_fence(__ATOMIC_ACQUIRE, "agent");
            if (lane == 0) flag[0] = 1u;
        }
        asm volatile("s_waitcnt vmcnt(0) lgkmcnt(0)" ::: "memory"); __builtin_amdgcn_s_barrier(); asm volatile("" ::: "memory");
        if (tid < 256) { const float* sl = slots + (size_t)(u.pm * BM + tid) * 8; float tot = 0.f;
#pragma unroll
            for (int t = 0; t < 8; ++t) tot += __hip_atomic_load(sl + t, __ATOMIC_RELAXED, __HIP_MEMORY_SCOPE_AGENT);
            S[tid] = 1.0f / sqrtf(tot * (1.0f / DM) + EPS); }
        asm volatile("s_waitcnt lgkmcnt(0)" ::: "memory"); __builtin_amdgcn_s_barrier(); asm volatile("" ::: "memory");
#pragma unroll
        for (int ai = 0; ai < 2; ++ai)
#pragma unroll
            for (int m = 0; m < 4; ++m) { const float rs = S[rl0 + ai * HALF + m * 16]; const size_t off = (size_t)(row0 + ai * HALF + m * 16) * DM + col0;
#pragma unroll
                for (int bj = 0; bj < 2; ++bj) { const f32x4 y0 = (acc[ai][bj][m][0] * rs) * ma[bj][0] + mb[bj][0], y1 = (acc[ai][bj][m][1] * rs) * ma[bj][1] + mb[bj][1];
                    if (hout) { u32x4 w; w.x = cvtpk(y0.x, y0.y); w.y = cvtpk(y0.z, y0.w); w.z = cvtpk(y1.x, y1.y); w.w = cvtpk(y1.z, y1.w); *(u32x4*)(hout + off + bj * HALF) = w; }
                    else { *(f32x4*)(fout + off + bj * HALF) = y0; *(f32x4*)(fout + off + bj * HALF + 4) = y1; } } }
    }
};

template <class Epi, bool ALIGN_EPI>
__device__ __forceinline__ void gemm_phase(LAS unsigned char* lds, const Gemm g, const TileOrder& S, const Epi& E, const int tid) {
    const int wid = __builtin_amdgcn_readfirstlane(tid >> 6), lane = tid & 63, wr = wid >> 2, wc = wid & 3, fr = lane & 15, fq = lane >> 4;
    const int K = g.K, nt = K / BK;
    unsigned voffA[2], voffB[2];
#pragma unroll
    for (int i = 0; i < 2; ++i) { int R, C; stage_rc(wid * 2048 + i * 1024 + lane * 16, R, C); const int Rb = Epi::PERM ? ((R & ~31) + perm32(R & 31)) : R;
        const int Ra = Epi::APERM ? ((R & ~63) + 4 * (R & 15) + ((R >> 4) & 3)) : R;
        voffA[i] = (unsigned)(Ra * g.lda + C) * 2u; voffB[i] = (unsigned)(Rb * g.ldb + C) * 2u; }
    const size_t kstep = (size_t)(BK * 2);
    const size_t hstepA = (size_t)HALF * g.lda * 2, hstepB = (size_t)HALF * g.ldb * 2;
    const unsigned ldsw = (unsigned)wid * 2048u, ldsbase = (unsigned)__builtin_amdgcn_readfirstlane((int)(unsigned)(uintptr_t)lds);
    const int aoff = lds_byte(wr * 64 + fr, fq * 8), boff = lds_byte(wc * 32 + fr, fq * 8);
#define PG8_SA(b, h) (((b) * 2 + (h)) * HTB)
#define PG8_SB(b, h) ((4 + (b) * 2 + (h)) * HTB)
#define PG8_STAGE(bufoff, gbase, voff) do { const char* gb_ = (const char*)(gbase); const char* gb1_ = gb_ - 1024; const unsigned m0v_ = ldsbase + (unsigned)(bufoff) + ldsw; \
          \
        asm volatile("s_mov_b32 m0, %0\n\ts_nop 0\n\tglobal_load_lds_dwordx4 %1, %3\n\tglobal_load_lds_dwordx4 %2, %4 offset:1024" \
                     :: "s"(m0v_), "v"((voff)[0]), "v"((voff)[1]), "s"(gb_), "s"(gb1_) : "memory", "m0"); } while (0)
#define PG8_LDA(dst, b, h) do { _Pragma("unroll") for (int m = 0; m < 4; ++m) _Pragma("unroll") for (int k = 0; k < 2; ++k) dst[m][k] = *(const LAS bf16x8*)(lds + PG8_SA(b, h) + aoff + m * 2048 + k * 1024); } while (0)
#define PG8_LDB(dst, b, h) do { _Pragma("unroll") for (int n = 0; n < 2; ++n) _Pragma("unroll") for (int k = 0; k < 2; ++k) dst[n][k] = *(const LAS bf16x8*)(lds + PG8_SB(b, h) + boff + n * 2048 + k * 1024); } while (0)
#define PG8_MMA(ai, bj, At, Bt) do { __builtin_amdgcn_s_setprio(1); _Pragma("unroll") for (int m = 0; m < 4; ++m) _Pragma("unroll") for (int n = 0; n < 2; ++n) _Pragma("unroll") for (int k = 0; k < 2; ++k) \
        acc[ai][bj][m][n] = __builtin_amdgcn_mfma_f32_16x16x32_bf16(Bt[n][k], At[m][k], acc[ai][bj][m][n], 0, 0, 0); __builtin_amdgcn_s_setprio(0); } while (0)
#define PG8_WAIT_V(n) asm volatile("s_waitcnt vmcnt(" #n ")" ::: "memory")
#define PG8_WAIT_VL8 asm volatile("s_waitcnt vmcnt(8) lgkmcnt(0)" ::: "memory")
#define PG8_WAIT_L(n) asm volatile("s_waitcnt lgkmcnt(" #n ")" ::: "memory")
#define PG8_BAR __builtin_amdgcn_s_barrier()
#define PG8_SCHED __builtin_amdgcn_sched_barrier(0)
    Unit cur, nxt; int ui = 0;
    if (!S.next(0, cur)) return;
    f32x4 acc[2][2][4][2];
#pragma unroll
    for (int a = 0; a < 2; ++a)
#pragma unroll
        for (int b = 0; b < 2; ++b)
#pragma unroll
            for (int m = 0; m < 4; ++m)
#pragma unroll
                for (int n = 0; n < 2; ++n) acc[a][b][m][n] = (f32x4){0.f, 0.f, 0.f, 0.f};
    bf16x8 At[4][2], B0[2][2], B1[2][2];
    const char* cA = (const char*)g.A + (size_t)cur.g * g.a_g + (size_t)cur.pm * 2 * hstepA; const char* cB = (const char*)g.Bt + (size_t)cur.g * g.b_g + (size_t)cur.pn * 2 * hstepB;
    PG8_STAGE(PG8_SB(0, 0), cB, voffB); PG8_STAGE(PG8_SB(0, 1), cB + hstepB, voffB); PG8_STAGE(PG8_SA(0, 0), cA, voffA); PG8_STAGE(PG8_SA(0, 1), cA + hstepA, voffA);
    if (wr == 1) PG8_BAR;
    PG8_WAIT_V(2); PG8_BAR;
    PG8_STAGE(PG8_SB(1, 0), cB + kstep, voffB); PG8_STAGE(PG8_SA(1, 0), cA + kstep, voffA); PG8_STAGE(PG8_SB(1, 1), cB + hstepB + kstep, voffB);
    PG8_WAIT_V(6); PG8_BAR;
    for (;;) {
        const bool has_next = S.next(ui + 1, nxt);
        const char* nA = has_next ? (const char*)g.A + (size_t)nxt.g * g.a_g + (size_t)nxt.pm * 2 * hstepA : cA;
        const char* nB = has_next ? (const char*)g.Bt + (size_t)nxt.g * g.b_g + (size_t)nxt.pn * 2 * hstepB : cB;
        for (int t = 0; t < nt; t += 2) {
            const bool last = (t == nt - 2);
            const char* a1 = cA + (size_t)(t + 1) * kstep;
            const char* a2 = last ? nA : cA + (size_t)(t + 2) * kstep; const char* b2 = last ? nB : cB + (size_t)(t + 2) * kstep;
            const char* a3 = a2 + kstep; const char* b3 = b2 + kstep;
            PG8_LDB(B0, 0, 0); PG8_LDB(B1, 0, 1); PG8_SCHED; PG8_LDA(At, 0, 0); PG8_STAGE(PG8_SA(1, 1), a1 + hstepA, voffA);
            PG8_WAIT_VL8; PG8_BAR; PG8_MMA(0, 0, At, B0); PG8_MMA(0, 1, At, B1); PG8_BAR; PG8_SCHED;
            PG8_STAGE(PG8_SA(0, 0), a2, voffA); PG8_SCHED; PG8_LDA(At, 0, 1); PG8_STAGE(PG8_SB(0, 0), b2, voffB); PG8_STAGE(PG8_SB(0, 1), b2 + hstepB, voffB);
            PG8_WAIT_VL8; PG8_BAR; PG8_MMA(1, 0, At, B0); PG8_MMA(1, 1, At, B1); PG8_BAR; PG8_SCHED;
            PG8_LDB(B0, 1, 0); PG8_LDB(B1, 1, 1); PG8_SCHED; PG8_LDA(At, 1, 0); PG8_STAGE(PG8_SA(0, 1), a2 + hstepA, voffA);
            PG8_WAIT_VL8; PG8_BAR; PG8_MMA(0, 0, At, B0); PG8_MMA(0, 1, At, B1); PG8_BAR; PG8_SCHED;
            PG8_STAGE(PG8_SA(1, 0), a3, voffA); PG8_SCHED; PG8_LDA(At, 1, 1); PG8_STAGE(PG8_SB(1, 0), b3, voffB); PG8_STAGE(PG8_SB(1, 1), b3 + hstepB, voffB);
            PG8_WAIT_VL8; PG8_BAR; PG8_MMA(1, 0, At, B0); PG8_MMA(1, 1, At, B1); PG8_BAR; PG8_SCHED;
        }
        if constexpr (ALIGN_EPI) { if (wr == 0) PG8_BAR; }
        if constexpr (!Epi::AFTER_DRAIN) E(acc, cur, wr, wc, fr, fq);
        if (!has_next) break;
#pragma unroll
        for (int a = 0; a < 2; ++a)
#pragma unroll
            for (int b = 0; b < 2; ++b)
#pragma unroll
                for (int m = 0; m < 4; ++m)
#pragma unroll
                    for (int n = 0; n < 2; ++n) acc[a][b][m][n] = (f32x4){0.f, 0.f, 0.f, 0.f};
        cur = nxt; cA = nA; cB = nB; ++ui;
        if constexpr (ALIGN_EPI) { if (wr == 1) PG8_BAR; }
    }
    PG8_WAIT_V(0);
    if constexpr (!ALIGN_EPI) { if (wr == 0) PG8_BAR; }
    PG8_BAR;
    if constexpr (Epi::AFTER_DRAIN) E.fused(acc, cur, wr, wc, fr, fq, lds, wid, lane);
#undef PG8_SA
#undef PG8_SB
#undef PG8_STAGE
#undef PG8_LDA
#undef PG8_LDB
#undef PG8_MMA
#undef PG8_WAIT_V
#undef PG8_WAIT_L
#undef PG8_WAIT_VL8
#undef PG8_BAR
#undef PG8_SCHED
}
__device__ __forceinline__ f32x4 pgp_y(const LAS char* Yb, const LAS float* rsd, const int j) {
    const u32x2 w = *(const LAS u32x2*)(Yb + j * 128); const float sc = rsd[j];
    return (f32x4){bflo(w.x) * sc, bfhi(w.x) * sc, bflo(w.y) * sc, bfhi(w.y) * sc};
}
}

namespace att {
constexpr int QBLK = 32, KVBLK = 64;
constexpr float SCALE = 0.072168783648703220f;
constexpr float THR = 8.f;
constexpr int SHM_V = 16384, SHM_KN = 16384, SHM_KR = 8192;
#define KSWZ(row, colB) ((row) * 256 + ((colB) ^ (((row) & 7) << 4)))
#define KRSWZ(row, colB) ((row) * 128 + ((colB) ^ (((row) & 7) << 4)))
#define SBAR() __builtin_amdgcn_sched_barrier(0)
#define LDS_BAR() asm volatile("s_waitcnt lgkmcnt(0)\n\ts_barrier" ::: "memory")
__device__ __forceinline__ int crow(int r, int hi) { return (r & 3) + 8 * (r >> 2) + 4 * hi; }
__device__ __forceinline__ void partialSM(f32x16& p0, f32x16& p1, float& m_reg, float& mn, float& alpha) {
  constexpr float C = SCALE * 1.4426950408889634f;
  float pmax = p0[0];
#pragma unroll
  for (int r = 1; r < 16; ++r) pmax = fmaxf(pmax, p0[r]);
#pragma unroll
  for (int r = 0; r < 16; ++r) pmax = fmaxf(pmax, p1[r]);
  { auto rr = __builtin_amdgcn_permlane32_swap(__float_as_uint(pmax), __float_as_uint(pmax), false, false);
    pmax = fmaxf(__uint_as_float(rr[0]), __uint_as_float(rr[1])); }
  if (__builtin_expect(__all(pmax - m_reg <= THR / SCALE), 1)) { mn = m_reg; alpha = 1.f; }
  else { mn = fmaxf(m_reg, pmax); alpha = __builtin_amdgcn_exp2f((m_reg - mn) * C); m_reg = mn; }
  float mnC = -mn * C;
#pragma unroll
  for (int r = 0; r < 16; ++r) p0[r] = fmaf(p0[r], C, mnC);
#pragma unroll
  for (int r = 0; r < 16; ++r) p1[r] = fmaf(p1[r], C, mnC);
#pragma unroll
  for (int r = 0; r < 16; ++r) p0[r] = __builtin_amdgcn_exp2f(p0[r]);
}
#define PK4(P, BASE, OUT) do { unsigned a0 = cvtpk(P[BASE + 0], P[BASE + 1]), a1 = cvtpk(P[BASE + 2], P[BASE + 3]);   \
    unsigned b0 = cvtpk(P[BASE + 4], P[BASE + 5]), b1 = cvtpk(P[BASE + 6], P[BASE + 7]);                              \
    auto r0 = __builtin_amdgcn_permlane32_swap(a0, b0, false, false); auto r1 = __builtin_amdgcn_permlane32_swap(a1, b1, false, false); \
    u32x4 w = {r0[0], r1[0], r0[1], r1[1]}; OUT = *reinterpret_cast<bf16x8*>(&w); } while (0)
__device__ __forceinline__ void finishSM(f32x16& p0, f32x16& p1, float alpha, float& l_reg, bf16x8& pa0, bf16x8& pa1, bf16x8& pa2, bf16x8& pa3) {
#pragma unroll
  for (int r = 0; r < 16; ++r) p1[r] = __builtin_amdgcn_exp2f(p1[r]);
  float ps = 0;
#pragma unroll
  for (int r = 0; r < 16; ++r) ps += p0[r];
#pragma unroll
  for (int r = 0; r < 16; ++r) ps += p1[r];
  { auto rr = __builtin_amdgcn_permlane32_swap(__float_as_uint(ps), __float_as_uint(ps), false, false);
    ps = __uint_as_float(rr[0]) + __uint_as_float(rr[1]); }
  l_reg = l_reg * alpha + ps;
  PK4(p0, 0, pa0); PK4(p0, 8, pa1); PK4(p1, 0, pa2); PK4(p1, 8, pa3);
}
__device__ __forceinline__ void qkt128(f32x16& p0, f32x16& p1, const char* Ks, const bf16x8* qr, int r32, int hi) {
#pragma unroll
  for (int d0 = 0; d0 < 8; ++d0) { int cb = (d0 * 16 + hi * 8) * 2;
    bf16x8 b0 = *reinterpret_cast<const bf16x8*>(Ks + KSWZ(r32, cb));
    bf16x8 b1 = *reinterpret_cast<const bf16x8*>(Ks + KSWZ(32 + r32, cb));
    p0 = __builtin_amdgcn_mfma_f32_32x32x16_bf16(b0, qr[d0], p0, 0, 0, 0);
    p1 = __builtin_amdgcn_mfma_f32_32x32x16_bf16(b1, qr[d0], p1, 0, 0, 0); }
}
__device__ __forceinline__ void qkt64(f32x16& p0, f32x16& p1, const char* Ks, const bf16x8* qr, int r32, int hi) {
#pragma unroll
  for (int d0 = 0; d0 < 4; ++d0) { int cb = (d0 * 16 + hi * 8) * 2;
    bf16x8 b0 = *reinterpret_cast<const bf16x8*>(Ks + KRSWZ(r32, cb));
    bf16x8 b1 = *reinterpret_cast<const bf16x8*>(Ks + KRSWZ(32 + r32, cb));
    p0 = __builtin_amdgcn_mfma_f32_32x32x16_bf16(b0, qr[d0], p0, 0, 0, 0);
    p1 = __builtin_amdgcn_mfma_f32_32x32x16_bf16(b1, qr[d0], p1, 0, 0, 0); }
}
__device__ __forceinline__ int v_st(int k, int c) { const int kk = (k & ~0xC) | ((k & 4) << 1) | ((k & 8) >> 1); return ((kk >> 3) * 4 + (c >> 5)) * 512 + ((kk & 7) * 32 + (c & 31)) * 2; }
__device__ __forceinline__ int v_rd_base(int lane) { return ((lane & 3) << 3) | (((lane >> 2) & 3) << 6) | (((lane >> 4) & 1) << 5) | (((lane >> 5) & 1) << 8); }
constexpr int v_rd_off(int d0, int ks, int half) { return d0 * 512 + ks * 4096 + half * 2048; }
template <int OFF> __device__ __forceinline__ s16x4 tr_read(int vb) {
  s16x4 r; asm volatile("ds_read_b64_tr_b16 %0, %1 offset:%2" : "=&v"(r) : "v"(vb), "i"(OFF) : "memory"); return r;
}
#define PKLH(L, H) (bf16x8){L[0], L[1], L[2], L[3], H[0], H[1], H[2], H[3]}
template <int D0> __device__ __forceinline__ void pv_one(f32x16& od, int vb, bf16x8 pa0, bf16x8 pa1, bf16x8 pa2, bf16x8 pa3) {
  const s16x4 l0 = tr_read<v_rd_off(D0, 0, 0)>(vb), h0 = tr_read<v_rd_off(D0, 0, 1)>(vb), l1 = tr_read<v_rd_off(D0, 1, 0)>(vb), h1 = tr_read<v_rd_off(D0, 1, 1)>(vb);
  const s16x4 l2 = tr_read<v_rd_off(D0, 2, 0)>(vb), h2 = tr_read<v_rd_off(D0, 2, 1)>(vb), l3 = tr_read<v_rd_off(D0, 3, 0)>(vb), h3 = tr_read<v_rd_off(D0, 3, 1)>(vb);
  asm volatile("s_waitcnt lgkmcnt(0)" ::: "memory"); SBAR();
  od = __builtin_amdgcn_mfma_f32_32x32x16_bf16(pa0, PKLH(l0, h0), od, 0, 0, 0);
  od = __builtin_amdgcn_mfma_f32_32x32x16_bf16(pa1, PKLH(l1, h1), od, 0, 0, 0);
  od = __builtin_amdgcn_mfma_f32_32x32x16_bf16(pa2, PKLH(l2, h2), od, 0, 0, 0);
  od = __builtin_amdgcn_mfma_f32_32x32x16_bf16(pa3, PKLH(l3, h3), od, 0, 0, 0);
}
__device__ __forceinline__ void pv_d0(f32x16* o, int vb, bf16x8 pa0, bf16x8 pa1, bf16x8 pa2, bf16x8 pa3) {
  pv_one<0>(o[0], vb, pa0, pa1, pa2, pa3); pv_one<1>(o[1], vb, pa0, pa1, pa2, pa3); pv_one<2>(o[2], vb, pa0, pa1, pa2, pa3); pv_one<3>(o[3], vb, pa0, pa1, pa2, pa3);
}

__device__ __forceinline__ void mla_body(const bf16_t* __restrict__ Qn, const bf16_t* __restrict__ Qr, const bf16_t* __restrict__ Kn, const bf16_t* __restrict__ Kr,
                                         const bf16_t* __restrict__ Vh, bf16_t* __restrict__ Ob, int ldo, int seq, char* lds, const int tid) {
  const int wid = tid >> 6, lane = tid & 63, r32 = lane & 31, hi = lane >> 5;
  char* V_lds = lds; char* K_lds = lds + 2 * SHM_V; char* R_lds = lds + 2 * SHM_V + 2 * SHM_KN;
  float* ws = (float*)(lds + 2 * SHM_V + 2 * SHM_KN + 2 * SHM_KR) + wid * 64; float* li_l = ws; float* al_l = ws + 32;
  float m_reg = -1e30f, l_reg = 0; f32x16 o[4] = {}; bf16x8 qr[12];
  { const bf16_t* Qw = Qn + (long)(wid * QBLK + r32) * 128 + hi * 8;
#pragma unroll
    for (int d0 = 0; d0 < 8; ++d0) qr[d0] = *reinterpret_cast<const bf16x8*>(Qw + d0 * 16);
    const bf16_t* Qw2 = Qr + (long)(wid * QBLK + r32) * 64 + hi * 8;
#pragma unroll
    for (int d0 = 0; d0 < 4; ++d0) qr[8 + d0] = *reinterpret_cast<const bf16x8*>(Qw2 + d0 * 16); }
  const int sr = tid >> 4, sc = (tid & 15) * 8, vst0 = v_st(sr, sc), vst1 = v_st(32 + sr, sc);
  const int rr = tid >> 3, rc = (tid & 7) * 8;
  const int vb0 = (int)(uintptr_t)V_lds + v_rd_base(lane);
  bf16x8 svs0, svs1, sks0, sks1, skr;
#define SLOAD(k0) do { svs0 = *reinterpret_cast<const bf16x8*>(&Vh[(long)((k0) + sr) * 128 + sc]); svs1 = *reinterpret_cast<const bf16x8*>(&Vh[(long)((k0) + 32 + sr) * 128 + sc]); \
    sks0 = *reinterpret_cast<const bf16x8*>(&Kn[(long)((k0) + sr) * 128 + sc]); sks1 = *reinterpret_cast<const bf16x8*>(&Kn[(long)((k0) + 32 + sr) * 128 + sc]); \
    skr = *reinterpret_cast<const bf16x8*>(&Kr[(long)((k0) + rr) * 64 + rc]); } while (0)
#define SWRITE(b) do { *(bf16x8*)(V_lds + (b) * SHM_V + vst0) = svs0; *(bf16x8*)(V_lds + (b) * SHM_V + vst1) = svs1; int kc = sc * 2;               \
    *(bf16x8*)(K_lds + (b) * SHM_KN + KSWZ(sr, kc)) = sks0; *(bf16x8*)(K_lds + (b) * SHM_KN + KSWZ(32 + sr, kc)) = sks1;                       \
    *(bf16x8*)(R_lds + (b) * SHM_KR + KRSWZ(rr, rc * 2)) = skr; } while (0)
#define RESC(a) do { if (__any((a) < 1.f)) { if (hi == 0) al_l[r32] = (a); asm volatile("s_waitcnt lgkmcnt(0)" ::: "memory"); \
    _Pragma("unroll") for (int d = 0; d < 4; ++d) _Pragma("unroll") for (int r = 0; r < 16; ++r) o[d][r] *= al_l[crow(r, hi)]; } } while (0)
  const int NT = seq / KVBLK;
  SLOAD(0); asm volatile("s_waitcnt vmcnt(0)" ::: "memory"); SWRITE(0); __syncthreads();
  for (int j = 0; j < NT; ++j) {
    const int buf = j & 1;
    if (j + 1 < NT) SLOAD((j + 1) * KVBLK);
    f32x16 p0 = {}, p1 = {}; float mn, al; bf16x8 pa0, pa1, pa2, pa3;
    qkt128(p0, p1, K_lds + buf * SHM_KN, qr, r32, hi); qkt64(p0, p1, R_lds + buf * SHM_KR, qr + 8, r32, hi);
    partialSM(p0, p1, m_reg, mn, al);
    RESC(al);
    finishSM(p0, p1, al, l_reg, pa0, pa1, pa2, pa3); SBAR();
    pv_d0(o, vb0 + buf * SHM_V, pa0, pa1, pa2, pa3);
    if (j + 1 < NT) { asm volatile("s_waitcnt vmcnt(0)" ::: "memory"); SWRITE(buf ^ 1); }
    __syncthreads();
  }
  if (hi == 0) li_l[r32] = l_reg; asm volatile("s_waitcnt lgkmcnt(0)" ::: "memory");
  float rli[16];
#pragma unroll
  for (int r = 0; r < 16; ++r) rli[r] = __builtin_amdgcn_rcpf(li_l[crow(r, hi)]);
  char* OT = lds + wid * 8704;
  { char* OTw = OT + (4 * hi) * 272 + r32 * 2; asm volatile("" : "+v"(OTw));
#pragma unroll
    for (int r = 0; r < 16; ++r) { const int rc = (r & 3) + 8 * (r >> 2);
#pragma unroll
      for (int d0 = 0; d0 < 4; ++d0) *(unsigned short*)(OTw + rc * 272 + d0 * 64) = (unsigned short)f2bf(o[d0][r] * rli[r]); } }
  asm volatile("s_waitcnt lgkmcnt(0)" ::: "memory");
  bf16_t* Ow = Ob + (long)(wid * QBLK) * ldo;
  { int ln = r32 + 32 * hi; asm volatile("" : "+v"(ln));
    const int rw = ln >> 4, ch = ln & 15;
#pragma unroll
    for (int i = 0; i < 8; ++i) { const int row = i * 4 + rw;
      *(u32x4*)(Ow + (long)row * ldo + ch * 8) = *(const u32x4*)(OT + row * 272 + ch * 16); } }
#undef SLOAD
#undef SWRITE
#undef RESC
}
}


#define XB_TMO      128
#define XB_XCNT(j)  (256  + 64 * (j))
#define XB_XSUB(j)  (1280 + 64 * (j))
#define XB_XGEN(j)  (2304 + 64 * (j))
#define XB_TOP      3328
#define XB_TOPGEN   3392
#define XCD_BAR_WORDS 3456
#define XB_SPIN_CAP (1u << 18)
__device__ __forceinline__ unsigned xb_ld(unsigned* p)              { return __hip_atomic_load(p, __ATOMIC_RELAXED, __HIP_MEMORY_SCOPE_AGENT); }
__device__ __forceinline__ unsigned xb_add(unsigned* p, unsigned v) { return __hip_atomic_fetch_add(p, v, __ATOMIC_RELAXED, __HIP_MEMORY_SCOPE_AGENT); }
__device__ __forceinline__ unsigned xb_xcc_id() { return (unsigned)__builtin_amdgcn_s_getreg((3 << 11) | 20) & 0xFu; }
#define XB_SPIN(cond, bar) do { unsigned _sp = 0; while (cond) { __builtin_amdgcn_s_sleep(1); \
    if ((++_sp & 255u) == 0u) { if (xb_ld(&(bar)[XB_TMO])) break; if (_sp > XB_SPIN_CAP) { atomicAdd(&(bar)[XB_TMO], 1u); break; } } } } while (0)
struct XcdBarrier { unsigned* bar; unsigned x; volatile LAS unsigned* st; };
__device__ __forceinline__ XcdBarrier xcd_barrier_post(unsigned* bar, volatile LAS unsigned* st) {
    XcdBarrier b; b.bar = bar; b.x = xb_xcc_id(); b.st = st;
    if (threadIdx.x == 0) (void)xb_add(&bar[XB_XCNT(b.x)], 1u);
    return b;
}
__device__ __forceinline__ void xcd_barrier_complete(unsigned* bar, unsigned x, unsigned& nloc, unsigned& nx) {
    const unsigned G = gridDim.x * gridDim.y * gridDim.z;
    unsigned sum, cnt, mine, sp = 0u;
    for (;;) {
        sum = 0u; cnt = 0u; mine = 0u;
#pragma unroll
        for (unsigned j = 0; j < 16; ++j) { const unsigned c = xb_ld(&bar[XB_XCNT(j)]); sum += c; cnt += (c > 0u) ? 1u : 0u; mine = (j == x) ? c : mine; }
        if (sum == G) break;
        __builtin_amdgcn_s_sleep(1);
        if ((++sp & 255u) == 0u) { if (xb_ld(&bar[XB_TMO])) break; if (sp > XB_SPIN_CAP) { atomicAdd(&bar[XB_TMO], 1u); break; } }
    }
    nloc = mine > 0u ? mine : 1u; nx = cnt > 0u ? cnt : 1u;
}
__device__ __forceinline__ void xcd_barrier(const XcdBarrier& b) {
    asm volatile("s_waitcnt vmcnt(0)" ::: "memory");
    __syncthreads();
    if (threadIdx.x == 0) {
        unsigned* bar = b.bar;
        __builtin_amdgcn_s_waitcnt(0);
        unsigned nloc = b.st[0], nx = b.st[1];
        if (nloc == 0u) { xcd_barrier_complete(bar, b.x, nloc, nx); b.st[0] = nloc; b.st[1] = nx; }
        const unsigned old = xb_add(&bar[XB_XSUB(b.x)], 1u);
        const unsigned gen = old / nloc;
        if (old + 1u == (gen + 1u) * nloc) {
            __builtin_amdgcn_fence(__ATOMIC_RELEASE, "agent");
            asm volatile("s_waitcnt vmcnt(0)" ::: "memory");
            const unsigned og = xb_add(&bar[XB_TOP], 1u);
            const unsigned tg = og / nx;
            if (og + 1u == (tg + 1u) * nx) xb_add(&bar[XB_TOPGEN], 1u);
            else XB_SPIN(xb_ld(&bar[XB_TOPGEN]) == tg, bar);
            __builtin_amdgcn_fence(__ATOMIC_ACQUIRE, "agent");
            xb_add(&bar[XB_XGEN(b.x)], 1u);
            asm volatile("s_waitcnt vmcnt(0)" ::: "memory");
        } else {
            XB_SPIN(xb_ld(&bar[XB_XGEN(b.x)]) == gen, bar);
            __builtin_amdgcn_fence(__ATOMIC_ACQUIRE, "agent");
            asm volatile("s_waitcnt vmcnt(0)" ::: "memory");
        }
    }
    __syncthreads();
}
constexpr int MISC_OFF = LDS_BYTES - 256;
constexpr size_t CTL_ZERO_BYTES = 64 * 1024;

struct Args { const float* in[23]; float* out; unsigned char* ws; int ph_lo, ph_hi; };

#ifndef ONLYMASK
#define ONLYMASK 0xffffffffu
#endif
#define EN(p) (((ONLYMASK) >> (p)) & 1u)
#ifndef REPMASK
#define REPMASK 0u
#endif
#define REP(p) (((REPMASK) >> (p)) & 1u)
enum Phase { PH_PREP = 0, PH_NORM1, PH_G1, PH_SPLIT1, PH_G2, PH_G3, PH_SPLIT2, PH_R1, PH_R2, PH_ATTN, PH_R3, PH_G4, PH_NORM2A, PH_G5, PH_CONVA, PH_G6,
             PH_RSTD, PH_POOL, PH_G7, PH_NORM2B, PH_G8, PH_CONVB, PH_G9, PH_FINAL, PH_COUNT };


#define x_in (args.in[0])
#define c_in (args.in[1])
#define ctx_in (args.in[2])
#define cctx_in (args.in[3])
#define ada_w (args.in[4])
#define ada_b (args.in[5])
#define norm1_g (args.in[6])
#define norm2_g (args.in[7])
#define w_up (args.in[8])
#define conv_w (args.in[9])
#define conv_b (args.in[10])
#define w_down (args.in[11])
#define w_in (args.in[12])
#define qn_g (args.in[13])
#define w_uq (args.in[14])
#define kvn_g (args.in[15])
#define w_ukv (args.in[16])
#define dec_f (args.in[17])
#define dec_b (args.in[18])
#define w_out (args.in[19])
#define pool_w (args.in[20])
#define pool_scale (args.in[21])
#define final_g (args.in[22])
#define X (args.out)
#define ADA ((float*)(ws + WS_ADA))
#define RT128 ((f32x2*)(ws + WS_RT128))
#define RT64 ((f32x2*)(ws + WS_RT64))
#define RSTDQ ((float*)(ws + WS_RSTDQ))
#define RSTDKV ((float*)(ws + WS_RSTDKV))
#define RSTDX ((float*)(ws + WS_RSTDX))
#define WIN ((bf16_t*)(ws + WS_WIN))
#define WUQ ((bf16_t*)(ws + WS_WUQ))
#define WUKV ((bf16_t*)(ws + WS_WUKV))
#define WPOOL ((bf16_t*)(ws + WS_WPOOL))
#define WOUT ((bf16_t*)(ws + WS_WOUT))
#define WUP ((bf16_t*)(ws + WS_WUP))
#define WDN ((bf16_t*)(ws + WS_WDN))
#define H ((bf16_t*)(ws + WS_H))
#define XB2 ((bf16_t*)(ws + WS_MIX))
#define RQ ((bf16_t*)(ws + WS_RQ))
#define RK ((bf16_t*)(ws + WS_RK))
#define RV ((bf16_t*)(ws + WS_RV))
#define RG ((bf16_t*)(ws + WS_RG))
#define CQ ((bf16_t*)(ws + WS_CQ))
#define CKV ((bf16_t*)(ws + WS_CKV))
#define QN ((bf16_t*)(ws + WS_QN))
#define QR ((bf16_t*)(ws + WS_QR))
#define KN ((bf16_t*)(ws + WS_KN))
#define KR ((bf16_t*)(ws + WS_KR))
#define VC ((bf16_t*)(ws + WS_VC))
#define KVB ((bf16_t*)(ws + WS_KVB))
#define ST ((bf16_t*)(ws + WS_ST))
#define MIX ((bf16_t*)(ws + WS_MIX))
#define ACT ((bf16_t*)(ws + WS_ACT))
#define Z1 ((float*)(ws + WS_Z))
#define Z2 ((float*)(ws + WS_Z))
#define Z3 ((float*)(ws + WS_Z3))
#define U ((bf16_t*)(ws + WS_Z))
#define HALO ((float*)(ws + WS_Z))
#define XB ((bf16_t*)(ws + WS_XB))
#define PH_PARAMS const Args& args, unsigned char* ws, LAS unsigned char* lds, unsigned char* lds_raw, const int tid, const int lane, const int wave, const int bid, const int G, const int gw, const int NGW, const int ph
#define PH_CALL(p) args, ws, lds, lds_raw, tid, lane, wave, bid, G, gw, NGW, (p)
constexpr int CV_I0 = 32 * 160, CV_I1 = 8 * 48, CV_I2 = 4 * 64, CV_I3 = 32 * 64, CV_I4 = 32 * 352, CV_I6 = 88 * 64, CV_I8 = 8 * 16;
constexpr int CV_N0 = CV_I0 + CV_I1 + CV_I2 + CV_I3 + CV_I4 + CV_I6, CV_N1 = CV_I4 + CV_I6 + 4 * CV_I8;

constexpr int CT_W_IN = 16 * 40, CT_W_UQ = 4 * 12, CT_W_UKV = 2 * 16, CT_W_OUT = 16 * 16, CT_W_UP = 16 * 88, CT_W_DN = 44 * 16, CT_POOL = 4 * 4;
constexpr int CT_N0 = CT_W_IN + CT_W_UQ + CT_W_UKV + CT_W_OUT + CT_W_UP + CT_W_DN, CT_N1 = CT_W_UP + CT_W_DN + 4 * CT_POOL;
struct CTile { const float* W; bf16_t* WT; const float* ks; int K, N, k0, n0, runA, runB, mode; };
__device__ __forceinline__ const float* ct_opaque(const float* p) { asm volatile("" : "+s"(p)); return p; }
__device__ __forceinline__ void ct_decode(const Args& args, unsigned char* ws, const int set, int r, CTile& t) {
    int ntn, nt, kt; t.ks = nullptr; t.mode = 0;
    if (set == 0 && r < CT_W_IN) { ntn = 40; kt = r / ntn; nt = r % ntn; t.W = ct_opaque(w_in); t.K = DM; t.N = INC; t.WT = WIN;
        if (nt < 16) { t.runA = nt * 128; t.runB = t.runA + 64; t.mode = 1; } else if (nt < 38) { t.runA = nt * 128; t.runB = t.runA + 64; } else if (nt == 38) { t.runA = 4864; t.runB = -1; t.mode = 2; } else { t.runA = -1; t.runB = -1; } }
    else if (set == 0 && (r -= CT_W_IN) < CT_W_UQ) { ntn = 12; kt = r / ntn; nt = r % ntn; t.W = ct_opaque(w_uq); t.K = QRANK; t.N = 1536; t.WT = WUQ; t.ks = qn_g;
        if (nt < 8) { t.runA = nt * 192; t.runB = t.runA + 64; } else { const int h0 = 2 * (nt - 8); t.runA = h0 * 192 + 128; t.runB = (h0 + 1) * 192 + 128; t.mode = 2; } }
    else if (set == 0 && (r -= CT_W_UQ) < CT_W_UKV) { ntn = 16; kt = r / ntn; nt = r % ntn; t.W = ct_opaque(w_ukv); t.K = KVRANK; t.N = 2048; t.WT = WUKV; t.ks = kvn_g;
        t.runA = nt < 8 ? nt * 256 : (nt - 8) * 256 + 128; t.runB = t.runA + 64; }
    else if (set == 0 && (r -= CT_W_UKV) < CT_W_OUT) { ntn = 16; kt = r / ntn; nt = r % ntn; t.W = ct_opaque(w_out); t.K = DM; t.N = DM; t.WT = WOUT; t.runA = nt * 128; t.runB = t.runA + 64; }
    else if (set == 0 ? (r -= CT_W_OUT) < CT_W_UP : r < CT_W_UP) { ntn = 88; kt = r / ntn; nt = r % ntn; const int l = set; t.W = ct_opaque(w_up + (size_t)l * DM * FF2); t.K = DM; t.N = FF2; t.WT = WUP + (size_t)l * FF2 * DM;
        t.runA = (nt & 1) * FF + (nt >> 1) * 128; t.runB = t.runA + 64; }
    else if ((r -= CT_W_UP) < CT_W_DN) { ntn = 16; kt = r / ntn; nt = r % ntn; const int l = set; t.W = ct_opaque(w_down + (size_t)l * FF * DM); t.K = FF; t.N = DM; t.WT = WDN + (size_t)l * DM * FF; t.runA = nt * 128; t.runB = t.runA + 64; }
    else { r -= CT_W_DN; const int gi = r / CT_POOL; r %= CT_POOL; ntn = 4; kt = r / ntn; nt = r % ntn; t.W = ct_opaque(pool_w + (size_t)gi * 512 * 512); t.K = 512; t.N = 512; t.WT = WPOOL + (size_t)gi * 512 * 512; t.runA = nt * 128; t.runB = t.runA + 64; }
    t.k0 = kt * 128; t.n0 = nt * 128;
}
__device__ __forceinline__ void ct_load(const CTile& t, f32x4 (&v)[8], const int wave, const int lane) {
    const int c = (lane & 31) * 4, run = c < 64 ? t.runA : t.runB;
    if (t.runA < 0 && t.runB < 0) {
#pragma unroll
        for (int i = 0; i < 8; ++i) v[i] = (f32x4){0.f, 0.f, 0.f, 0.f};
        return; }
    const int runc = run >= 0 ? run : t.runA;
    const float* p = t.W + (size_t)(t.k0 + wave * 16 + (lane >> 5)) * t.N + runc + (c & 63);
#pragma unroll
    for (int i = 0; i < 8; ++i) v[i] = __builtin_nontemporal_load((const f32x4*)(p + (size_t)(2 * i) * t.N));
    if (run < 0) {
#pragma unroll
        for (int i = 0; i < 8; ++i) v[i] = (f32x4){0.f, 0.f, 0.f, 0.f}; }
}
__device__ __forceinline__ void ct_put(const CTile& t, const f32x4 (&v)[8], LAS float* T, const int wave, const int lane) {
    const int c = (lane & 31) * 4, row0 = wave * 16 + (lane >> 5);
#pragma unroll
    for (int i = 0; i < 8; ++i) { f32x4 x = v[i]; const int row = row0 + 2 * i; if (t.ks) x *= t.ks[t.k0 + row]; LAS float* d = T + row * 129 + c; d[0] = x.x; d[1] = x.y; d[2] = x.z; d[3] = x.w; }
}
__device__ __forceinline__ void ct_store(const CTile& t, const LAS float* T, const int wave, const int lane) {
    const int c8 = lane & 7;
#pragma unroll
    for (int j = 0; j < 4; ++j) { const int half = j & 1, n = wave * 16 + (j >> 1) * 8 + (lane >> 3), kk0 = half * 64 + c8 * 8;
        const int lc = t.mode == 0 ? n : (t.mode == 1 ? (n >> 1) + (n & 1) * 64 : (n & 64) + ((n & 63) >> 1) + (n & 1) * 32);
        const LAS float* sp = T + kk0 * 129 + lc;
        u32x4 o; o.x = pk2(sp[0 * 129], sp[1 * 129]); o.y = pk2(sp[2 * 129], sp[3 * 129]); o.z = pk2(sp[4 * 129], sp[5 * 129]); o.w = pk2(sp[6 * 129], sp[7 * 129]);
        *(u32x4*)(t.WT + (size_t)(t.n0 + n) * t.K + t.k0 + kk0) = o; }
}
__device__ __forceinline__ void convert_tiles2(PH_PARAMS, const int set, const int lo1, const int hi1, const int lo2, const int hi2, const int vb, const int nvb) {
    const int n1 = hi1 - lo1, hi = n1 + (hi2 - lo2), lo = 0;
#define CT_IDX(v) ((v) < n1 ? lo1 + (v) : lo2 + ((v) - n1))
    LAS float* T0 = (LAS float*)lds; LAS float* T1 = (LAS float*)(lds + 66048);
    const int it = lo + vb; if (it >= hi) return;
    CTile tc, ta, tb; f32x4 vA[8], vB[8];
    ct_decode(args, ws, set, CT_IDX(it), tc); ct_load(tc, vA, wave, lane);
    __syncthreads();
    ct_put(tc, vA, T0, wave, lane);
    bool hasA = it + nvb < hi, hasB = it + 2 * nvb < hi; ta = tc; tb = tc;
    if (hasA) { ct_decode(args, ws, set, CT_IDX(it + nvb), ta); ct_load(ta, vA, wave, lane); }
    if (hasB) { ct_decode(args, ws, set, CT_IDX(it + 2 * nvb), tb); ct_load(tb, vB, wave, lane); }
    __syncthreads();
    int nx = it + 3 * nvb, cur = 0;
    for (;;) {
        ct_store(tc, cur ? T1 : T0, wave, lane);
        if (!hasA) break;
        ct_put(ta, vA, cur ? T0 : T1, wave, lane); tc = ta;
        hasA = hasB && nx < hi;
        if (hasA) { ct_decode(args, ws, set, CT_IDX(nx), ta); ct_load(ta, vA, wave, lane); }
        nx += nvb;
        __syncthreads(); cur ^= 1;
        ct_store(tc, cur ? T1 : T0, wave, lane);
        if (!hasB) break;
        ct_put(tb, vB, cur ? T0 : T1, wave, lane); tc = tb;
        hasB = hasA && nx < hi;
        if (hasB) { ct_decode(args, ws, set, CT_IDX(nx), tb); ct_load(tb, vB, wave, lane); }
        nx += nvb;
        __syncthreads(); cur ^= 1;
    }
    __syncthreads();
}
#undef CT_IDX
__device__ __forceinline__ void convert_tiles(PH_PARAMS, const int set, const int lo, const int hi, const int vb, const int nvb) { convert_tiles2(PH_CALL(ph), set, lo, hi, 0, 0, vb, nvb); }
__device__ __forceinline__ void ada_items(PH_PARAMS, const int l, const int vb, const int nvb) {
        {
            LAS float* sil = (LAS float*)lds; LAS float* red = (LAS float*)(lds + 5 * 2048 * 4);
            for (int i = tid; i < 5 * 2048; i += 512) { const int r = i >> 11, k = i & 2047; const float v = r < 4 ? c_in[r * 2048 + k] : cctx_in[k]; sil[i] = v / (1.f + expf(-v)); }
            __syncthreads();
            for (int item = vb; item < 128; item += nvb) {
                const int n0 = item * 96, kq = lane >> 3, c4 = (lane & 7) * 4;
                const float* Wp = ada_w + (size_t)l * DM * NADA + n0 + c4;
                f32x4 a[5][3];
#pragma unroll
                for (int r = 0; r < 5; ++r)
#pragma unroll
                    for (int j = 0; j < 3; ++j) a[r][j] = (f32x4){0.f, 0.f, 0.f, 0.f};
                const int kbeg = wave * 256 + kq;
                const float* wp = Wp + (size_t)kbeg * NADA; const LAS float* sp = sil + kbeg;
#define ADA_LOAD(W) do { _Pragma("unroll") for (int u = 0; u < 4; ++u) _Pragma("unroll") for (int j = 0; j < 3; ++j) W[u][j] = __builtin_nontemporal_load((const f32x4*)(wp + (size_t)(8 * u) * NADA + 32 * j)); wp += (size_t)32 * NADA; } while (0)
#define ADA_FMA(W) do { _Pragma("unroll") for (int u = 0; u < 4; ++u) _Pragma("unroll") for (int r = 0; r < 5; ++r) { const float sv = sp[r * 2048 + 8 * u]; \
                        _Pragma("unroll") for (int j = 0; j < 3; ++j) a[r][j] += W[u][j] * sv; } sp += 32; } while (0)
                f32x4 wv0[4][3], wv1[4][3];
                ADA_LOAD(wv0);
#pragma unroll 1
                for (int kk = 0; kk < 8; kk += 2) {
                    ADA_LOAD(wv1);
                    ADA_FMA(wv0);
                    if (kk + 2 < 8) ADA_LOAD(wv0);
                    ADA_FMA(wv1);
                }
#undef ADA_LOAD
#undef ADA_FMA
#pragma unroll
                for (int r = 0; r < 5; ++r)
#pragma unroll
                    for (int j = 0; j < 3; ++j) {
#pragma unroll
                        for (int q = 0; q < 4; ++q) { float v = a[r][j][q]; v += __shfl_xor(v, 8); v += __shfl_xor(v, 16); v += __shfl_xor(v, 32); a[r][j][q] = v; }
                        if (kq == 0) *(LAS f32x4*)(red + (wave * 5 + r) * 96 + 32 * j + c4) = a[r][j]; }
                __syncthreads();
                if (tid < 5 * 96) { const int r = tid / 96, j = tid % 96; float sum = ada_b[l * NADA + n0 + j];
#pragma unroll
                    for (int w = 0; w < 8; ++w) sum += red[(w * 5 + r) * 96 + j];
                    ADA[(size_t)(l * 5 + r) * NADA + n0 + j] = sum; }
                __syncthreads();
            }
            __syncthreads();
        }
}
__device__ __forceinline__ void phase_PREP(PH_PARAMS) {
        if (G == 256) ada_items(PH_CALL(ph), bid >> 7, bid & 127, 128);
        else { ada_items(PH_CALL(ph), 0, bid, G); __syncthreads(); ada_items(PH_CALL(ph), 1, bid, G); }
        asm volatile("s_waitcnt vmcnt(0)" ::: "memory"); __syncthreads();
        if (tid == 0) { __builtin_amdgcn_fence(__ATOMIC_RELEASE, "agent"); asm volatile("s_waitcnt vmcnt(0)" ::: "memory"); __hip_atomic_fetch_add((unsigned*)(ws + WS_CTL + 49152), 1u, __ATOMIC_RELAXED, __HIP_MEMORY_SCOPE_AGENT); }
    for (int i = bid * 512 + tid; i < 32768 + 8192; i += G * 512) ((float*)(ws + WS_RSTDQ))[i] = 0.f;
        for (int i = bid * 512 + tid; i < 2048 * 96; i += G * 512) {
            const int t = i / 96, e = i % 96; const float row = (float)(t >> 6), col = (float)(t & 63);
            float s, c;
            if (e < 64) { const int nf = 32; const int j = e < nf ? e : e - nf; const float inv = exp2f(-(float)j / (float)nf * 13.287712379549449f); const float ang = (e < nf ? row : col) * inv;
                sincos_acc(ang, s, c); RT128[t * 64 + e] = (f32x2){c, s}; }
            else { const int e2 = e - 64; const int nf = 16; const int j = e2 < nf ? e2 : e2 - nf; const float inv = exp2f(-(float)j / (float)nf * 13.287712379549449f); const float ang = (e2 < nf ? row : col) * inv;
                sincos_acc(ang, s, c); RT64[t * 32 + e2] = (f32x2){c, s}; }
        }
        if (G == 256) convert_tiles(PH_CALL(ph), 0, 0, CT_N0 - CT_W_DN, bid, G);
        else convert_tiles(PH_CALL(ph), 0, 0, CT_N0, bid, G);
        if (tid == 0) { unsigned spins = 0; while (__hip_atomic_load((unsigned*)(ws + WS_CTL + 49152), __ATOMIC_RELAXED, __HIP_MEMORY_SCOPE_AGENT) < (unsigned)G) { __builtin_amdgcn_s_sleep(2); if (++spins > (1u << 20)) break; }
            __builtin_amdgcn_fence(__ATOMIC_ACQUIRE, "agent"); asm volatile("s_waitcnt vmcnt(0)" ::: "memory"); }
        __syncthreads();
}
__device__ __forceinline__ void phase_NORM(PH_PARAMS) {
        const int l = (ph == PH_NORM2B); const int nrows = (ph == PH_NORM1) ? MALL : MLAT;
        const float* gvec = (ph == PH_NORM1 ? norm1_g : norm2_g) + l * DM;
        const int shc = (ph == PH_NORM1) ? 0 : 3;
        LAS float* gm = (LAS float*)lds; LAS float* sm = gm + 5 * DM;
        for (int i = tid; i < 5 * DM / 4; i += 512) { const int r = i / (DM / 4), c = (i % (DM / 4)) * 4;
            const float* sh = ADA + (size_t)(l * 5 + r) * NADA + shc * DM; const float* sc = sh + DM;
            *(LAS f32x4*)(gm + r * DM + c) = *(const f32x4*)(gvec + c) * (*(const f32x4*)(sc + c) + 1.0f); *(LAS f32x4*)(sm + r * DM + c) = *(const f32x4*)(sh + c); }
        __syncthreads();
#define NORM_ROW(m_) ((ph == PH_NORM1) ? ((m_) < MLAT ? x_in + (size_t)(m_) * DM : ctx_in + (size_t)((m_) - MLAT) * DM) : X + (size_t)(m_) * DM)
        int m = gw; if (m >= nrows) return;
        f32x4 v[8], vn[8];
        { const float* xrow = NORM_ROW(m);
#pragma unroll
          for (int j = 0; j < 8; ++j) v[j] = ((const f32x4*)xrow)[lane + 64 * j]; }
        for (;;) {
            const int mn = m + NGW; const bool more = mn < nrows;
            if (more) { const float* xn = NORM_ROW(mn);
#pragma unroll
                for (int j = 0; j < 8; ++j) vn[j] = ((const f32x4*)xn)[lane + 64 * j]; }
            const int r = (ph == PH_NORM1 && m >= MLAT) ? 4 : (m >> 11);
            float ss = 0.f;
#pragma unroll
            for (int j = 0; j < 8; ++j) ss += (v[j].x * v[j].x + v[j].y * v[j].y) + (v[j].z * v[j].z + v[j].w * v[j].w);
            const float rstd = 1.0f / sqrtf(wave_sum(ss) * (1.0f / DM) + EPS);
            bf16_t* orow = H + (size_t)m * DM;
#pragma unroll
            for (int j = 0; j < 8; ++j) { const int idx = 4 * (lane + 64 * j);
                const f32x4 y = (v[j] * rstd) * *(const LAS f32x4*)(gm + r * DM + idx) + *(const LAS f32x4*)(sm + r * DM + idx);
                u32x2 w; w.x = pk2(y.x, y.y); w.y = pk2(y.z, y.w); *(u32x2*)(orow + idx) = w; }
            if (!more) break;
#pragma unroll
            for (int j = 0; j < 8; ++j) v[j] = vn[j];
            m = mn;
        }
#undef NORM_ROW
}
__device__ __forceinline__ void phase_R1(PH_PARAMS) {
        char* ldsg = (char*)lds_raw;
        const int r32 = lane & 31, hi = lane >> 5;
        const int sr = tid >> 4, sc = (tid & 15) * 8;
        u32x4 kq[2][2], vq[2][2];
#define R1_LOAD(item_) do { const int bh_ = (item_) / NCHUNK, ci_ = (item_) % NCHUNK; const int key0_ = ci_ < 2 ? ci_ * 128 : CTX + (ci_ - 2) * 128; \
            const bf16_t* Kp_ = RK + ((size_t)bh_ * NKEY + key0_) * HD; const bf16_t* Vp_ = RV + ((size_t)bh_ * NKEY + key0_) * HD; \
            _Pragma("unroll") for (int tl = 0; tl < 2; ++tl) _Pragma("unroll") for (int hh = 0; hh < 2; ++hh) { const int m_ = 64 * tl + 32 * hh + sr; \
                kq[tl][hh] = *(const u32x4*)(Kp_ + (size_t)m_ * HD + sc); vq[tl][hh] = *(const u32x4*)(Vp_ + (size_t)m_ * HD + sc); } } while (0)
        if (bid < 32 * NCHUNK) R1_LOAD(bid);
        for (int item = bid; item < 32 * NCHUNK; item += G) {
            const int bh = item / NCHUNK, ci = item % NCHUNK, h = bh & 7;
            const float xf = dec_f[h], xb = dec_b[h];
            const float lf2 = -log1pf(expf(-xf)) * 1.4426950408889634f, lb2 = -log1pf(expf(-xb)) * 1.4426950408889634f;
#pragma unroll
            for (int tl = 0; tl < 2; ++tl)
#pragma unroll
                for (int hh = 0; hh < 2; ++hh) { const int row = 32 * hh + sr, m = 64 * tl + row;
                    const u32x4 kv = kq[tl][hh]; const u32x4 vv = vq[tl][hh];
                    const float ff = __builtin_amdgcn_exp2f((float)(127 - m) * lf2), fb = __builtin_amdgcn_exp2f((float)m * lb2);
                    u32x4 vf, vb;
                    vf.x = pk2(bflo(vv.x) * ff, bfhi(vv.x) * ff); vf.y = pk2(bflo(vv.y) * ff, bfhi(vv.y) * ff); vf.z = pk2(bflo(vv.z) * ff, bfhi(vv.z) * ff); vf.w = pk2(bflo(vv.w) * ff, bfhi(vv.w) * ff);
                    vb.x = pk2(bflo(vv.x) * fb, bfhi(vv.x) * fb); vb.y = pk2(bflo(vv.y) * fb, bfhi(vv.y) * fb); vb.z = pk2(bflo(vv.z) * fb, bfhi(vv.z) * fb); vb.w = pk2(bflo(vv.w) * fb, bfhi(vv.w) * fb);
                    const int o = att::v_st(row, sc);
                    *(u32x4*)(ldsg + tl * 16384 + o) = kv; *(u32x4*)(ldsg + 32768 + tl * 16384 + o) = vf; *(u32x4*)(ldsg + 65536 + tl * 16384 + o) = vb; }
            LDS_BAR();
            if (item + G < 32 * NCHUNK) R1_LOAD(item + G);
            const int D0 = wave & 3, eh = wave >> 2;
            const int base = (int)(uintptr_t)ldsg + att::v_rd_base(lane);
            const int kb = base + D0 * 512, fb0 = base + 32768 + (2 * eh) * 512, bb0 = base + 65536 + (2 * eh) * 512;
            f32x16 af0 = {}, af1 = {}, ab0 = {}, ab1 = {};
#define R1_STEP(TL, KS) do { const int off_ = (TL) * 16384; \
                const s16x4 kl = att::tr_read<att::v_rd_off(0, KS, 0)>(kb + off_), kh = att::tr_read<att::v_rd_off(0, KS, 1)>(kb + off_); \
                const s16x4 f0l = att::tr_read<att::v_rd_off(0, KS, 0)>(fb0 + off_), f0h = att::tr_read<att::v_rd_off(0, KS, 1)>(fb0 + off_); \
                const s16x4 f1l = att::tr_read<att::v_rd_off(1, KS, 0)>(fb0 + off_), f1h = att::tr_read<att::v_rd_off(1, KS, 1)>(fb0 + off_); \
                const s16x4 b0l = att::tr_read<att::v_rd_off(0, KS, 0)>(bb0 + off_), b0h = att::tr_read<att::v_rd_off(0, KS, 1)>(bb0 + off_); \
                const s16x4 b1l = att::tr_read<att::v_rd_off(1, KS, 0)>(bb0 + off_), b1h = att::tr_read<att::v_rd_off(1, KS, 1)>(bb0 + off_); \
                asm volatile("s_waitcnt lgkmcnt(0)" ::: "memory"); SBAR(); \
                const bf16x8 ka = PKLH(kl, kh); \
                af0 = __builtin_amdgcn_mfma_f32_32x32x16_bf16(ka, PKLH(f0l, f0h), af0, 0, 0, 0); af1 = __builtin_amdgcn_mfma_f32_32x32x16_bf16(ka, PKLH(f1l, f1h), af1, 0, 0, 0); \
                ab0 = __builtin_amdgcn_mfma_f32_32x32x16_bf16(ka, PKLH(b0l, b0h), ab0, 0, 0, 0); ab1 = __builtin_amdgcn_mfma_f32_32x32x16_bf16(ka, PKLH(b1l, b1h), ab1, 0, 0, 0); } while (0)
            R1_STEP(0, 0); R1_STEP(0, 1); R1_STEP(0, 2); R1_STEP(0, 3); R1_STEP(1, 0); R1_STEP(1, 1); R1_STEP(1, 2); R1_STEP(1, 3);
#undef R1_STEP
            LDS_BAR();
            { char* OT = ldsg + wave * 17408;
#pragma unroll
              for (int r = 0; r < 16; ++r) { const int rr = att::crow(r, hi);
                  *(float*)(OT + rr * 272 + r32 * 4) = af0[r]; *(float*)(OT + rr * 272 + (32 + r32) * 4) = af1[r];
                  *(float*)(OT + 8704 + rr * 272 + r32 * 4) = ab0[r]; *(float*)(OT + 8704 + rr * 272 + (32 + r32) * 4) = ab1[r]; }
              asm volatile("s_waitcnt lgkmcnt(0)" ::: "memory");
              bf16_t* of = KVB + ((size_t)(bh * NCHUNK + ci) * 2 + 0) * 16384 + (size_t)(32 * D0) * 128 + 64 * eh;
#pragma unroll
              for (int dir = 0; dir < 2; ++dir)
#pragma unroll
                  for (int i = 0; i < 8; ++i) { const int row = i * 4 + (lane >> 4), ch = lane & 15;
                      stbf4(of + (size_t)dir * 16384 + row * 128 + ch * 4, *(const f32x4*)(OT + dir * 8704 + row * 272 + ch * 16)); } }
            LDS_BAR();
        }
}
#undef R1_LOAD
__device__ __forceinline__ void phase_R2(PH_PARAMS) {
        for (int it = bid * 512 + tid; it < 64 * 4096; it += G * 512) {
            const int e4 = it & 4095, dir = (it >> 12) & 1, bh = it >> 13, h = bh & 7;
            const float xd = dir ? dec_b[h] : dec_f[h]; const float g128 = expf(128.f * -log1pf(expf(-xd)));
            const bf16_t* kv = KVB + ((size_t)bh * NCHUNK * 2 + dir) * 16384 + 4 * e4;
            bf16_t* st = ST + ((size_t)bh * 16 * 2 + dir) * 16384 + 4 * e4;
            u32x2 a[17];
#pragma unroll
            for (int i = 0; i < 17; ++i) { const int ci = dir == 0 ? i : (i == 0 ? 1 : (i == 1 ? 0 : 19 - i)); a[i] = *(const u32x2*)(kv + (size_t)ci * 32768); }
#define BF4(w) ((f32x4){bflo((w).x), bfhi((w).x), bflo((w).y), bfhi((w).y)})
            f32x4 S = BF4(a[0]) * g128 + BF4(a[1]);
#pragma unroll
            for (int k = 0; k < 16; ++k) { const int c = dir == 0 ? k : 15 - k; stbf4(st + (size_t)c * 32768, S);
                if (k < 15) S = S * g128 + BF4(a[2 + k]); }
#undef BF4
        }
}
__device__ __forceinline__ void phase_ATTN(PH_PARAMS) {
        for (int item = bid; item < 256; item += G) {
            const int xcd = item & 7, slot = item >> 3, bh = xcd * 4 + (slot >> 3), qb = slot & 7, b = bh >> 3, h = bh & 7;
            att::mla_body(QN + ((size_t)bh * SEQ + qb * 256) * HD, QR + ((size_t)bh * SEQ + qb * 256) * DR, KN + (size_t)bh * NKEY * HD, KR + (size_t)b * NKEY * DR, VC + (size_t)bh * NKEY * HD,
                          MIX + ((size_t)(b * SEQ + qb * 256)) * DM + 1024 + h * HD, DM, NKEY, (char*)lds_raw, tid);
            __syncthreads();
        }
}
__device__ __forceinline__ void phase_R3(PH_PARAMS) {
        char* ldsg = (char*)lds_raw;
        const int r32 = lane & 31, hi = lane >> 5;
        const int sr = tid >> 4, sc = (tid & 15) * 8;
        float* part = (float*)(ldsg + 131072);
        for (int item = bid; item < 32 * 16; item += G) {
            const int bh = item >> 4, c = item & 15, b = bh >> 3, h = bh & 7;
            const float xf = dec_f[h], xb = dec_b[h];
            const float lf2 = -log1pf(expf(-xf)) * 1.4426950408889634f, lb2 = -log1pf(expf(-xb)) * 1.4426950408889634f;
            const bf16_t* Kp = RK + ((size_t)bh * NKEY + CTX + c * 128) * HD; const bf16_t* Vp = RV + ((size_t)bh * NKEY + CTX + c * 128) * HD;
            const bf16_t* Sp = ST + (size_t)(bh * 16 + c) * 32768;
            { u32x4 t0[4], t1[4];
#pragma unroll
              for (int q = 0; q < 4; ++q) { const int tl = q >> 1, hh = q & 1; const int row = 32 * hh + sr, m = 64 * tl + row;
                  t0[q] = *(const u32x4*)(Kp + (size_t)m * HD + sc); t1[q] = *(const u32x4*)(Vp + (size_t)m * HD + sc); }
#pragma unroll
              for (int q = 0; q < 4; ++q) { const int tl = q >> 1, hh = q & 1; const int row = 32 * hh + sr;
                  *(u32x4*)(ldsg + tl * 16384 + KSWZ(row, sc * 2)) = t0[q]; *(u32x4*)(ldsg + 32768 + tl * 16384 + att::v_st(row, sc)) = t1[q]; }
              asm volatile("" ::: "memory");
#pragma unroll
              for (int q = 0; q < 8; ++q) { const int tl = q >> 1, hh = q & 1; const int row = 32 * hh + sr, m = 64 * tl + row;
                  if (q < 4) t0[q] = *(const u32x4*)(Sp + (size_t)m * 128 + sc); else t1[q - 4] = *(const u32x4*)(Sp + (size_t)m * 128 + sc); }
#pragma unroll
              for (int q = 0; q < 8; ++q) { const int tl = q >> 1, hh = q & 1; const int row = 32 * hh + sr;
                  *(u32x4*)(ldsg + 65536 + tl * 16384 + att::v_st(row, sc)) = (q < 4) ? t0[q] : t1[q - 4]; }
              asm volatile("" ::: "memory"); }
            const int qw = wave & 3, ch = wave >> 2; int n = 32 * qw + r32;
            asm volatile("" : "+v"(n));
            bf16x8 qr[8];
            { const bf16_t* Qw = RQ + ((size_t)bh * SEQ + c * 128 + n) * HD + hi * 8;
#pragma unroll
              for (int d0 = 0; d0 < 8; ++d0) qr[d0] = *reinterpret_cast<const bf16x8*>(Qw + d0 * 16); }
            __syncthreads();
            f32x16 o0 = {}, o1 = {};
            const int vb = (int)(uintptr_t)ldsg + att::v_rd_base(lane);
#pragma unroll
            for (int tl = 0; tl < 2; ++tl) {
                f32x16 p0 = {}, p1 = {};
                att::qkt128(p0, p1, ldsg + tl * 16384, qr, r32, hi);
#pragma unroll
                for (int r = 0; r < 16; ++r) { const float d0f = (float)(n - (64 * tl + att::crow(r, hi))), d1f = d0f - 32.f;
                    p0[r] *= __builtin_amdgcn_exp2f(fmaxf(d0f, 0.f) * lf2 + fmaxf(-d0f, 0.f) * lb2);
                    p1[r] *= __builtin_amdgcn_exp2f(fmaxf(d1f, 0.f) * lf2 + fmaxf(-d1f, 0.f) * lb2); }
                bf16x8 pa0, pa1, pa2, pa3;
                PK4(p0, 0, pa0); PK4(p0, 8, pa1); PK4(p1, 0, pa2); PK4(p1, 8, pa3);
                const int vt = vb + 32768 + tl * 16384;
                if (ch == 0) { att::pv_one<0>(o0, vt, pa0, pa1, pa2, pa3); att::pv_one<1>(o1, vt, pa0, pa1, pa2, pa3); }
                else { att::pv_one<2>(o0, vt, pa0, pa1, pa2, pa3); att::pv_one<3>(o1, vt, pa0, pa1, pa2, pa3); }
            }
#pragma unroll 1
            for (int dir = 0; dir < 2; ++dir) {
                const float sf = __builtin_amdgcn_exp2f(dir == 0 ? (float)(n + 1) * lf2 : (float)(128 - n) * lb2);
#pragma unroll
                for (int kt = 0; kt < 2; ++kt) {
                    bf16x8 qs[4];
#pragma unroll
                    for (int d0 = 0; d0 < 4; ++d0) { const u32x4 w = *reinterpret_cast<const u32x4*>(&qr[4 * kt + d0]); u32x4 o;
                        o.x = cvtpk(bflo(w.x) * sf, bfhi(w.x) * sf); o.y = cvtpk(bflo(w.y) * sf, bfhi(w.y) * sf); o.z = cvtpk(bflo(w.z) * sf, bfhi(w.z) * sf); o.w = cvtpk(bflo(w.w) * sf, bfhi(w.w) * sf);
                        qs[d0] = *reinterpret_cast<const bf16x8*>(&o); }
                    const int vt = vb + 65536 + (dir * 2 + kt) * 16384;
                    if (ch == 0) { att::pv_one<0>(o0, vt, qs[0], qs[1], qs[2], qs[3]); att::pv_one<1>(o1, vt, qs[0], qs[1], qs[2], qs[3]); }
                    else { att::pv_one<2>(o0, vt, qs[0], qs[1], qs[2], qs[3]); att::pv_one<3>(o1, vt, qs[0], qs[1], qs[2], qs[3]); } }
            }
            float sq[16];
#pragma unroll
            for (int r = 0; r < 16; ++r) { float v = o0[r] * o0[r] + o1[r] * o1[r];
                v += __shfl_xor(v, 1); v += __shfl_xor(v, 2); v += __shfl_xor(v, 4); v += __shfl_xor(v, 8); v += __shfl_xor(v, 16); sq[r] = v; }
            if (r32 == 0) {
#pragma unroll
                for (int r = 0; r < 16; ++r) part[ch * 128 + 32 * qw + att::crow(r, hi)] = sq[r]; }
            __syncthreads();
            { float* OT = (float*)ldsg;
              float* OTb = OT + (32 * qw + 4 * hi) * 132 + 64 * ch + r32; const float* pb = part + 32 * qw + 4 * hi;
              asm volatile("" : "+v"(OTb), "+v"(pb));
#pragma unroll
              for (int r = 0; r < 16; ++r) { const int rc = (r & 3) + 8 * (r >> 2); const float tot = pb[rc] + pb[128 + rc];
                  const float rn = 1.0f / sqrtf(tot * (1.0f / 128.f) + EPS);
                  OTb[rc * 132] = o0[r] * rn; OTb[rc * 132 + 32] = o1[r] * rn; }
              __syncthreads();
              const int orow = tid >> 2, oc0 = (tid & 3) * 32; const size_t grow = (size_t)b * SEQ + c * 128 + orow;
              const bf16_t* gp = RG + grow * 1024 + h * HD + oc0; bf16_t* mp = MIX + grow * DM + h * HD + oc0; const float* op = OT + orow * 132 + oc0;
#pragma unroll
              for (int q = 0; q < 4; ++q) { const u32x4 gw4 = *(const u32x4*)(gp + 8 * q); const f32x4 a = *(const f32x4*)(op + 8 * q), bq = *(const f32x4*)(op + 8 * q + 4);
                  u32x4 w; w.x = pk2(a.x * silu_f(bflo(gw4.x)), a.y * silu_f(bfhi(gw4.x))); w.y = pk2(a.z * silu_f(bflo(gw4.y)), a.w * silu_f(bfhi(gw4.y)));
                  w.z = pk2(bq.x * silu_f(bflo(gw4.z)), bq.y * silu_f(bfhi(gw4.z))); w.w = pk2(bq.z * silu_f(bflo(gw4.w)), bq.w * silu_f(bfhi(gw4.w)));
                  *(u32x4*)(mp + 8 * q) = w; } }
            __syncthreads();
        }
}
__device__ __forceinline__ void phase_GEMM_G1(PH_PARAMS) {
    pg8::Gemm g{H, WIN, DM, DM, DM, 0, 0}; pg8::TileOrder S; S.init(MALL / 256, INP / 256, 1, G, bid); pg8::EpiSplit1 E{ws};
    pg8::gemm_phase<pg8::EpiSplit1, true>(lds, g, S, E, tid);
    if (G == 256 && bid >= 208) convert_tiles(PH_CALL(ph), 0, CT_N0 - CT_W_DN, CT_N0, bid - 208, 48);
}
__device__ __forceinline__ void phase_GEMM_LR(PH_PARAMS) {
    pg8::Gemm g; pg8::TileOrder S; pg8::EpiLowRank E;
    if (ph == PH_G2) { g = pg8::Gemm{CQ, WUQ, QRANK, QRANK, QRANK, 0, 0}; S.init(MLAT / 256, 1536 / 256, 1, G, bid); S.wgm = 4; E = pg8::EpiLowRank{ws, 0}; }
    else { g = pg8::Gemm{CKV, WUKV, KVRANK, KVRANK, KVRANK, 0, 0}; S.init(MALL / 256, 2048 / 256, 1, G, (bid + 64) % G); S.wgm = 9; E = pg8::EpiLowRank{ws, 1}; }
    pg8::gemm_phase<pg8::EpiLowRank, true>(lds, g, S, E, tid);
}
__device__ __forceinline__ void phase_GEMM_UP(PH_PARAMS) {
    const int l = (ph == PH_G8);
    pg8::Gemm g{H, WUP + (size_t)l * FF2 * DM, DM, DM, DM, 0, 0}; pg8::TileOrder S; S.init(MLAT / 256, FF2 / 256, 1, G, bid); S.wgm = 4;
    pg8::EpiConv E{conv_w + (size_t)l * 3 * FF2, conv_b + (size_t)l * FF2, ACT, HALO, (LAS float*)(lds + 131072)};
    pg8::gemm_phase<pg8::EpiConv, true>(lds, g, S, E, tid);
    if (ph == PH_G5) { if (G == 256 && bid >= 128) { convert_tiles(PH_CALL(ph), 1, 0, CT_W_UP, bid - 128, 128); convert_tiles(PH_CALL(ph), 1, CT_W_UP + CT_W_DN, CT_N1, bid - 128, 128);
                                                    }
                       else if (G != 256) convert_tiles(PH_CALL(ph), 1, 0, CT_N1, bid, G); }
    if (ph == PH_G8 && G == 256 && bid >= 128) convert_tiles(PH_CALL(ph), 1, CT_W_UP, CT_W_UP + CT_W_DN, bid - 128, 128);
}
__device__ __forceinline__ void conv_fixup(PH_PARAMS, const int pm) {
    const int l = (ph == PH_G9); const float* cw = conv_w + (size_t)l * 3 * FF2; const float* cb = conv_b + (size_t)l * FF2;
    const int pmm = pm & 7;
    for (int idx = tid; idx < 2 * (FF / 4); idx += 512) {
        const int which = idx / (FF / 4), f = (idx % (FF / 4)) * 4; const int cd = 256 * (f >> 7) + (f & 127);
        const float* hup; const float* hcur; const float* hdn; bool zup = false, zdn = false;
        if (which == 0) { hup = HALO + (size_t)((pm - 1) * 4 + 3) * FF2; hcur = HALO + (size_t)(pm * 4 + 0) * FF2; hdn = HALO + (size_t)(pm * 4 + 1) * FF2; zup = (pmm == 0); if (zup) hup = hcur; }
        else { hup = HALO + (size_t)(pm * 4 + 2) * FF2; hcur = HALO + (size_t)(pm * 4 + 3) * FF2; hdn = HALO + (size_t)((pm + 1) * 4 + 0) * FF2; zdn = (pmm == 7); if (zdn) hdn = hcur; }
        f32x4 up[2];
#pragma unroll
        for (int bj = 0; bj < 2; ++bj) { const int c = cd + bj * 128; const float* p = cw + bj * FF + f;
            f32x4 vu = *(const f32x4*)(hup + c), vc = *(const f32x4*)(hcur + c), vd = *(const f32x4*)(hdn + c);
            if (zup) vu = (f32x4){0.f, 0.f, 0.f, 0.f}; if (zdn) vd = (f32x4){0.f, 0.f, 0.f, 0.f};
            up[bj] = *(const f32x4*)(cb + bj * FF + f) + *(const f32x4*)p * vu + *(const f32x4*)(p + FF2) * vc + *(const f32x4*)(p + 2 * FF2) * vd; }
        const f32x4 a = up[0], gt = up[1];
        u32x2 w; w.x = pk2(a.x * silu_f(gt.x), a.y * silu_f(gt.y)); w.y = pk2(a.z * silu_f(gt.z), a.w * silu_f(gt.w));
        *(u32x2*)(ACT + (size_t)(pm * 256 + (which ? 255 : 0)) * FF + f) = w;
    }
}
__device__ __forceinline__ void phase_GEMM_RES(PH_PARAMS) {
    pg8::Gemm g{ACT, WDN, FF, FF, FF, 0, 0}; pg8::TileOrder S; S.init(MLAT / 256, DM / 256, 1, G, bid); S.wgm = 4; pg8::EpiResid E{XB, XB, ADA + 5 * DM, nullptr, 0, RSTDX};
    { pg8::Unit uu; for (int i = 0; S.next(i, uu); ++i) conv_fixup(args, ws, lds, lds_raw, tid, lane, wave, bid, G, gw, NGW, ph, uu.pm);
        asm volatile("s_waitcnt vmcnt(0)" ::: "memory"); __syncthreads(); }
    pg8::gemm_phase<pg8::EpiResid, false>(lds, g, S, E, tid);
}
__device__ __forceinline__ void phase_GEMM_POOL(PH_PARAMS) {
    using namespace pg8;
    TileOrder S; S.init(MLAT / 256, 2, 4, G, bid);
    const bf16_t* xb = XB; const float* ssq = RSTDX; const float* gvec = norm1_g + DM; const float* sc1 = ADA + 5 * NADA + DM; const bf16_t* Wp = WPOOL;
    constexpr int SA0 = 0, SB0 = 32768, YOFF = 98304, RSD = YOFF + 272 * 128, GMV = RSD + 272 * 4;
    static_assert(GMV + 512 * 4 <= 147456 - 256, "pool GEMM LDS map");
#define PGP_BAR asm volatile("s_waitcnt lgkmcnt(0)\n\ts_barrier" ::: "memory")
#define PGP_ISSUE_B(kt_) do { const int slot_ = (kt_) & 1; \
        _Pragma("unroll") for (int h_ = 0; h_ < 2; ++h_) _Pragma("unroll") for (int i_ = 0; i_ < 2; ++i_) \
            __builtin_amdgcn_global_load_lds((const unsigned*)(cB + (size_t)h_ * (128 * 512 * 2) + (size_t)(kt_) * 128 + voffB[i_]), (LAS unsigned*)(lds + SB0 + slot_ * 32768 + h_ * 16384 + ldsw + i_ * 8192), 16, 0, 0); } while (0)
#define PGP_ISSUE_Y(kt_) do { \
        _Pragma("unroll") for (int q_ = 0; q_ < 5; ++q_) { const int iq_ = wid + 8 * q_; if (iq_ < 34) { int t_ = t0 - 8 + iq_ * 8 + (lane >> 3); t_ = t_ < 0 ? 0 : (t_ > SEQ - 1 ? SEQ - 1 : t_); \
            __builtin_amdgcn_global_load_lds((const unsigned*)(xrow0 + (size_t)t_ * DM + (kt_) * 64 + (lane & 7) * 8), (LAS unsigned*)(lds + YOFF + iq_ * 1024), 16, 0, 0); } } } while (0)
    Unit cur;
    for (int ui = 0; S.next(ui, cur); ++ui) {
        if (G == 256) { const int xcd = bid & 7, off = bid >> 3; cur.pm = 4 * xcd + (off & 3); cur.pn = (off >> 2) & 1; cur.g = off >> 3; }
        int tq = threadIdx.x; asm volatile("" : "+v"(tq));
        const int wid = __builtin_amdgcn_readfirstlane(tq >> 6), lane = tq & 63, wr = wid >> 2, wc = wid & 3, fr = lane & 15, fq = lane >> 4;
        unsigned voffB[2];
#pragma unroll
        for (int i = 0; i < 2; ++i) { int R, C; stage_rc(tq * 16 + i * 8192, R, C); const int Rb = (R & ~31) + perm32(R & 31); voffB[i] = (unsigned)(Rb * 512 + C) * 2u; }
        const unsigned ldsw = (unsigned)wid * 1024u;
        const int aoff = lds_byte(wr * 64 + fr, fq * 8), boff = lds_byte(wc * 32 + fr, fq * 8);
        const int cg = tq & 15, seg = tq >> 4;
        const int b = cur.pm >> 3, t0 = (cur.pm & 7) * 256, hw = 1 << cur.g, kc0 = cur.g * 512;
        const bf16_t* xrow0 = xb + (size_t)b * SEQ * DM + kc0;
        const char* cB = (const char*)(Wp + (size_t)cur.g * 512 * 512 + (size_t)cur.pn * 256 * 512);
        PGP_ISSUE_Y(0); PGP_ISSUE_B(0);
        if (tq < 272) { const int t = t0 - 8 + tq; float rs = 0.f; if (t >= 0 && t < SEQ) rs = 1.0f / sqrtf(ssq[(size_t)b * SEQ + t] * (1.0f / DM) + EPS); *(LAS float*)(lds + RSD + tq * 4) = rs; }
        *(LAS float*)(lds + GMV + tq * 4) = gvec[kc0 + tq] * (sc1[(size_t)b * NADA + kc0 + tq] + 1.0f);
        f32x4 acc[2][2][4][2];
#pragma unroll
        for (int a = 0; a < 2; ++a)
#pragma unroll
            for (int bb = 0; bb < 2; ++bb)
#pragma unroll
                for (int m = 0; m < 4; ++m)
#pragma unroll
                    for (int n = 0; n < 2; ++n) acc[a][bb][m][n] = (f32x4){0.f, 0.f, 0.f, 0.f};
#pragma unroll 1
        for (int kt = 0; kt < 8; ++kt) {
            asm volatile("s_waitcnt vmcnt(0)" ::: "memory"); PGP_BAR;
            if (kt + 1 < 8) PGP_ISSUE_B(kt + 1);
            {   const LAS char* Yb = (const LAS char*)(lds + YOFF + cg * 8); const LAS float* rsd = (const LAS float*)(lds + RSD);
                const int r0 = seg * 8;
                const f32x4 gm = *(const LAS f32x4*)(lds + GMV + (kt * 64 + cg * 4) * 4);
                f32x4 Sv = {0.f, 0.f, 0.f, 0.f};
                for (int u = -hw; u < hw; ++u) Sv += pgp_y(Yb, rsd, r0 + 8 + u);
                LAS unsigned char* arow = lds + SA0 + (r0 >> 7) * 16384 + lds_byte(r0 & 127, cg * 4);
                const LAS char* yq = Yb + (r0 + 8) * 128; const LAS float* rq = rsd + r0 + 8;
#pragma unroll 1
                for (int r = 0; r < 8; ++r) { const int t = t0 + r0 + r; int lo = t - hw, hi = t + hw; lo = lo < 0 ? 0 : lo; hi = hi > SEQ ? SEQ : hi;
                    const f32x4 own = pgp_y(yq, rq, 0);
                    const f32x4 p = (Sv * __builtin_amdgcn_rcpf((float)(hi - lo)) - own) * gm;
                    u32x2 o; o.x = pk2(p.x, p.y); o.y = pk2(p.z, p.w);
                    *(LAS u32x2*)arow = o;
                    Sv += pgp_y(yq, rq, hw) - pgp_y(yq, rq, -hw);
                    arow += 64; yq += 128; rq += 1; }
            }
            PGP_BAR;
            if (kt + 1 < 8) PGP_ISSUE_Y(kt + 1);
            {   const int sb = SB0 + (kt & 1) * 32768; bf16x8 At[4][2], B0[2][2], B1[2][2];
#pragma unroll
                for (int n = 0; n < 2; ++n)
#pragma unroll
                    for (int k = 0; k < 2; ++k) { B0[n][k] = *(const LAS bf16x8*)(lds + sb + boff + n * 2048 + k * 1024); B1[n][k] = *(const LAS bf16x8*)(lds + sb + 16384 + boff + n * 2048 + k * 1024); }
#pragma unroll
                for (int ai = 0; ai < 2; ++ai) {
#pragma unroll
                    for (int m = 0; m < 4; ++m)
#pragma unroll
                        for (int k = 0; k < 2; ++k) At[m][k] = *(const LAS bf16x8*)(lds + SA0 + ai * 16384 + aoff + m * 2048 + k * 1024);
                    asm volatile("s_waitcnt lgkmcnt(0)" ::: "memory");
#pragma unroll
                    for (int m = 0; m < 4; ++m)
#pragma unroll
                        for (int n = 0; n < 2; ++n)
#pragma unroll
                            for (int k = 0; k < 2; ++k) { acc[ai][0][m][n] = __builtin_amdgcn_mfma_f32_16x16x32_bf16(B0[n][k], At[m][k], acc[ai][0][m][n], 0, 0, 0);
                                                          acc[ai][1][m][n] = __builtin_amdgcn_mfma_f32_16x16x32_bf16(B1[n][k], At[m][k], acc[ai][1][m][n], 0, 0, 0); }
                }
            }
        }
        asm volatile("s_waitcnt vmcnt(0)" ::: "memory"); PGP_BAR;
        {
            const EpiResidNorm E{nullptr, XB, XB2, ADA + 5 * NADA + 2 * DM, pool_scale, 512, norm2_g + DM, ADA + 5 * NADA + 3 * DM, ADA + 5 * NADA + 4 * DM, H, nullptr,
                                 (float*)(ws + WS_SLOTS), (unsigned*)(ws + WS_CTL + 16384) + 32 * 64};
            E.fused(acc, cur, wr, wc, fr, fq, lds, wid, lane); }
        asm volatile("s_waitcnt vmcnt(0)" ::: "memory"); PGP_BAR;
    }
#undef PGP_BAR
#undef PGP_ISSUE_B
#undef PGP_ISSUE_Y
}
__device__ __forceinline__ void phase_GEMM_RN(PH_PARAMS) {
    pg8::Gemm g; pg8::TileOrder S; pg8::EpiResidNorm E;
    float* slots = (float*)(ws + WS_SLOTS); unsigned* cntb = (unsigned*)(ws + WS_CTL + 16384);
    if (ph == PH_G4) { g = pg8::Gemm{MIX, WOUT, DM, DM, DM, 0, 0}; S.init(MLAT / 256, DM / 256, 1, G, bid); S.wgm = 4;
        E = pg8::EpiResidNorm{x_in, nullptr, XB, ADA + 2 * DM, nullptr, 0, norm2_g, ADA + 3 * DM, ADA + 4 * DM, H, nullptr, slots, cntb}; }
    else if (ph == PH_G7) { return; }
    else { g = pg8::Gemm{ACT, WDN + (size_t)DM * FF, FF, FF, FF, 0, 0}; S.init(MLAT / 256, DM / 256, 1, G, bid); S.wgm = 4;
        E = pg8::EpiResidNorm{nullptr, XB2, nullptr, ADA + 5 * NADA + 5 * DM, nullptr, 0, final_g, nullptr, nullptr, nullptr, X, slots, cntb + 64 * 64}; }
    if (ph == PH_G9) { pg8::Unit uu; for (int i = 0; S.next(i, uu); ++i) conv_fixup(args, ws, lds, lds_raw, tid, lane, wave, bid, G, gw, NGW, ph, uu.pm);
        asm volatile("s_waitcnt vmcnt(0)" ::: "memory"); __syncthreads(); }
    pg8::gemm_phase<pg8::EpiResidNorm, false>(lds, g, S, E, tid);
}
__global__ void __launch_bounds__(512, 2) mega(Args args) {
    extern __shared__ __attribute__((aligned(16))) unsigned char lds_raw[];
    LAS unsigned char* lds = (LAS unsigned char*)lds_raw;
    const int G = gridDim.x, bid = blockIdx.x;
    const int NGW = G * 8;
#define PH_LOCALS int tid_ = threadIdx.x; asm volatile("" : "+v"(tid_)); const int tid = tid_, lane = tid & 63, wave = __builtin_amdgcn_readfirstlane(tid >> 6), gw = bid * 8 + wave; (void)lane; (void)gw;
    unsigned char* ws = args.ws;
    const int lo = args.ph_lo, hi = args.ph_hi;
    volatile LAS unsigned* MISC = (volatile LAS unsigned*)(lds + MISC_OFF);
    if (threadIdx.x < 64) MISC[threadIdx.x] = 0u;
    __syncthreads();
    XcdBarrier bar; bar.bar = (unsigned*)(ws + WS_CTL); bar.x = 0; bar.st = nullptr;
    if (hi - lo > 1) bar = xcd_barrier_post((unsigned*)(ws + WS_CTL), MISC + 8);
#define IN(k) (EN(k) && lo <= (k) && (k) < hi)
#define SEAM(k) do { if ((k) + 1 < hi) xcd_barrier(bar); else __syncthreads(); } while (0)
    if (IN(PH_PREP)) { { PH_LOCALS phase_PREP(PH_CALL(PH_PREP)); } { PH_LOCALS phase_NORM(PH_CALL(PH_NORM1)); } SEAM(PH_NORM1); }
    if (IN(PH_G1)) { PH_LOCALS phase_GEMM_G1(PH_CALL(PH_G1)); SEAM(PH_G1); }
    if (IN(PH_G2)) { { PH_LOCALS phase_GEMM_LR(PH_CALL(PH_G2)); } { PH_LOCALS phase_GEMM_LR(PH_CALL(PH_G3)); } __syncthreads(); { PH_LOCALS phase_R1(PH_CALL(PH_R1)); } SEAM(PH_G2); }
    if (IN(PH_R2)) { { PH_LOCALS phase_R2(PH_CALL(PH_R2)); }
        asm volatile("s_waitcnt vmcnt(0)" ::: "memory"); __syncthreads();
        if (threadIdx.x == 0) { __builtin_amdgcn_fence(__ATOMIC_RELEASE, "agent"); asm volatile("s_waitcnt vmcnt(0)" ::: "memory"); __hip_atomic_fetch_add((unsigned*)(ws + WS_CTL + 49152 + 256), 1u, __ATOMIC_RELAXED, __HIP_MEMORY_SCOPE_AGENT); }
        { PH_LOCALS phase_ATTN(PH_CALL(PH_ATTN)); }
        if (threadIdx.x == 0) { unsigned spins = 0; while (__hip_atomic_load((unsigned*)(ws + WS_CTL + 49152 + 256), __ATOMIC_RELAXED, __HIP_MEMORY_SCOPE_AGENT) < (unsigned)G) { __builtin_amdgcn_s_sleep(2); if (++spins > (1u << 20)) break; }
            __builtin_amdgcn_fence(__ATOMIC_ACQUIRE, "agent"); asm volatile("s_waitcnt vmcnt(0)" ::: "memory"); }
        __syncthreads();
        { PH_LOCALS phase_R3(PH_CALL(PH_R3)); }
        SEAM(PH_R3); }
    if (IN(PH_G4)) { PH_LOCALS phase_GEMM_RN(PH_CALL(PH_G4)); SEAM(PH_G4); }
    if (IN(PH_G5)) { PH_LOCALS phase_GEMM_UP(PH_CALL(PH_G5)); if (REP(PH_G5)) { __syncthreads(); phase_GEMM_UP(PH_CALL(PH_G5)); } SEAM(PH_G5); }
    if (IN(PH_G6)) { PH_LOCALS phase_GEMM_RES(PH_CALL(PH_G6)); SEAM(PH_G6); }
    if (IN(PH_G7)) { PH_LOCALS phase_GEMM_POOL(PH_CALL(PH_G7)); SEAM(PH_G7); }
    if (IN(PH_G8)) { PH_LOCALS phase_GEMM_UP(PH_CALL(PH_G8)); if (REP(PH_G8)) { __syncthreads(); phase_GEMM_UP(PH_CALL(PH_G8)); } SEAM(PH_G8); }
    if (IN(PH_G9)) { PH_LOCALS phase_GEMM_RN(PH_CALL(PH_G9)); }
}

extern "C" void kernel_launch(void* const* d_in, const int* in_sizes, int n_in, void* d_out, int out_size, void* d_ws, size_t ws_size, hipStream_t stream) {
    static int ok = 0;
    if (ok == 0) {
        if (n_in != 23 || out_size != MLAT * DM || ws_size < WS_END) { fprintf(stderr, "kernel_launch: unexpected shapes: n_in %d out %d ws %zu (need %zu)\n", n_in, out_size, ws_size, (size_t)WS_END); ok = -1; return; }
        if (hipFuncSetAttribute((const void*)mega, hipFuncAttributeMaxDynamicSharedMemorySize, LDS_BYTES) != hipSuccess) { fprintf(stderr, "kernel_launch: hipFuncSetAttribute failed\n"); ok = -1; return; }
        int dev = 0, cus = 0, per_cu = 0;
        if (hipGetDevice(&dev) != hipSuccess || hipDeviceGetAttribute(&cus, hipDeviceAttributeMultiprocessorCount, dev) != hipSuccess ||
            hipOccupancyMaxActiveBlocksPerMultiprocessor(&per_cu, (const void*)mega, 512, LDS_BYTES) != hipSuccess || per_cu < 1 || (long)cus * per_cu < 256) {
            fprintf(stderr, "kernel_launch: the 256-workgroup persistent grid is not resident on this device (CUs %d, workgroups per CU %d); nothing launched\n", cus, per_cu); ok = -1; return; }
        ok = 1;
    }
    if (ok < 0) return;
    Args a{};
    for (int i = 0; i < 23; ++i) a.in[i] = (const float*)d_in[i];
    a.out = (float*)d_out; a.ws = (unsigned char*)d_ws;
    if (hipMemsetAsync((char*)d_ws + WS_CTL, 0, CTL_ZERO_BYTES, stream) != hipSuccess) { fprintf(stderr, "kernel_launch: hipMemsetAsync failed\n"); return; }
    a.ph_lo = 0; a.ph_hi = PH_COUNT;
    hipLaunchKernelGGL(mega, dim3(256), dim3(512), LDS_BYTES, stream, a);
    const hipError_t le = hipPeekAtLastError();
    if (le != hipSuccess) fprintf(stderr, "kernel_launch: launch failed: %s\n", hipGetErrorName(le));
}
```
